# Optimizing an MI355X kernel written in HIP

```python
import jax, jax.numpy as jnp
from jax import lax
import numpy as np

D_MODEL = 1024
BATCH = 4
SEQ = 8192
DEPTH = 2

GRID_W = 64
CTX_LEN = 256
HEAD_DIM = 64
N_HEADS_A = 8
N_KV_A = 2
N_HEADS_B = 8
N_KV_B = 2
BRANCH_WIDTH = 512
CONV_K = 3
WINDOW = 128
Q_BLOCK = 128
N_BRANCH = 3
N_EXPERTS = 16
EXPERT_HIDDEN = 1024
CAPACITY_FACTOR = 2
ROPE_BASE = 10000.0
EPS = 1e-6
NEG_INF = -1e30

KV_A = N_KV_A * HEAD_DIM
KV_B = N_KV_B * HEAD_DIM
KV_END = 2 * KV_A + 2 * KV_B
OFF_QA = KV_END
OFF_QB = OFF_QA + N_HEADS_A * HEAD_DIM
OFF_CONV = OFF_QB + N_HEADS_B * HEAD_DIM
OFF_GATE = OFF_CONV + 3 * BRANCH_WIDTH
PROJ_WIDTH = OFF_GATE + N_BRANCH * D_MODEL

kernel_name = "hybrid_parallel_gqa_window_shortconv_ecmoe_dit"


def rmsnorm(x, g):
    x32 = x.astype(jnp.float32)
    y = x32 * lax.rsqrt(jnp.mean(x32 * x32, axis=-1, keepdims=True) + EPS)
    return (y * g.astype(jnp.float32)).astype(x.dtype)


def modulate(h, shift, scale):
    return h * (1 + scale) + shift


def rope_tables(n):
    rows = n // GRID_W
    row = jnp.repeat(jnp.arange(rows, dtype=jnp.float32), GRID_W)
    col = jnp.tile(jnp.arange(GRID_W, dtype=jnp.float32), rows)
    n_freq = HEAD_DIM // 4
    inv = ROPE_BASE ** (-jnp.arange(n_freq, dtype=jnp.float32) / n_freq)
    ang = jnp.concatenate([row[:, None] * inv, col[:, None] * inv], axis=-1)
    return jnp.cos(ang), jnp.sin(ang)


def apply_rope(x, cos, sin):
    half = HEAD_DIM // 2
    c = cos[None, :, None, :].astype(x.dtype)
    s = sin[None, :, None, :].astype(x.dtype)
    x1, x2 = x[..., :half], x[..., half:]
    return jnp.concatenate([x1 * c - x2 * s, x2 * c + x1 * s], axis=-1)


def q_heads(p_q, qg, n_heads, n_kv, rope):
    B, n, _ = p_q.shape
    q = rmsnorm(p_q.reshape(B, n, n_heads, HEAD_DIM), qg)
    if rope is not None:
        q = apply_rope(q, *rope)
    return q.reshape(B, n, n_kv, n_heads // n_kv, HEAD_DIM)


def kv_heads(p_kv, kg_a, kg_b, rope):
    B, n, _ = p_kv.shape
    ka, va, kb, vb = jnp.split(p_kv, [KV_A, 2 * KV_A, 2 * KV_A + KV_B], axis=-1)
    ka = rmsnorm(ka.reshape(B, n, N_KV_A, HEAD_DIM), kg_a)
    kb = rmsnorm(kb.reshape(B, n, N_KV_B, HEAD_DIM), kg_b)
    va = va.reshape(B, n, N_KV_A, HEAD_DIM)
    vb = vb.reshape(B, n, N_KV_B, HEAD_DIM)
    if rope is not None:
        ka = apply_rope(ka, *rope)
        kb = apply_rope(kb, *rope)
    return ka, va, kb, vb


def attend(q, k, v, mask, sink):
    s = jnp.einsum('bqkgd,bskd->bkgqs', q, k, preferred_element_type=jnp.float32) * (HEAD_DIM ** -0.5)
    if mask is not None:
        s = jnp.where(mask, s, NEG_INF)
    if sink is not None:
        sk = jnp.broadcast_to(sink.astype(jnp.float32)[None, :, :, None, None], s.shape[:-1] + (1,))
        p = jax.nn.softmax(jnp.concatenate([s, sk], axis=-1), axis=-1)[..., :-1]
    else:
        p = jax.nn.softmax(s, axis=-1)
    return jnp.einsum('bkgqs,bskd->bqkgd', p.astype(v.dtype), v)


def to_blocks(q):
    B, n, KV, G, d = q.shape
    return q.reshape(B, n // Q_BLOCK, Q_BLOCK, KV, G, d).transpose(1, 0, 2, 3, 4, 5)


def from_blocks(o, n):
    nblk, B, qb, KV, G, d = o.shape
    return o.transpose(1, 0, 2, 3, 4, 5).reshape(B, n, KV * G * d)


def global_attention(q, k_lat, v_lat, k_ctx, v_ctx):
    k = jnp.concatenate([k_lat, k_ctx], axis=1)
    v = jnp.concatenate([v_lat, v_ctx], axis=1)
    o = lax.map(lambda qb: attend(qb, k, v, None, None), to_blocks(q))
    return from_blocks(o, q.shape[1])


def window_attention(q, k_lat, v_lat, k_ctx, v_ctx, sink):
    n = q.shape[1]
    nblk = n // Q_BLOCK
    pad = ((0, 0), (WINDOW, WINDOW), (0, 0), (0, 0))
    k_pad = jnp.pad(k_lat, pad)
    v_pad = jnp.pad(v_lat, pad)
    span = Q_BLOCK + 2 * WINDOW
    ctx_mask = jnp.ones((Q_BLOCK, k_ctx.shape[1]), dtype=bool)

    def block(args):
        i, qb = args
        start = i * Q_BLOCK
        kb = lax.dynamic_slice_in_dim(k_pad, start, span, axis=1)
        vb = lax.dynamic_slice_in_dim(v_pad, start, span, axis=1)
        qpos = start + jnp.arange(Q_BLOCK)
        kpos = start - WINDOW + jnp.arange(span)
        local = (jnp.abs(qpos[:, None] - kpos[None, :]) <= WINDOW) & (kpos >= 0)[None, :] & (kpos < n)[None, :]
        mask = jnp.concatenate([local, ctx_mask], axis=1)
        return attend(qb, jnp.concatenate([kb, k_ctx], axis=1), jnp.concatenate([vb, v_ctx], axis=1), mask, sink)

    o = lax.map(block, (jnp.arange(nblk), to_blocks(q)))
    return from_blocks(o, n)


def short_conv(p_conv, w):
    b_gate, c_gate, x_in = jnp.split(p_conv, 3, axis=-1)
    u = c_gate * x_in
    n = u.shape[1]
    up = jnp.pad(u, ((0, 0), (CONV_K // 2, CONV_K // 2), (0, 0)))
    conv = sum(w[j] * up[:, j:j + n] for j in range(CONV_K))
    return b_gate * conv


def merge_branches(o_a, o_b, o_c, gate_logits, w_branch, w_out):
    g_a, g_b, g_c = jnp.split(jax.nn.sigmoid(gate_logits), 3, axis=-1)
    merged = g_a * (o_a @ w_branch[0]) + g_b * (o_b @ w_branch[1]) + g_c * (o_c @ w_branch[2])
    return merged @ w_out


def latent_mixer(p, ctx_kv, rope, qg_a, kg_a, qg_b, kg_b, sink, conv_w, w_branch, w_out):
    ka, va, kb, vb = kv_heads(p[..., :KV_END], kg_a, kg_b, rope)
    ka_c, va_c, kb_c, vb_c = ctx_kv
    qa = q_heads(p[..., OFF_QA:OFF_QB], qg_a, N_HEADS_A, N_KV_A, rope)
    qb = q_heads(p[..., OFF_QB:OFF_CONV], qg_b, N_HEADS_B, N_KV_B, rope)
    o_a = global_attention(qa, ka, va, ka_c, va_c)
    o_b = window_attention(qb, kb, vb, kb_c, vb_c, sink.reshape(N_KV_B, N_HEADS_B // N_KV_B))
    o_c = short_conv(p[..., OFF_CONV:OFF_GATE], conv_w)
    return merge_branches(o_a, o_b, o_c, p[..., OFF_GATE:], w_branch, w_out)


def context_mixer(pc, ctx_kv, qg_a, qg_b, sink, conv_w, w_branch, w_out):
    B, L, _ = pc.shape
    ka_c, va_c, kb_c, vb_c = ctx_kv
    qa = q_heads(pc[..., OFF_QA:OFF_QB], qg_a, N_HEADS_A, N_KV_A, None)
    qb = q_heads(pc[..., OFF_QB:OFF_CONV], qg_b, N_HEADS_B, N_KV_B, None)
    o_a = attend(qa, ka_c, va_c, None, None).reshape(B, L, -1)
    o_b = attend(qb, kb_c, vb_c, None, sink.reshape(N_KV_B, N_HEADS_B // N_KV_B)).reshape(B, L, -1)
    o_c = short_conv(pc[..., OFF_CONV:OFF_GATE], conv_w)
    return merge_branches(o_a, o_b, o_c, pc[..., OFF_GATE:], w_branch, w_out)


def expert_choice_ffn(h, w_router, w_g, w_u, w_d):
    B, n, D = h.shape
    cap = CAPACITY_FACTOR * n // N_EXPERTS
    logits = jnp.einsum('bnd,de->ben', h, w_router, preferred_element_type=jnp.float32)
    aff = jax.nn.softmax(logits, axis=1)
    gate, idx = lax.top_k(aff, cap)
    bi = jnp.arange(B)[:, None, None]
    xs = h[bi, idx]
    a = jnp.einsum('becd,edf->becf', xs, w_g)
    u = jnp.einsum('becd,edf->becf', xs, w_u)
    y = jnp.einsum('becf,efd->becd', jax.nn.silu(a) * u, w_d)
    return jnp.zeros_like(h).at[bi, idx].add(y * gate[..., None].astype(y.dtype))


def setup_inputs(seed: int = 0) -> dict:
    key = jax.random.key(seed)
    ks = jax.random.split(key, 22)
    D = D_MODEL

    def nrm(k, shape, scale):
        return jax.random.normal(k, shape, jnp.float32) * scale

    return {
        "x": nrm(ks[0], (BATCH, SEQ, D), 1.0),
        "c": nrm(ks[1], (BATCH, D), 1.0),
        "ctx": nrm(ks[2], (BATCH, CTX_LEN, D), 1.0),
        "c_ctx": nrm(ks[3], (D,), 1.0),
        "w_ada": nrm(ks[4], (DEPTH, D, 6 * D), 0.5 * D ** -0.5),
        "b_ada": nrm(ks[5], (DEPTH, 6 * D), 0.02),
        "g_mix": 1.0 + nrm(ks[6], (DEPTH, D), 0.02),
        "g_ffn": 1.0 + nrm(ks[7], (DEPTH, D), 0.02),
        "w_in": nrm(ks[8], (DEPTH, D, PROJ_WIDTH), D ** -0.5),
        "qg_a": 1.0 + nrm(ks[9], (DEPTH, HEAD_DIM), 0.02),
        "kg_a": 1.0 + nrm(ks[10], (DEPTH, HEAD_DIM), 0.02),
        "qg_b": 1.0 + nrm(ks[11], (DEPTH, HEAD_DIM), 0.02),
        "kg_b": 1.0 + nrm(ks[12], (DEPTH, HEAD_DIM), 0.02),
        "sink_b": nrm(ks[13], (DEPTH, N_HEADS_B), 0.5),
        "conv_w": nrm(ks[14], (DEPTH, CONV_K, BRANCH_WIDTH), CONV_K ** -0.5),
        "w_branch": nrm(ks[15], (DEPTH, N_BRANCH, BRANCH_WIDTH, D), BRANCH_WIDTH ** -0.5),
        "w_out": nrm(ks[16], (DEPTH, D, D), D ** -0.5),
        "w_router": nrm(ks[17], (DEPTH, D, N_EXPERTS), D ** -0.5),
        "w_e_gate": nrm(ks[18], (DEPTH, N_EXPERTS, D, EXPERT_HIDDEN), D ** -0.5),
        "w_e_up": nrm(ks[19], (DEPTH, N_EXPERTS, D, EXPERT_HIDDEN), D ** -0.5),
        "w_e_down": nrm(ks[20], (DEPTH, N_EXPERTS, EXPERT_HIDDEN, D), EXPERT_HIDDEN ** -0.5),
    }


def reference(x, c, ctx, c_ctx, w_ada, b_ada, g_mix, g_ffn, w_in, qg_a, kg_a, qg_b, kg_b, sink_b,
              conv_w, w_branch, w_out, w_router, w_e_gate, w_e_up, w_e_down):
    n = x.shape[1]
    rope = rope_tables(n)
    silu_c = jax.nn.silu(c)
    silu_cc = jax.nn.silu(c_ctx)
    xc = ctx
    for l in range(DEPTH):
        last = l == DEPTH - 1
        mod = silu_c @ w_ada[l] + b_ada[l]
        sh1, sc1, gt1, sh2, sc2, gt2 = [m[:, None, :] for m in jnp.split(mod, 6, axis=-1)]
        modc = silu_cc @ w_ada[l] + b_ada[l]
        shc1, scc1, gtc1, shc2, scc2, gtc2 = jnp.split(modc, 6)

        hc = modulate(rmsnorm(xc, g_mix[l]), shc1, scc1)
        pc = hc @ (w_in[l][:, :KV_END] if last else w_in[l])
        ctx_kv = kv_heads(pc[..., :KV_END], kg_a[l], kg_b[l], None)

        h = modulate(rmsnorm(x, g_mix[l]), sh1, sc1)
        p = h @ w_in[l]
        x = x + gt1 * latent_mixer(p, ctx_kv, rope, qg_a[l], kg_a[l], qg_b[l], kg_b[l], sink_b[l],
                                   conv_w[l], w_branch[l], w_out[l])
        h2 = modulate(rmsnorm(x, g_ffn[l]), sh2, sc2)
        x = x + gt2 * expert_choice_ffn(h2, w_router[l], w_e_gate[l], w_e_up[l], w_e_down[l])

        if not last:
            xc = xc + gtc1 * context_mixer(pc, ctx_kv, qg_a[l], qg_b[l], sink_b[l], conv_w[l],
                                           w_branch[l], w_out[l])
            hc2 = modulate(rmsnorm(xc, g_ffn[l]), shc2, scc2)
            xc = xc + gtc2 * expert_choice_ffn(hc2, w_router[l], w_e_gate[l], w_e_up[l], w_e_down[l])
    return x
```

```cpp
#include <hip/hip_runtime.h>
#include <hip/hip_bf16.h>
#include <cmath>
#include <cstdio>
#include <cstdint>

#define GAS __attribute__((address_space(1)))
#define LAS __attribute__((address_space(3)))
typedef unsigned short bf16_t;
typedef short bf16x8 __attribute__((ext_vector_type(8)));
typedef short s16x4 __attribute__((ext_vector_type(4)));
typedef float f32x4 __attribute__((ext_vector_type(4)));
typedef float f32x16 __attribute__((ext_vector_type(16)));
typedef unsigned u32x4 __attribute__((ext_vector_type(4)));
typedef unsigned u32x2 __attribute__((ext_vector_type(2)));
typedef int v4i32 __attribute__((ext_vector_type(4)));
typedef int v8i32 __attribute__((ext_vector_type(8)));

#ifndef MK_ONE_LAUNCH
#define MK_ONE_LAUNCH 1
#endif

constexpr int D = 1024, NB = 4, SEQ = 8192, CTX = 256, DEPTH = 2;
constexpr int ML = NB * SEQ, MC = NB * CTX, MT = ML + MC;
constexpr int PW = 6144;
constexpr int QW = 1024, GW = 3072;
constexpr int OFF_QA = 0, OFF_QB = 512;
constexpr int KVROWS = SEQ + CTX;
constexpr int NE = 16, CAP = 1024, CAPC = 32, EH = 1024;
constexpr float EPS = 1e-6f;
constexpr float LOG2E = 1.4426950408889634f;
constexpr float QSCALE = 0.125f * LOG2E;
constexpr int NWAVES = 8, NTHR = 512;

constexpr size_t MiB = 1u << 20;
constexpr size_t WS_CTL = 0, CTL_ZERO_BYTES = 64 * 1024;
constexpr size_t WS_MOD = 1 * MiB;
constexpr size_t WS_GAINS = 1 * MiB + 768 * 1024;
constexpr size_t WS_XC = 2 * MiB;
constexpr size_t WS_AFF = 6 * MiB;
constexpr size_t WS_IDX = 9 * MiB;
constexpr size_t WS_GATEV = 11 * MiB;
constexpr size_t WS_INV = 13 * MiB;
constexpr size_t WS_WIN = 16 * MiB;
constexpr size_t WS_WBR = 28 * MiB;
constexpr size_t WS_WOUT = 31 * MiB;
constexpr size_t WS_H = 33 * MiB;
constexpr size_t WS_KA = 99 * MiB, WS_KB = 108 * MiB, WS_VTA = 117 * MiB, WS_VTB = 126 * MiB;
constexpr size_t WS_QKV = 135 * MiB;
constexpr size_t WS_CONV = 234 * MiB;
constexpr size_t WS_GATE = 333 * MiB;
constexpr size_t WS_XS = 135 * MiB;
constexpr size_t WS_HID = 271 * MiB;
constexpr size_t WS_WGU = 407 * MiB;
constexpr size_t WS_WD = 471 * MiB;
constexpr size_t WS_DELTA = 531 * MiB;
constexpr size_t WS_H8 = 597 * MiB;
constexpr size_t WS_END = 630 * MiB;
constexpr int MOE_ROWS_LAT = NB * NE * CAP;
constexpr int MOE_ROWS = MOE_ROWS_LAT + NE * 256;

constexpr int RING_BYTES = 131072, MISC_OFF = RING_BYTES, LDS_BYTES = 147456;

__device__ __forceinline__ unsigned cvt_pk_bf16(float lo, float hi) { unsigned r; asm("v_cvt_pk_bf16_f32 %0, %1, %2" : "=v"(r) : "v"(lo), "v"(hi)); return r; }
__device__ __forceinline__ float bf_lo(unsigned w) { return __uint_as_float(w << 16); }
__device__ __forceinline__ float bf_hi(unsigned w) { return __uint_as_float(w & 0xffff0000u); }
__device__ __forceinline__ float wave_sum(float v) {
#pragma unroll
    for (int o = 1; o < 64; o <<= 1) v += __shfl_xor(v, o);
    return v;
}
__device__ __forceinline__ float fast_sigmoid(float v) { return __builtin_amdgcn_rcpf(1.0f + __builtin_amdgcn_exp2f(-v * LOG2E)); }
#define LDS_WAIT() asm volatile("s_waitcnt lgkmcnt(0)" ::: "memory")

#define XB_TMO      128
#define XB_XCNT(j)  (256  + 64 * (j))
#define XB_XSUB(j)  (1280 + 64 * (j))
#define XB_XGEN(j)  (2304 + 64 * (j))
#define XB_TOP      3328
#define XB_TOPGEN   3392
#define XCD_BAR_WORDS 3456
#define XB_SPIN_CAP (1u << 18)

__device__ __forceinline__ unsigned xb_ld(unsigned* p)              { return __hip_atomic_load(p, __ATOMIC_RELAXED, __HIP_MEMORY_SCOPE_AGENT); }
__device__ __forceinline__ unsigned xb_add(unsigned* p, unsigned v) { return __hip_atomic_fetch_add(p, v, __ATOMIC_RELAXED, __HIP_MEMORY_SCOPE_AGENT); }
__device__ __forceinline__ unsigned xb_xcc_id() { return (unsigned)__builtin_amdgcn_s_getreg((3 << 11) | 20) & 0xFu; }
#define XB_SPIN(cond, bar) do { unsigned _sp = 0; while (cond) { __builtin_amdgcn_s_sleep(1); \
    if ((++_sp & 255u) == 0u) { if (xb_ld(&(bar)[XB_TMO])) break; if (_sp > XB_SPIN_CAP) { atomicAdd(&(bar)[XB_TMO], 1u); break; } } } } while (0)

struct XcdBarrier { unsigned* bar; unsigned x; volatile LAS unsigned* st; };

__device__ __forceinline__ XcdBarrier xcd_barrier_post(unsigned* bar, volatile LAS unsigned* st) {
    XcdBarrier b; b.bar = bar; b.x = xb_xcc_id(); b.st = st;
    if (threadIdx.x == 0) (void)xb_add(&bar[XB_XCNT(b.x)], 1u);
    return b;
}
__device__ __forceinline__ void xcd_barrier_complete(unsigned* bar, unsigned x, unsigned& nloc, unsigned& nx) {
    const unsigned G = gridDim.x * gridDim.y * gridDim.z;
    unsigned sum, cnt, mine, sp = 0u;
    for (;;) {
        sum = 0u; cnt = 0u; mine = 0u;
#pragma unroll
        for (unsigned j = 0; j < 16; ++j) { const unsigned c = xb_ld(&bar[XB_XCNT(j)]); sum += c; cnt += (c > 0u) ? 1u : 0u; mine = (j == x) ? c : mine; }
        if (sum == G) break;
        __builtin_amdgcn_s_sleep(1);
        if ((++sp & 255u) == 0u) { if (xb_ld(&bar[XB_TMO])) break; if (sp > XB_SPIN_CAP) { atomicAdd(&bar[XB_TMO], 1u); break; } }
    }
    nloc = mine > 0u ? mine : 1u; nx = cnt > 0u ? cnt : 1u;
}
__device__ __forceinline__ void xcd_barrier(const XcdBarrier& b) {
    asm volatile("s_waitcnt vmcnt(0)" ::: "memory");
    __syncthreads();
    if (threadIdx.x == 0) {
        unsigned* bar = b.bar;
        __builtin_amdgcn_s_waitcnt(0);
        unsigned nloc = b.st[0], nx = b.st[1];
        if (nloc == 0u) { xcd_barrier_complete(bar, b.x, nloc, nx); b.st[0] = nloc; b.st[1] = nx; }
        const unsigned old = xb_add(&bar[XB_XSUB(b.x)], 1u);
        const unsigned gen = old / nloc;
        if (old + 1u == (gen + 1u) * nloc) {
            __builtin_amdgcn_fence(__ATOMIC_RELEASE, "agent");
            asm volatile("s_waitcnt vmcnt(0)" ::: "memory");
            const unsigned og = xb_add(&bar[XB_TOP], 1u);
            const unsigned tg = og / nx;
            if (og + 1u == (tg + 1u) * nx) xb_add(&bar[XB_TOPGEN], 1u);
            else XB_SPIN(xb_ld(&bar[XB_TOPGEN]) == tg, bar);
            __builtin_amdgcn_fence(__ATOMIC_ACQUIRE, "agent");
            xb_add(&bar[XB_XGEN(b.x)], 1u);
            asm volatile("s_waitcnt vmcnt(0)" ::: "memory");
        } else {
            XB_SPIN(xb_ld(&bar[XB_XGEN(b.x)]) == gen, bar);
            __builtin_amdgcn_fence(__ATOMIC_ACQUIRE, "agent");
            asm volatile("s_waitcnt vmcnt(0)" ::: "memory");
        }
    }
    __syncthreads();
}

#ifndef PG8_ALIGN_EPI
#define PG8_ALIGN_EPI 1
#endif
#ifndef PG8_SP2
#define PG8_SP2 1
#endif
namespace pg8 {
constexpr int BM = 256, BK = 64, HALF = 128, HTB = HALF * BK * 2, STAGE_BYTES = 8 * HTB, NXCD = 8, WGM = 8;
__host__ __device__ __forceinline__ int lds_byte(int r, int c) { const int st = (r >> 4) * 2 + (c >> 5), rr = r & 15, cc = c & 31, ob = rr * 64 + cc * 2; return st * 1024 + (ob ^ (((ob >> 9) & 1) << 5)); }
__host__ __device__ __forceinline__ void stage_rc(int b, int& R, int& C) { const int st = b / 1024, sb = b % 1024, swz = sb ^ (((sb >> 9) & 1) << 5); R = (st >> 1) * 16 + swz / 64; C = (st & 1) * 32 + (swz % 64) / 2; }
__host__ __device__ __forceinline__ int perm32(int rho) { const int n = rho >> 4, i = rho & 15; return 8 * (i >> 2) + 4 * n + (i & 3); }

__device__ __forceinline__ void glds16_saddr(unsigned voff, const void* sbase, unsigned lds_dst) { unsigned keep;
    asm volatile("s_mov_b32 %0, m0\n\ts_mov_b32 m0, %3\n\ts_nop 0\n\tglobal_load_lds_dwordx4 %1, %2\n\ts_mov_b32 m0, %0" : "=&s"(keep) : "v"(voff), "s"(sbase), "s"(lds_dst) : "memory"); }
struct Unit { const char* a; const char* b; int pm, pn, aux; };

struct TileOrder {
    int nM, nN, nwg, G, c;
    __device__ __forceinline__ void init(int nM_, int nN_, int G_, int c_) { nM = nM_; nN = nN_; nwg = nM * nN; G = G_; c = c_; }
    __device__ __forceinline__ bool tile(int i, int& pm, int& pn) const {
        const long L = (long)i * G + c; if (L >= nwg) return false;
        int wgid = (int)L; { const int q = nwg / NXCD, r = nwg % NXCD, xcd = wgid % NXCD, off = wgid / NXCD; wgid = (xcd < r ? xcd * (q + 1) : r * (q + 1) + (xcd - r) * q) + off; }
        const int nig = WGM * nN, gid = wgid / nig, fm = gid * WGM, gsz = (nM - fm) < WGM ? (nM - fm) : WGM;
        pm = fm + ((wgid % nig) % gsz); pn = (wgid % nig) / gsz; return true;
    }
};

template <class Epi, class Sched>
__device__ __forceinline__ void gemm_phase(LAS unsigned char* lds, const int K, const int lda, const int ldb, const Sched& S, const Epi& E) {
    int tid_ = threadIdx.x; asm volatile("" : "+v"(tid_));
    const int tid = tid_, wid = __builtin_amdgcn_readfirstlane(tid >> 6), lane = tid & 63, wr = wid >> 2, wc = wid & 3, fr = lane & 15, fq = lane >> 4;
    const int nt = K / BK;
    unsigned voffA[2], voffB[2]; int Rr[2];
#pragma unroll
    for (int i = 0; i < 2; ++i) { int R, C; stage_rc(tid * 16 + i * 8192, R, C); const int Rb = Epi::PERM ? ((R & ~31) + perm32(R & 31)) : R;
        voffA[i] = Sched::GATHER ? (unsigned)C * 2u : (unsigned)(R * lda + C) * 2u; voffB[i] = (unsigned)(Rb * ldb + C) * 2u; Rr[i] = R; }
    unsigned gA0 = 0u, gA1 = 0u, nG0 = 0u, nG1 = 0u;
    const size_t kstep = (size_t)(BK * 2);
    const size_t hstepA = (size_t)HALF * lda * 2, hstepB = (size_t)HALF * ldb * 2;
    const unsigned ldsw = (unsigned)wid * 1024u;
    const unsigned ldsbase = (unsigned)__builtin_amdgcn_readfirstlane((int)((unsigned)(uintptr_t)lds + ldsw));
    const int aoff = lds_byte(wr * 64 + fr, fq * 8), boff = lds_byte(wc * 32 + fr, fq * 8);
#define PG8_SA(b, h) (((b) * 2 + (h)) * HTB)
#define PG8_SB(b, h) ((4 + (b) * 2 + (h)) * HTB)
#define PG8_STAGE(bufoff, gbase, voff) do { _Pragma("unroll") for (int _i = 0; _i < 2; ++_i) \
        glds16_saddr((voff)[_i], (const void*)(gbase), ldsbase + (unsigned)((bufoff) + _i * 8192)); } while (0)
#define PG8_STAGE_A(b, h, ptr_plain, ptr_gather, GO) do { if constexpr (Sched::GATHER) { const unsigned go_[2] = { ((GO) & 0xffffu) * S.rowbytes() + voffA[0], ((GO) >> 16) * S.rowbytes() + voffA[1] }; PG8_STAGE(PG8_SA(b, h), ptr_gather, go_); } \
        else PG8_STAGE(PG8_SA(b, h), ptr_plain, voffA); } while (0)
#define PG8_LDA(dst, b, h) do { _Pragma("unroll") for (int m = 0; m < 4; ++m) { \
        if constexpr (Epi::FP8) dst##8[m] = __builtin_shufflevector(*(const LAS v4i32*)(lds + PG8_SA(b, h) + aoff + m * 2048), *(const LAS v4i32*)(lds + PG8_SA(b, h) + aoff + m * 2048 + 1024), 0, 1, 2, 3, 4, 5, 6, 7); \
        else { _Pragma("unroll") for (int k = 0; k < 2; ++k) dst[m][k] = *(const LAS bf16x8*)(lds + PG8_SA(b, h) + aoff + m * 2048 + k * 1024); } } } while (0)
#define PG8_LDB(dst, b, h) do { _Pragma("unroll") for (int n = 0; n < 2; ++n) { \
        if constexpr (Epi::FP8) dst##8[n] = __builtin_shufflevector(*(const LAS v4i32*)(lds + PG8_SB(b, h) + boff + n * 2048), *(const LAS v4i32*)(lds + PG8_SB(b, h) + boff + n * 2048 + 1024), 0, 1, 2, 3, 4, 5, 6, 7); \
        else { _Pragma("unroll") for (int k = 0; k < 2; ++k) dst[n][k] = *(const LAS bf16x8*)(lds + PG8_SB(b, h) + boff + n * 2048 + k * 1024); } } } while (0)
#define PG8_MMA(ai, bj, At, Bt) do { __builtin_amdgcn_s_setprio(1); \
        if constexpr (Epi::FP8) {     \
            _Pragma("unroll") for (int m = 0; m < 4; ++m) _Pragma("unroll") for (int n = 0; n < 2; ++n) { \
                asm volatile("v_mfma_scale_f32_16x16x128_f8f6f4 %0, %1, %2, %0, %3, %3 op_sel_hi:[0,0,0]" : "+v"(acc[ai][bj][m][n]) : "v"(Bt##8[n]), "v"(At##8[m]), "v"(sc8)); }   \
        } else { \
            _Pragma("unroll") for (int m = 0; m < 4; ++m) _Pragma("unroll") for (int n = 0; n < 2; ++n) _Pragma("unroll") for (int k = 0; k < 2; ++k) \
                acc[ai][bj][m][n] = __builtin_amdgcn_mfma_f32_16x16x32_bf16(Bt[n][k], At[m][k], acc[ai][bj][m][n], 0, 0, 0); } \
        __builtin_amdgcn_s_setprio(0); } while (0)
#define PG8_WAIT_V(n) asm volatile("s_waitcnt vmcnt(" #n ")" ::: "memory")
#define PG8_WAIT_L(n) asm volatile("s_waitcnt lgkmcnt(" #n ")" ::: "memory")
#define PG8_BAR __builtin_amdgcn_s_barrier()
#define PG8_SCHED __builtin_amdgcn_sched_barrier(0)
    Unit cur, nxt; int ui = 0;
    if (!S.next(0, cur)) return;
    f32x4 acc[2][2][4][2];
#pragma unroll
    for (int a = 0; a < 2; ++a)
#pragma unroll
        for (int b = 0; b < 2; ++b)
#pragma unroll
            for (int m = 0; m < 4; ++m)
#pragma unroll
                for (int n = 0; n < 2; ++n) acc[a][b][m][n] = (f32x4){0.f, 0.f, 0.f, 0.f};
    const int sc8 = 0x7F7F7F7F;
    bf16x8 At[4][2], B0[2][2], B1[2][2]; v8i32 At8[4], B08[2], B18[2];
    const char* cA = cur.a; const char* cB = cur.b;
    if constexpr (Sched::GATHER) { S.rows(cur, tid, gA0, gA1); }
#if PG8_SP2
    PG8_STAGE(PG8_SB(0, 0), cB, voffB); PG8_STAGE(PG8_SB(0, 1), cB + hstepB, voffB); PG8_STAGE_A(0, 0, cA, cA, gA0); PG8_STAGE_A(0, 1, cA + hstepA, cA, gA1);
    if (wr == 1) PG8_BAR;
    PG8_WAIT_V(2); PG8_BAR;
    PG8_STAGE(PG8_SB(1, 0), cB + kstep, voffB); PG8_STAGE_A(1, 0, cA + kstep, cA + kstep, gA0); PG8_STAGE(PG8_SB(1, 1), cB + hstepB + kstep, voffB);
    PG8_WAIT_V(6); PG8_BAR;
#else
    PG8_STAGE(PG8_SB(0, 0), cB, voffB); PG8_STAGE_A(0, 0, cA, cA, gA0); PG8_STAGE(PG8_SB(0, 1), cB + hstepB, voffB); PG8_STAGE_A(0, 1, cA + hstepA, cA, gA1);
    if (wr == 1) PG8_BAR;
    PG8_WAIT_V(4); PG8_BAR;
    PG8_STAGE(PG8_SB(1, 0), cB + kstep, voffB); PG8_STAGE_A(1, 0, cA + kstep, cA + kstep, gA0); PG8_STAGE(PG8_SB(1, 1), cB + hstepB + kstep, voffB);
    PG8_WAIT_V(6); PG8_BAR;
#endif
    for (;;) {
        const bool has_next = S.next(ui + 1, nxt);
        const char* nA = has_next ? nxt.a : cA; const char* nB = has_next ? nxt.b : cB;
        if constexpr (Sched::GATHER) { if (has_next) S.rows(nxt, tid, nG0, nG1); else { nG0 = gA0; nG1 = gA1; } }
#pragma unroll 1
        for (int t = 0; t < nt; t += 2) {
            const bool last = (t == nt - 2);
            const char* a1 = cA + (size_t)(t + 1) * kstep;
            const char* a2 = last ? nA : cA + (size_t)(t + 2) * kstep; const char* b2 = last ? nB : cB + (size_t)(t + 2) * kstep;
            const char* a3 = a2 + kstep; const char* b3 = b2 + kstep;
            const unsigned s0 = last ? nG0 : gA0, s1 = last ? nG1 : gA1;
#if PG8_SP2
            PG8_LDB(B0, 0, 0); PG8_LDB(B1, 0, 1); PG8_SCHED; PG8_LDA(At, 0, 0); PG8_STAGE_A(1, 1, a1 + hstepA, a1, gA1);
            PG8_WAIT_V(8); PG8_WAIT_L(0); PG8_BAR; PG8_MMA(0, 0, At, B0); PG8_MMA(0, 1, At, B1); PG8_BAR; PG8_SCHED;
            PG8_LDA(At, 0, 1); PG8_STAGE(PG8_SB(0, 0), b2, voffB); PG8_STAGE(PG8_SB(0, 1), b2 + hstepB, voffB); PG8_STAGE_A(0, 0, a2, a2, s0);
            PG8_WAIT_V(8); PG8_WAIT_L(0); PG8_BAR; PG8_MMA(1, 0, At, B0); PG8_MMA(1, 1, At, B1); PG8_BAR; PG8_SCHED;
            PG8_LDB(B0, 1, 0); PG8_LDB(B1, 1, 1); PG8_SCHED; PG8_LDA(At, 1, 0); PG8_STAGE_A(0, 1, a2 + hstepA, a2, s1);
            PG8_WAIT_V(8); PG8_WAIT_L(0); PG8_BAR; PG8_MMA(0, 0, At, B0); PG8_MMA(0, 1, At, B1); PG8_BAR; PG8_SCHED;
            PG8_LDA(At, 1, 1); PG8_STAGE(PG8_SB(1, 0), b3, voffB); PG8_STAGE(PG8_SB(1, 1), b3 + hstepB, voffB); PG8_STAGE_A(1, 0, a3, a3, s0);
            PG8_WAIT_V(8); PG8_WAIT_L(0); PG8_BAR; PG8_MMA(1, 0, At, B0); PG8_MMA(1, 1, At, B1); PG8_BAR; PG8_SCHED;
#else
            PG8_LDB(B0, 0, 0); PG8_SCHED; PG8_LDA(At, 0, 0); PG8_STAGE_A(1, 1, a1 + hstepA, a1, gA1);
            PG8_WAIT_L(8); PG8_BAR; PG8_WAIT_L(0); PG8_MMA(0, 0, At, B0); PG8_BAR; PG8_SCHED;
            PG8_LDB(B1, 0, 1); PG8_STAGE(PG8_SB(0, 0), b2, voffB);
            PG8_BAR; PG8_WAIT_L(0); PG8_MMA(0, 1, At, B1); PG8_BAR;
            PG8_LDA(At, 0, 1); PG8_STAGE_A(0, 0, a2, a2, s0);
            PG8_BAR; PG8_WAIT_L(0); PG8_MMA(1, 0, At, B0); PG8_BAR; PG8_SCHED;
            PG8_STAGE(PG8_SB(0, 1), b2 + hstepB, voffB);
            PG8_WAIT_V(6); PG8_BAR; PG8_MMA(1, 1, At, B1); PG8_BAR;
            PG8_LDB(B0, 1, 0); PG8_SCHED; PG8_LDA(At, 1, 0); PG8_STAGE_A(0, 1, a2 + hstepA, a2, s1);
            PG8_WAIT_L(8); PG8_BAR; PG8_WAIT_L(0); PG8_MMA(0, 0, At, B0); PG8_BAR; PG8_SCHED;
            PG8_LDB(B1, 1, 1); PG8_STAGE(PG8_SB(1, 0), b3, voffB);
            PG8_BAR; PG8_WAIT_L(0); PG8_MMA(0, 1, At, B1); PG8_BAR;
            PG8_LDA(At, 1, 1); PG8_STAGE_A(1, 0, a3, a3, s0);
            PG8_BAR; PG8_WAIT_L(0); PG8_MMA(1, 0, At, B0); PG8_BAR; PG8_SCHED;
            PG8_STAGE(PG8_SB(1, 1), b3 + hstepB, voffB);
            PG8_WAIT_V(6); PG8_BAR; PG8_MMA(1, 1, At, B1); PG8_BAR;
#endif
        }
#if PG8_ALIGN_EPI
        if (wr == 0) PG8_BAR;
#endif
        if constexpr (Epi::FP8) asm volatile("s_nop 15\n\ts_nop 15" ::: "memory");
        { int t_ = tid; asm volatile("" : "+v"(t_)); const int fr_ = t_ & 15, fq_ = (t_ >> 4) & 3;
          E(acc, cur, wr, wc, fr_, fq_); }
        if (!has_next) break;
        bool keep_acc = false; if constexpr (Epi::CHAIN) keep_acc = E.keep(cur);
        if (!keep_acc) {
#pragma unroll
        for (int a = 0; a < 2; ++a)
#pragma unroll
            for (int b = 0; b < 2; ++b)
#pragma unroll
                for (int m = 0; m < 4; ++m)
#pragma unroll
                    for (int n = 0; n < 2; ++n) acc[a][b][m][n] = (f32x4){0.f, 0.f, 0.f, 0.f};
        }
        cur = nxt; cA = nA; cB = nB; ++ui;
        if constexpr (Sched::GATHER) { gA0 = nG0; gA1 = nG1; }
#if PG8_ALIGN_EPI
        if (wr == 1) PG8_BAR;
#endif
    }
    PG8_WAIT_V(0);
#if !PG8_ALIGN_EPI
    if (wr == 0) PG8_BAR;
#endif
    PG8_BAR;
#undef PG8_SA
#undef PG8_SB
#undef PG8_STAGE
#undef PG8_STAGE_A
#undef PG8_LDA
#undef PG8_LDB
#undef PG8_MMA
#undef PG8_WAIT_V
#undef PG8_WAIT_L
#undef PG8_BAR
#undef PG8_SCHED
}

struct SchedPlain {
    static constexpr bool GATHER = false;
    TileOrder T; const char* A; const char* B; size_t atile, btile; int pn0;
    __device__ __forceinline__ bool next(int i, Unit& u) const { if (!T.tile(i, u.pm, u.pn)) return false; u.a = A + (size_t)u.pm * atile; u.b = B + (size_t)u.pn * btile; u.pn += pn0; u.aux = 0; return true; }
};
struct SchedMerge {
    static constexpr bool GATHER = false;
    TileOrder T; const char* Q; const char* C; const char* W;
    __device__ __forceinline__ bool next(int i, Unit& u) const { const int k = i % 3; if (!T.tile(i / 3, u.pm, u.pn)) return false;
        u.a = (k < 2 ? Q + (size_t)(512 * k) * 2 : C) + (size_t)u.pm * 256 * QW * 2; u.b = W + ((size_t)(k * 1024 + u.pn * 256) * 512) * 2; u.aux = k; return true; }
};
struct SchedMergeOne {
    static constexpr bool GATHER = false;
    int pm, pn; const char* Q; const char* C; const char* W;
    __device__ __forceinline__ bool next(int i, Unit& u) const { if (i >= 3) return false; const int k = i; u.pm = pm; u.pn = pn;
        u.a = (k < 2 ? Q + (size_t)(512 * k) * 2 : C) + (size_t)u.pm * 256 * QW * 2; u.b = W + ((size_t)(k * 1024 + u.pn * 256) * 512) * 2; u.aux = k; return true; }
};
struct SchedPlainOne {
    static constexpr bool GATHER = false;
    int pm, pn, pn0; const char* A; const char* B; size_t atile, btile;
    __device__ __forceinline__ bool next(int i, Unit& u) const { if (i >= 1) return false; u.pm = pm; u.pn = pn; u.a = A + (size_t)pm * atile; u.b = B + (size_t)(pn - pn0) * btile; u.aux = 0; return true; }
};
template <bool GATHER_> struct SchedMoE {
    static constexpr bool GATHER = GATHER_;
    int G, v, nN, has_ctx; const char* A; const char* W; size_t wexp; const int* idx; int rb;
    __device__ __forceinline__ bool next(int i, Unit& u) const {
        const int L = i * G + v, per = 4 * nN, nlat = 64 * per; int tm, e, pn;
        if (L < nlat) { const int g = L / per, r = L % per; tm = g * 4 + r / nN; pn = r % nN; e = g & 15; }
        else { const int L2 = L - nlat; if (!has_ctx || L2 >= 16 * nN) return false; e = L2 / nN; pn = L2 % nN; tm = 256 + e; }
        u.a = GATHER_ ? A : A + (size_t)tm * 256 * rb; u.b = W + (size_t)e * wexp + (size_t)pn * 256 * rb; u.pm = tm; u.pn = pn; u.aux = e; return true;
    }
    __device__ __forceinline__ unsigned srcrow(int tm, int j) const {
        const bool latent = tm < 256; const int e = tm - 256, b = (j >> 5) & 3, sl = j & 31;
        const int ix = latent ? tm * 256 + j : MOE_ROWS_LAT + (b * NE + e) * CAPC + sl;
        const int base = latent ? (tm >> 6) * SEQ : ML + b * CTX;
        const int v = idx[ix];
        return (latent || j < 128) ? (unsigned)(base + v) : 0u;
    }
    __device__ __forceinline__ unsigned rowbytes() const { return (unsigned)rb; }
    __device__ __forceinline__ void rows(const Unit& u, const int tid, unsigned& p0, unsigned& p1) const {
        int t_ = tid; asm volatile("" : "+v"(t_)); int r0, r1, c_; stage_rc(t_ * 16, r0, c_); stage_rc(t_ * 16 + 8192, r1, c_);
        p0 = srcrow(u.pm, r0) | (srcrow(u.pm, r1) << 16); p1 = srcrow(u.pm, 128 + r0) | (srcrow(u.pm, 128 + r1) << 16);
    }
};

__device__ __forceinline__ unsigned pack4_fp8(float a, float b, float c, float d) {
    unsigned w; asm("v_cvt_pk_fp8_f32 %0, %1, %2" : "=v"(w) : "v"(a), "v"(b)); asm("v_cvt_pk_fp8_f32 %0, %1, %2 op_sel:[0,0,1]" : "+v"(w) : "v"(c), "v"(d)); return w; }
constexpr float WSCALE = 32.0f, WDESCALE = 1.0f / 32.0f;
#ifndef EPI_NT
#define EPI_NT 1
#endif
#if EPI_NT
#define EPI_ST16(p, v) __builtin_nontemporal_store((v), (u32x4*)(p))
#else
#define EPI_ST16(p, v) (*(u32x4*)(p) = (v))
#endif
struct EpiInProj {
    static constexpr bool PERM = true, CHAIN = false, FP8 = false;
    bf16_t* W0;
    const float* gains;
    const float* rope;
    __device__ __forceinline__ void operator()(f32x4 (&acc)[2][2][4][2], const Unit& u, int wr, int wc, int fr, int fq) const {
        if (u.pn < 6) {
            const int hg = u.pn * 4 + wc;
            const bool isv = (hg < 8) && ((hg & 2) != 0), isq = hg >= 8, lat = u.pm < 128;
            const int b = lat ? (u.pm >> 5) : (u.pm - 128);
            const int gsel = (hg < 8) ? ((hg & 4) ? 1 : 0) : (hg < 16 ? 2 : 3);
            const float* gp = gains + gsel * 64 + 8 * fq;
            const f32x4 g1a = *(const f32x4*)gp, g1b = *(const f32x4*)(gp + 4), g2a = *(const f32x4*)(gp + 32), g2b = *(const f32x4*)(gp + 36);
            float frq[8];
            { const f32x4 fa = *(const f32x4*)(rope + 8 * (fq & 1)), fb = *(const f32x4*)(rope + 8 * (fq & 1) + 4); frq[0] = fa[0]; frq[1] = fa[1]; frq[2] = fa[2]; frq[3] = fa[3]; frq[4] = fb[0]; frq[5] = fb[1]; frq[6] = fb[2]; frq[7] = fb[3]; }
            bf16_t* dbase; size_t dpitch; int prow0;
            if (isq) { dbase = W0 + WS_QKV / 2 + OFF_QA + (hg - 8) * 64 + 8 * fq; dpitch = QW; prow0 = u.pm * BM; }
            else { const size_t off = (hg & 4) ? (isv ? WS_VTB : WS_KB) : (isv ? WS_VTA : WS_KA);
                dbase = W0 + off / 2 + (size_t)(b * 2 + (hg & 1)) * KVROWS * 64 + 8 * fq; dpitch = 64; prow0 = lat ? (u.pm & 31) * BM : SEQ; }
#pragma unroll
            for (int ai = 0; ai < 2; ++ai)
#pragma unroll
                for (int m = 0; m < 4; ++m) {
                    const int rt = ai * HALF + wr * 64 + m * 16 + fr;
                    float x1[8], x2[8];
#pragma unroll
                    for (int e = 0; e < 4; ++e) { x1[e] = acc[ai][0][m][0][e]; x1[4 + e] = acc[ai][0][m][1][e]; x2[e] = acc[ai][1][m][0][e]; x2[4 + e] = acc[ai][1][m][1][e]; }
                    if (!isv) {
                        float ss = 0.f;
#pragma unroll
                        for (int e = 0; e < 8; ++e) ss += x1[e] * x1[e] + x2[e] * x2[e];
                        ss += __shfl_xor(ss, 16); ss += __shfl_xor(ss, 32);
                        const float rinv = 1.0f / sqrtf(ss * (1.0f / 64.0f) + EPS);
#pragma unroll
                        for (int e = 0; e < 4; ++e) { x1[e] *= rinv * g1a[e]; x1[4 + e] *= rinv * g1b[e]; x2[e] *= rinv * g2a[e]; x2[4 + e] *= rinv * g2b[e]; }
                        if (lat) {
                            const int rowpos = 4 * (u.pm & 31) + 2 * ai + wr, colpos = 16 * m + fr;
                            const float posf = (float)((fq < 2) ? rowpos : colpos);
#pragma unroll
                            for (int e = 0; e < 8; ++e) { const float ang = posf * frq[e];
                                const float rev = ang * 0.15915494309189535f, cse = __builtin_amdgcn_cosf(rev), sne = __builtin_amdgcn_sinf(rev);
                                const float a1 = x1[e], a2 = x2[e]; x1[e] = a1 * cse - a2 * sne; x2[e] = a2 * cse + a1 * sne; }
                        }
                        if (isq) {
#pragma unroll
                            for (int e = 0; e < 8; ++e) { x1[e] *= QSCALE; x2[e] *= QSCALE; }
                        }
                    }
                    u32x4 w1, w2; w1.x = cvt_pk_bf16(x1[0], x1[1]); w1.y = cvt_pk_bf16(x1[2], x1[3]); w1.z = cvt_pk_bf16(x1[4], x1[5]); w1.w = cvt_pk_bf16(x1[6], x1[7]);
                    w2.x = cvt_pk_bf16(x2[0], x2[1]); w2.y = cvt_pk_bf16(x2[2], x2[3]); w2.z = cvt_pk_bf16(x2[4], x2[5]); w2.w = cvt_pk_bf16(x2[6], x2[7]);
                    bf16_t* dp = dbase + (size_t)(prow0 + rt) * dpitch;
                    *(u32x4*)dp = w1; *(u32x4*)(dp + 32) = w2;
                }
            return;
        }
        if (u.pn >= 8 && u.pn < 12) {
            const int row0 = u.pm * BM + wr * 64 + fr, col0 = 512 + (u.pn - 8) * HALF + wc * 32 + 8 * fq;
#pragma unroll
            for (int ai = 0; ai < 2; ++ai)
#pragma unroll
                for (int m = 0; m < 4; ++m) { const f32x4 c0 = acc[ai][0][m][0], c1 = acc[ai][0][m][1], x0 = acc[ai][1][m][0], x1v = acc[ai][1][m][1];
                    u32x4 w; w.x = cvt_pk_bf16(c0[0] * x0[0], c0[1] * x0[1]); w.y = cvt_pk_bf16(c0[2] * x0[2], c0[3] * x0[3]); w.z = cvt_pk_bf16(c1[0] * x1v[0], c1[1] * x1v[1]); w.w = cvt_pk_bf16(c1[2] * x1v[2], c1[3] * x1v[3]);
                    EPI_ST16(W0 + WS_CONV / 2 + (size_t)(row0 + ai * HALF + m * 16) * QW + col0, w); }
            return;
        }
        const int pnl = u.pn - 6;
        const int row0 = u.pm * BM + wr * 64 + fr, col0 = pnl * BM + wc * 32 + 8 * fq;
        bf16_t* const cbase = W0 + WS_CONV / 2;
#pragma unroll
        for (int ai = 0; ai < 2; ++ai)
#pragma unroll
            for (int m = 0; m < 4; ++m) { bf16_t* rowp = cbase + (size_t)(row0 + ai * HALF + m * 16) * QW + col0;
#pragma unroll
                for (int bj = 0; bj < 2; ++bj) { const f32x4 v0 = acc[ai][bj][m][0], v1 = acc[ai][bj][m][1];
                    u32x4 w; w.x = cvt_pk_bf16(v0[0], v0[1]); w.y = cvt_pk_bf16(v0[2], v0[3]); w.z = cvt_pk_bf16(v1[0], v1[1]); w.w = cvt_pk_bf16(v1[2], v1[3]);
                    EPI_ST16(rowp + bj * HALF, w); } }
    }
};
struct EpiInProjGate {
    static constexpr bool PERM = true, CHAIN = false, FP8 = true;
    bf16_t* W0;
    __device__ __forceinline__ void operator()(f32x4 (&acc)[2][2][4][2], const Unit& u, int wr, int wc, int fr, int fq) const {
        unsigned char* const gt8 = (unsigned char*)W0 + WS_GATE + ((size_t)(u.pm * 12 + (u.pn - 12)) << 16) + (size_t)(((wr * 4 + wc) * 64) + fq * 16 + fr) * 16;
#pragma unroll
        for (int ai = 0; ai < 2; ++ai)
#pragma unroll
            for (int m = 0; m < 4; ++m) { unsigned qb[4];
#pragma unroll
                for (int bj = 0; bj < 2; ++bj)
#pragma unroll
                    for (int n = 0; n < 2; ++n) { unsigned wv = 0u;
#pragma unroll
                        for (int j = 0; j < 4; ++j) { const float sg = fast_sigmoid(acc[ai][bj][m][n][j] * WDESCALE); const unsigned q = (unsigned)__builtin_amdgcn_fmed3f(sg * 256.0f, 0.0f, 255.0f); wv |= q << (8 * j); }
                        qb[bj * 2 + n] = wv; }
                EPI_ST16(gt8 + (size_t)((ai * 4 + m) * 512) * 16, ((u32x4){qb[0], qb[1], qb[2], qb[3]})); }
    }
};
struct EpiMerge {
    static constexpr bool PERM = true, CHAIN = true, FP8 = false;
    const unsigned char* Gt; bf16_t* Mg;
    __device__ __forceinline__ bool keep(const Unit& u) const { return u.aux < 2; }
    __device__ __forceinline__ void operator()(f32x4 (&acc)[2][2][4][2], const Unit& u, int wr, int wc, int fr, int fq) const {
        const int row0 = u.pm * BM + wr * 64 + fr, col0 = u.pn * BM + wc * 32 + 8 * fq; const int k = u.aux;
        const unsigned char* const gt8 = Gt + ((size_t)(u.pm * 12 + 4 * k + u.pn) << 16) + (size_t)(((wr * 4 + wc) * 64) + fq * 16 + fr) * 16;
        u32x4 g[2][4], q[2][4];
#pragma unroll
        for (int ai = 0; ai < 2; ++ai)
#pragma unroll
            for (int m = 0; m < 4; ++m) { const unsigned char* gp = gt8 + (size_t)((ai * 4 + m) * 512) * 16;
                g[ai][m] = *(const u32x4*)gp; if (k < 2) q[ai][m] = *(const u32x4*)(gp + ((size_t)4 << 16)); }
        asm volatile("" ::: "memory");
#pragma unroll
        for (int ai = 0; ai < 2; ++ai)
#pragma unroll
            for (int m = 0; m < 4; ++m)
#pragma unroll
                for (int bj = 0; bj < 2; ++bj) {
                    const unsigned g0w = bj ? g[ai][m].z : g[ai][m].x, g1w = bj ? g[ai][m].w : g[ai][m].y;
                    float gk[8];
#pragma unroll
                    for (int j = 0; j < 4; ++j) { gk[j] = ((float)((g0w >> (8 * j)) & 255u) + 0.5f) * (1.0f / 256.0f); gk[4 + j] = ((float)((g1w >> (8 * j)) & 255u) + 0.5f) * (1.0f / 256.0f); }
                    if (k < 2) {
                        const unsigned q0w = bj ? q[ai][m].z : q[ai][m].x, q1w = bj ? q[ai][m].w : q[ai][m].y;
#pragma unroll
                        for (int j = 0; j < 4; ++j) { const float d0 = (float)((q0w >> (8 * j)) & 255u) + 0.5f, d1 = (float)((q1w >> (8 * j)) & 255u) + 0.5f;
                            acc[ai][bj][m][0][j] *= (gk[j] * 256.0f) * __builtin_amdgcn_rcpf(d0); acc[ai][bj][m][1][j] *= (gk[4 + j] * 256.0f) * __builtin_amdgcn_rcpf(d1); }
                    } else {
                        const f32x4 v0 = acc[ai][bj][m][0], v1 = acc[ai][bj][m][1];
                        u32x4 w; w.x = cvt_pk_bf16(v0[0] * gk[0], v0[1] * gk[1]); w.y = cvt_pk_bf16(v0[2] * gk[2], v0[3] * gk[3]); w.z = cvt_pk_bf16(v1[0] * gk[4], v1[1] * gk[5]); w.w = cvt_pk_bf16(v1[2] * gk[6], v1[3] * gk[7]);
                        *(u32x4*)(Mg + (size_t)(row0 + ai * HALF + m * 16) * D + col0 + bj * HALF) = w;
                    }
                }
    }
};
struct EpiOut {
    static constexpr bool PERM = true, CHAIN = false, FP8 = false;
    bf16_t* Dl; const float* modl;
    __device__ __forceinline__ void operator()(f32x4 (&acc)[2][2][4][2], const Unit& u, int wr, int wc, int fr, int fq) const {
        const int mr = (u.pm < 128) ? (u.pm >> 5) : 4;
        const float* gt = modl + mr * PW + 2 * D;
        const int row0 = u.pm * BM + wr * 64 + fr, col0 = u.pn * BM + wc * 32 + 8 * fq;
        f32x4 gv[2][2];
#pragma unroll
        for (int bj = 0; bj < 2; ++bj)
#pragma unroll
            for (int n = 0; n < 2; ++n) gv[bj][n] = *(const f32x4*)(gt + col0 + bj * HALF + 4 * n);
#pragma unroll
        for (int ai = 0; ai < 2; ++ai)
#pragma unroll
            for (int m = 0; m < 4; ++m) { bf16_t* rowp = Dl + (size_t)(row0 + ai * HALF + m * 16) * D + col0;
#pragma unroll
                for (int bj = 0; bj < 2; ++bj) { const f32x4 v0 = acc[ai][bj][m][0] * gv[bj][0], v1 = acc[ai][bj][m][1] * gv[bj][1];
                    u32x4 w; w.x = cvt_pk_bf16(v0[0], v0[1]); w.y = cvt_pk_bf16(v0[2], v0[3]); w.z = cvt_pk_bf16(v1[0], v1[1]); w.w = cvt_pk_bf16(v1[2], v1[3]);
                    *(u32x4*)(rowp + bj * HALF) = w; } }
    }
};
struct EpiGU {
    static constexpr bool PERM = true, CHAIN = false, FP8 = true;
    unsigned char* Hd;
    __device__ __forceinline__ void operator()(f32x4 (&acc)[2][2][4][2], const Unit& u, int wr, int wc, int fr, int fq) const {
        const int row0 = u.pm * BM + wr * 64 + fr, col0 = u.pn * HALF + wc * 32 + 8 * fq;
#pragma unroll
        for (int ai = 0; ai < 2; ++ai)
#pragma unroll
            for (int m = 0; m < 4; ++m) { unsigned char* rowp = Hd + (size_t)(row0 + ai * HALF + m * 16) * EH + col0;
                float o[8];
#pragma unroll
                for (int n = 0; n < 2; ++n)
#pragma unroll
                    for (int j = 0; j < 4; ++j) { const float a = acc[ai][0][m][n][j] * WDESCALE, uu = acc[ai][1][m][n][j] * WDESCALE; o[4 * n + j] = a * fast_sigmoid(a) * uu; }
                u32x2 w; w.x = pack4_fp8(o[0], o[1], o[2], o[3]); w.y = pack4_fp8(o[4], o[5], o[6], o[7]);
                __builtin_nontemporal_store(w, (u32x2*)rowp); }
    }
};
struct EpiDown {
    static constexpr bool PERM = true, CHAIN = false, FP8 = true;
    bf16_t* Y;
    __device__ __forceinline__ void operator()(f32x4 (&acc)[2][2][4][2], const Unit& u, int wr, int wc, int fr, int fq) const {
        const int row0 = u.pm * BM + wr * 64 + fr, col0 = u.pn * BM + wc * 32 + 8 * fq;
#pragma unroll
        for (int ai = 0; ai < 2; ++ai)
#pragma unroll
            for (int m = 0; m < 4; ++m) { bf16_t* rowp = Y + (size_t)(row0 + ai * HALF + m * 16) * D + col0;
#pragma unroll
                for (int bj = 0; bj < 2; ++bj) { const f32x4 v0 = acc[ai][bj][m][0] * WDESCALE, v1 = acc[ai][bj][m][1] * WDESCALE;
                    u32x4 w; w.x = cvt_pk_bf16(v0[0], v0[1]); w.y = cvt_pk_bf16(v0[2], v0[3]); w.z = cvt_pk_bf16(v1[0], v1[1]); w.w = cvt_pk_bf16(v1[2], v1[3]);
                    EPI_ST16(rowp + bj * HALF, w); } }
    }
};
}

namespace ab {
using bf16=__hip_bfloat16;
using bf16x8=__attribute__((ext_vector_type(8)))short;
using s16x4=__attribute__((ext_vector_type(4)))short;
using f32x16=__attribute__((ext_vector_type(16)))float;
using u32x4=__attribute__((ext_vector_type(4)))unsigned;
constexpr int D=64, QP=1024, KP=64;
constexpr int NW=8,QBLK=32,QB=QBLK*NW,KVBLK=64;
__device__ __forceinline__ int crow(int r,int hi){return (r&3)+8*(r>>2)+4*hi;}
#define SBAR() __builtin_amdgcn_sched_barrier(0)
constexpr int NSLOT=3, SLOTB=8192;
constexpr int LDS_K=0, LDS_V=NSLOT*SLOTB, LDS_WS=2*NSLOT*SLOTB, LDS_OST=LDS_WS+NW*64*4, LDS_BYTES=LDS_OST+NW*4096;
constexpr float C2=0.125f*1.4426950408889634f;
__device__ __forceinline__ void glds16(const void*gsrc,unsigned lds_dst){unsigned keep;
  asm volatile("s_mov_b32 %0, m0\n\ts_mov_b32 m0, %2\n\ts_nop 0\n\tglobal_load_lds_dwordx4 %1, off\n\ts_mov_b32 m0, %0":"=&s"(keep):"v"(gsrc),"s"(lds_dst):"memory");}
__device__ __forceinline__ float max3f(float a,float b,float c){float r;asm("v_max3_f32 %0, %1, %2, %3":"=v"(r):"v"(a),"v"(b),"v"(c));return r;}
__device__ __forceinline__ float max2f(float a,float b){float r;asm("v_max_f32_e32 %0, %1, %2":"=v"(r):"v"(a),"v"(b));return r;}
__device__ __forceinline__ float fadd_s(float a,float b){float r;asm("v_add_f32_e32 %0, %1, %2":"=v"(r):"v"(a),"v"(b));return r;}
__device__ __forceinline__ float fsub_s(float a,float b){float r;asm("v_sub_f32_e32 %0, %1, %2":"=v"(r):"v"(a),"v"(b));return r;}
typedef float f32x2_t __attribute__((ext_vector_type(2))); typedef __bf16 bf16x2_t __attribute__((ext_vector_type(2)));
__device__ __forceinline__ unsigned cvtpk_s(float lo,float hi){f32x2_t v={lo,hi};bf16x2_t b=__builtin_convertvector(v,bf16x2_t);return __builtin_bit_cast(unsigned,b);}
#define WAIT_BAR(N) asm volatile("s_waitcnt vmcnt(" #N ") lgkmcnt(0)\n\ts_barrier":::"memory")

__device__ __forceinline__ void qkt(f32x16&p0,f32x16&p1,const char*Kslot,const bf16x8*qr,const f32x16&negm,int r32,int hi){
  const char*kb=Kslot+hi*1024+r32*16;
  #pragma unroll
  for(int d0=0;d0<4;++d0){
    const bf16x8 b0=*reinterpret_cast<const bf16x8*>(kb+d0*2048);
    const bf16x8 b1=*reinterpret_cast<const bf16x8*>(kb+d0*2048+512);
    if(d0==0){p0=__builtin_amdgcn_mfma_f32_32x32x16_bf16(b0,qr[0],negm,0,0,0);p1=__builtin_amdgcn_mfma_f32_32x32x16_bf16(b1,qr[0],negm,0,0,0);}
    else{p0=__builtin_amdgcn_mfma_f32_32x32x16_bf16(b0,qr[d0],p0,0,0,0);p1=__builtin_amdgcn_mfma_f32_32x32x16_bf16(b1,qr[d0],p1,0,0,0);}}
}
typedef __attribute__((address_space(3))) const char* lds_cptr;
typedef short v4i16_t __attribute__((ext_vector_type(4)));
__device__ __forceinline__ void kload8(bf16x8*kf,lds_cptr kp){
  kf[0]=*(const __attribute__((address_space(3))) bf16x8*)(kp);      kf[1]=*(const __attribute__((address_space(3))) bf16x8*)(kp+512);
  kf[2]=*(const __attribute__((address_space(3))) bf16x8*)(kp+2048); kf[3]=*(const __attribute__((address_space(3))) bf16x8*)(kp+2560);
  kf[4]=*(const __attribute__((address_space(3))) bf16x8*)(kp+4096); kf[5]=*(const __attribute__((address_space(3))) bf16x8*)(kp+4608);
  kf[6]=*(const __attribute__((address_space(3))) bf16x8*)(kp+6144); kf[7]=*(const __attribute__((address_space(3))) bf16x8*)(kp+6656);
}
__device__ __forceinline__ void kload2(bf16x8*kf,lds_cptr kp,int j){ kf[2*j]=*(const __attribute__((address_space(3))) bf16x8*)(kp+j*2048); kf[2*j+1]=*(const __attribute__((address_space(3))) bf16x8*)(kp+j*2048+512); }
__device__ __forceinline__ s16x4 vtr(lds_cptr p){ return __builtin_bit_cast(s16x4,__builtin_amdgcn_ds_read_tr16_b64_v4i16((__attribute__((address_space(3))) v4i16_t*)p)); }
__device__ __forceinline__ float rowmax(const f32x16&p0,const f32x16&p1){
  float a=max3f(p0[0],p0[1],p1[0]),b=max3f(p0[2],p0[3],p1[1]);a=max3f(a,p1[2],p1[3]);
  #pragma unroll
  for(int r=4;r<16;r+=4){a=max3f(a,p0[r],p0[r+1]);b=max3f(b,p0[r+2],p0[r+3]);a=max3f(a,p1[r],p1[r+1]);b=max3f(b,p1[r+2],p1[r+3]);}
  const float m=max2f(a,b);
  auto rr=__builtin_amdgcn_permlane32_swap(__float_as_uint(m),__float_as_uint(m),false,false);
  return max2f(__uint_as_float(rr[0]),__uint_as_float(rr[1]));
}
__device__ __forceinline__ void pv(f32x16*o,int vb,bf16x8 pa0,bf16x8 pa1,bf16x8 pa2,bf16x8 pa3){
  #pragma unroll
  for(int d0=0;d0<2;++d0){s16x4 lo[4],hi[4];
    #pragma unroll
    for(int ks=0;ks<4;++ks){
      asm volatile("ds_read_b64_tr_b16 %0,%1 offset:%c2":"=&v"(lo[ks]):"v"(vb),"i"(d0*4096+ks*1024):"memory");
      asm volatile("ds_read_b64_tr_b16 %0,%1 offset:%c2":"=&v"(hi[ks]):"v"(vb),"i"(d0*4096+ks*1024+512):"memory");}
    asm volatile("s_waitcnt lgkmcnt(0)":::"memory");SBAR();
    #define PK(k) (bf16x8){lo[k][0],lo[k][1],lo[k][2],lo[k][3],hi[k][0],hi[k][1],hi[k][2],hi[k][3]}
    o[d0]=__builtin_amdgcn_mfma_f32_32x32x16_bf16(pa0,PK(0),o[d0],0,0,0);
    o[d0]=__builtin_amdgcn_mfma_f32_32x32x16_bf16(pa1,PK(1),o[d0],0,0,0);
    o[d0]=__builtin_amdgcn_mfma_f32_32x32x16_bf16(pa2,PK(2),o[d0],0,0,0);
    o[d0]=__builtin_amdgcn_mfma_f32_32x32x16_bf16(pa3,PK(3),o[d0],0,0,0);
    #undef PK
  }
}

#ifndef ATTN_STORE16
#define ATTN_STORE16(p,v) (*(u32x4*)(p)=(v))
#endif
template<int THRL,bool WIN,bool HAS_SINK,bool NOMAX> __device__ __forceinline__ void attn_unit(const bf16*Qu,const bf16*__restrict__ Kh,const bf16*__restrict__ Vh,bf16*Ou,const int NT,char*shm,const int tid_in,const int lo,const int q0,const float sink2,const float mfix){
  int tid_o=tid_in; asm volatile("":"+v"(tid_o)); const int tid=tid_o;
  const int lane=tid&63,r32=lane&31,hi=lane>>5; const int wid=__builtin_amdgcn_readfirstlane(tid>>6);
  const bf16*Qw=Qu+(long)(wid*QBLK)*QP;
  const unsigned lds0=(unsigned)(uintptr_t)shm;
  float*wsf=(float*)(shm+LDS_WS)+wid*64;
  const bf16*ksrc=Kh+(long)lane*KP+wid*8;
  const bf16*vsrc=Vh+(long)(16*(wid&3)+(lane>>2))*KP+(wid>>2)*32+(lane&3)*8;
  const unsigned kdst=lds0+LDS_K+wid*1024, vdst=lds0+LDS_V+wid*1024;
  #define KVROW(t) (WIN ? (((t)<4) ? (long)(::SEQ+64*(t)) : (long)(64*(lo-4+(t)))) : (long)(t)*KVBLK)
  #define DMA_K(t,slot) glds16(ksrc+KVROW(t)*KP,(unsigned)__builtin_amdgcn_readfirstlane(kdst+(slot)))
  #define DMA_V(t,slot) glds16(vsrc+KVROW(t)*KP,(unsigned)__builtin_amdgcn_readfirstlane(vdst+(slot)))
  const int vb0=(int)(lds0+LDS_V)+((lane>>4)&1)*32+(lane&3)*8+(4*hi+((lane&15)>>2))*64;
  const char*Kbase=shm+LDS_K; bf16x8 kf[8];
  const lds_cptr shm3=(lds_cptr)shm; const lds_cptr kp0=shm3+LDS_K+hi*1024+r32*16; const lds_cptr vp0=shm3+LDS_V+((lane>>4)&1)*32+(lane&3)*8+(4*hi+((lane&15)>>2))*64;
  DMA_K(0,0);DMA_V(0,0);DMA_K(1,SLOTB);
  bf16x8 qr[4];
  #pragma unroll
  for(int d0=0;d0<4;++d0)qr[d0]=*reinterpret_cast<const bf16x8*>(&Qw[(long)r32*QP+d0*16+hi*8]);
  float mhat=NOMAX?mfix:0.f,l_reg=0.f;f32x16 o[2];o[0]=f32x16{};o[1]=f32x16{};f32x16 negm=f32x16{};
  if constexpr(NOMAX){ _Pragma("unroll") for(int r=0;r<16;++r)negm[r]=-mfix; }
  asm volatile("":"+v"(negm));
  const int qpos_=q0+wid*QBLK+r32;
  #define CMASK(P0,P1,t) do{ if(WIN && (t)>=4){ const int d0_=64*(lo-4+(t))+4*hi-qpos_; \
      _Pragma("unroll") for(int r=0;r<16;++r){ const int d_=d0_+(r&3)+8*(r>>2); if(d_>128||d_<-128)P0[r]=-INFINITY; if(d_+32>128||d_+32<-128)P1[r]=-INFINITY; } } }while(0)
  bool resc=false;
  #define START(P0,P1) do{ resc=false; if constexpr(!NOMAX) { const float rm=rowmax(P0,P1); \
      const float dl=rm; mhat=fadd_s(mhat,dl); \
      _Pragma("unroll") for(int r=0;r<16;++r){P0[r]=fsub_s(P0[r],dl);P1[r]=fsub_s(P1[r],dl);} \
      _Pragma("unroll") for(int r=0;r<16;++r)negm[r]=-mhat; asm volatile("":"+v"(negm)); } \
    _Pragma("unroll") for(int r=0;r<16;++r)P0[r]=__builtin_amdgcn_exp2f(P0[r]); }while(0)
  #define RESC() do{ if(resc){ asm volatile("s_waitcnt lgkmcnt(0)":::"memory"); \
      _Pragma("unroll") for(int d_=0;d_<2;++d_) _Pragma("unroll") for(int r=0;r<16;++r)o[d_][r]*=wsf[crow(r,hi)]; } }while(0)
  f32x16 pA0,pA1,pB0,pB1;
  int sl_prev=0,sl_cur=0,sl_next=SLOTB;
  #define ROT() do{sl_prev=sl_cur;sl_cur=sl_next;sl_next=(sl_next==(NSLOT-1)*SLOTB)?0:sl_next+SLOTB;}while(0)
  DMA_K(2,2*SLOTB);
  WAIT_BAR(3);
  qkt(pA0,pA1,Kbase,qr,negm,r32,hi);asm volatile("s_nop 15\n\ts_nop 7":"+v"(pA0),"+v"(pA1));CMASK(pA0,pA1,0);
  START(pA0,pA1);
  _Pragma("unroll") for(int r=0;r<16;++r)pA1[r]=__builtin_amdgcn_exp2f(pA1[r]);
  WAIT_BAR(0);
  DMA_K(3,0);DMA_V(1,SLOTB);
  ROT();
  kload8(kf,kp0+sl_cur);
  WAIT_BAR(2);
  s16x4 vlo[8],vhi[8]; u32x4 pw0,pw1,pw2,pw3;
  #define PKW(P,B) cvtpk_s(P[B],P[B+1])
  #define PAF(k) __builtin_bit_cast(bf16x8,pw##k)
  #define VFR(i) (bf16x8){vlo[i][0],vlo[i][1],vlo[i][2],vlo[i][3],vhi[i][0],vhi[i][1],vhi[i][2],vhi[i][3]}
  #define PIN(x) asm volatile("":"+v"(x))
  #define MX3(a,b,c) __builtin_fmaxf(__builtin_fmaxf((a),(b)),(c))
  #define GAPA(MF,A0,A1,A2,A3,W0,W1,PW) do{ MF; sacc+=A0; sacc+=A1; sacc+=A2; sacc+=A3; PIN(sacc); W0; W1; PIN(PW); SBAR(); }while(0)
  #define EX(v) __builtin_amdgcn_exp2f(v)
  #define GAPB(MF,X,B) do{ MF; X[B]=EX(X[B]); X[B+1]=EX(X[B+1]); X[B+2]=EX(X[B+2]); X[B+3]=EX(X[B+3]); PIN(X); SBAR(); }while(0)
  #define VRD(i) do{ vlo[i]=vtr(vp_+(((i)>>2)*4096+((i)&3)*1024)); vhi[i]=vtr(vp_+(((i)>>2)*4096+((i)&3)*1024+512)); }while(0)
  #define KRD(G,j) do{ if(G){ kload2(kf,kp0+sl_next,j); SBAR(); } }while(0)
  #define STEP(C0,C1,P0,P1,t,GK,GV,GL) do{ SBAR(); \
    const lds_cptr vp_=vp0+sl_prev; \
    VRD(0); SBAR(); float sacc=(P0[0]+P0[1]); \
    GAPA(C0=__builtin_amdgcn_mfma_f32_32x32x16_bf16(kf[0],qr[0],negm,0,0,0), P0[2],P0[3],P0[4],P0[5],     pw0[0]=PKW(P0,0), pw0[1]=PKW(P0,2), pw0); \
    VRD(4); SBAR(); GAPA(C1=__builtin_amdgcn_mfma_f32_32x32x16_bf16(kf[1],qr[0],negm,0,0,0), P0[6],P0[7],P0[8],P0[9],     pw0[2]=PKW(P0,4), pw0[3]=PKW(P0,6), pw0); \
    VRD(1); SBAR(); GAPA(C0=__builtin_amdgcn_mfma_f32_32x32x16_bf16(kf[2],qr[1],C0,0,0,0),   P0[10],P0[11],P0[12],P0[13], pw1[0]=PKW(P0,8), pw1[1]=PKW(P0,10), pw1); \
    VRD(5); SBAR(); GAPA(C1=__builtin_amdgcn_mfma_f32_32x32x16_bf16(kf[3],qr[1],C1,0,0,0),   P0[14],P0[15],P1[0],P1[1],   pw1[2]=PKW(P0,12),pw1[3]=PKW(P0,14), pw1); \
    VRD(2); SBAR(); GAPA(C0=__builtin_amdgcn_mfma_f32_32x32x16_bf16(kf[4],qr[2],C0,0,0,0),   P1[2],P1[3],P1[4],P1[5],     pw2[0]=PKW(P1,0), pw2[1]=PKW(P1,2), pw2); \
    VRD(6); SBAR(); GAPA(C1=__builtin_amdgcn_mfma_f32_32x32x16_bf16(kf[5],qr[2],C1,0,0,0),   P1[6],P1[7],P1[8],P1[9],     pw2[2]=PKW(P1,4), pw2[3]=PKW(P1,6), pw2); \
    VRD(3); SBAR(); GAPA(C0=__builtin_amdgcn_mfma_f32_32x32x16_bf16(kf[6],qr[3],C0,0,0,0),   P1[10],P1[11],P1[12],P1[13], pw3[0]=PKW(P1,8), pw3[1]=PKW(P1,10), pw3); \
    VRD(7); SBAR(); GAPA(C1=__builtin_amdgcn_mfma_f32_32x32x16_bf16(kf[7],qr[3],C1,0,0,0),   P1[14],P1[15],0.f,0.f,       pw3[2]=PKW(P1,12),pw3[3]=PKW(P1,14), pw3); \
    l_reg+=sacc; \
    if(GK){DMA_K((t)+3,sl_cur);} if(GV){DMA_V((t)+1,sl_next);} \
    CMASK(C0,C1,t); \
    if constexpr(NOMAX) { resc=false; if(__builtin_expect(NT<0,0)){ const float dl=1.f; mhat+=dl;   \
        _Pragma("unroll") for(int r=0;r<16;++r){C0[r]-=dl;C1[r]-=dl;} \
        _Pragma("unroll") for(int r=0;r<16;++r)negm[r]=-mhat; asm volatile("":"+v"(negm)); \
        const float f=__builtin_amdgcn_exp2f(-dl); l_reg*=f; if(hi==0)wsf[r32]=f; resc=true; } } \
    if constexpr(!NOMAX) { float a=MX3(C0[0],C0[1],C1[0]),b=MX3(C0[2],C0[3],C1[1]); a=MX3(a,C1[2],C1[3]); \
      _Pragma("unroll") for(int r=4;r<16;r+=4){a=MX3(a,C0[r],C0[r+1]);b=MX3(b,C0[r+2],C0[r+3]);a=MX3(a,C1[r],C1[r+1]);b=MX3(b,C1[r+2],C1[r+3]);} \
      float rm=__builtin_fmaxf(a,b); { auto rr=__builtin_amdgcn_permlane32_swap(__float_as_uint(rm),__float_as_uint(rm),false,false); rm=__builtin_fmaxf(__uint_as_float(rr[0]),__uint_as_float(rr[1])); } \
      resc=false; \
      if(__builtin_expect(__any(rm>(float)THRL),0)){ const float dl=__builtin_fmaxf(rm,0.f); mhat+=dl; \
        _Pragma("unroll") for(int r=0;r<16;++r){C0[r]-=dl;C1[r]-=dl;} \
        _Pragma("unroll") for(int r=0;r<16;++r)negm[r]=-mhat; asm volatile("":"+v"(negm)); \
        const float f=__builtin_amdgcn_exp2f(-dl); l_reg*=f; if(hi==0)wsf[r32]=f; resc=true; } } \
    SBAR(); \
    GAPB(o[0]=__builtin_amdgcn_mfma_f32_32x32x16_bf16(PAF(0),VFR(0),o[0],0,0,0), C0,0); \
    GAPB(o[1]=__builtin_amdgcn_mfma_f32_32x32x16_bf16(PAF(0),VFR(4),o[1],0,0,0), C0,4); \
    KRD(GL,0); GAPB(o[0]=__builtin_amdgcn_mfma_f32_32x32x16_bf16(PAF(1),VFR(1),o[0],0,0,0), C0,8); \
    KRD(GL,1); GAPB(o[1]=__builtin_amdgcn_mfma_f32_32x32x16_bf16(PAF(1),VFR(5),o[1],0,0,0), C0,12); \
    KRD(GL,2); GAPB(o[0]=__builtin_amdgcn_mfma_f32_32x32x16_bf16(PAF(2),VFR(2),o[0],0,0,0), C1,0); \
    KRD(GL,3); GAPB(o[1]=__builtin_amdgcn_mfma_f32_32x32x16_bf16(PAF(2),VFR(6),o[1],0,0,0), C1,4); \
    GAPB(o[0]=__builtin_amdgcn_mfma_f32_32x32x16_bf16(PAF(3),VFR(3),o[0],0,0,0), C1,8); \
    GAPB(o[1]=__builtin_amdgcn_mfma_f32_32x32x16_bf16(PAF(3),VFR(7),o[1],0,0,0), C1,12); \
    }while(0)
  int t=1;
  for(;t+5<NT;t+=2){
    STEP(pB0,pB1,pA0,pA1,t,true,true,true);     WAIT_BAR(2); RESC(); ROT();
    STEP(pA0,pA1,pB0,pB1,t+1,true,true,true);   WAIT_BAR(2); RESC(); ROT();
  }
  #define ENDW(tt) do{ if((tt)+3<NT){WAIT_BAR(2);} else if((tt)+2<NT){WAIT_BAR(1);} else {WAIT_BAR(0);} }while(0)
  for(;t+1<NT;t+=2){
    STEP(pB0,pB1,pA0,pA1,t,(t+3<NT),(t+1<NT),(t+1<NT));       ENDW(t);   RESC(); ROT();
    STEP(pA0,pA1,pB0,pB1,t+1,(t+4<NT),(t+2<NT),(t+2<NT));     ENDW(t+1); RESC(); ROT();
  }
  STEP(pB0,pB1,pA0,pA1,NT-1,false,false,false); RESC();
  { float sacc=pB0[0]+pB0[1]; _Pragma("unroll") for(int r=2;r<16;++r)sacc+=pB0[r]; _Pragma("unroll") for(int r=0;r<16;++r)sacc+=pB1[r]; l_reg+=sacc;
    pw0=(u32x4){PKW(pB0,0),PKW(pB0,2),PKW(pB0,4),PKW(pB0,6)};pw1=(u32x4){PKW(pB0,8),PKW(pB0,10),PKW(pB0,12),PKW(pB0,14)};pw2=(u32x4){PKW(pB1,0),PKW(pB1,2),PKW(pB1,4),PKW(pB1,6)};pw3=(u32x4){PKW(pB1,8),PKW(pB1,10),PKW(pB1,12),PKW(pB1,14)};
    SBAR(); pv(o,vb0+sl_cur,PAF(0),PAF(1),PAF(2),PAF(3)); }
  #undef PKW
  #undef PAF
  #undef VFR
  #undef PIN
  #undef MX3
  #undef GAPA
  #undef GAPB
  #undef EX
  #undef VRD
  #undef KRD
  #undef STEP
  #undef ENDW
  {auto rr=__builtin_amdgcn_permlane32_swap(__float_as_uint(l_reg),__float_as_uint(l_reg),false,false);l_reg=__uint_as_float(rr[0])+__uint_as_float(rr[1]);}
  if(HAS_SINK) l_reg+=__builtin_amdgcn_exp2f(sink2-mhat);
  if(hi==0)wsf[32+r32]=l_reg;asm volatile("s_waitcnt lgkmcnt(0)":::"memory");
  float rli[16];
  #pragma unroll
  for(int r=0;r<16;++r)rli[r]=__builtin_amdgcn_rcpf(wsf[32+crow(r,hi)]);
  bf16*Ow=Ou+(long)(wid*QBLK)*QP;
  { bf16*stg=(bf16*)(shm+LDS_OST)+wid*2048;
    #pragma unroll
    for(int r=0;r<16;++r){const int orow=crow(r,hi);
      #pragma unroll
      for(int d0=0;d0<2;++d0)stg[orow*64+d0*32+r32]=__float2bfloat16(o[d0][r]*rli[r]);}
    asm volatile("s_waitcnt lgkmcnt(0)":::"memory");
    #pragma unroll
    for(int i=0;i<4;++i){const int row=i*8+(lane>>3),ch=lane&7; const u32x4 v=*(const u32x4*)(stg+row*64+ch*8); ATTN_STORE16(Ow+(long)row*QP+ch*8,v);} }
  asm volatile("s_waitcnt lgkmcnt(0)\n\ts_barrier":::"memory");
  #undef DMA_K
  #undef DMA_V
  #undef KVROW
  #undef CMASK
  #undef START
  #undef RESC
  #undef ROT
}
constexpr int ATTN_LDS_BYTES=LDS_BYTES;
#undef SBAR
#undef WAIT_BAR
}

struct Args { const float* in[21]; float* out; unsigned char* ws; int ph_lo, ph_hi; };

constexpr int TAB_OFF = MISC_OFF + 256;
struct Frame {
    LAS unsigned char* lds; int tid, lane, wave, G, bx, vcu, gw, NGW;
    __device__ __forceinline__ unsigned long long tab(int i) const { const u32x2 v = ((const LAS u32x2*)(lds + TAB_OFF))[i];
        const unsigned lo = __builtin_amdgcn_readfirstlane(v.x), hi = __builtin_amdgcn_readfirstlane(v.y); return ((unsigned long long)hi << 32) | lo; }
    __device__ __forceinline__ const float* in(int i) const { return (const float*)(const GAS float*)tab(i); }
    __device__ __forceinline__ unsigned char* wsp(size_t off) const { return (unsigned char*)(GAS unsigned char*)(tab(22) + off); }
#define FIN(name, i) __device__ __forceinline__ const float* name() const { return in(i); }
    FIN(x, 0) FIN(c, 1) FIN(ctx, 2) FIN(c_ctx, 3) FIN(w_ada, 4) FIN(b_ada, 5) FIN(g_mix, 6) FIN(g_ffn, 7) FIN(w_in, 8) FIN(qg_a, 9) FIN(kg_a, 10) FIN(qg_b, 11) FIN(kg_b, 12)
    FIN(sink_b, 13) FIN(conv_w, 14) FIN(w_branch, 15) FIN(w_out, 16) FIN(w_router, 17) FIN(w_eg, 18) FIN(w_eu, 19) FIN(w_ed, 20)
#undef FIN
    __device__ __forceinline__ float* out() const { return (float*)(GAS float*)tab(21); }
#define FWS(type, name, off) __device__ __forceinline__ type* name() const { return (type*)wsp(off); }
    FWS(float, mod, WS_MOD) FWS(float, gains, WS_GAINS) FWS(float, xc, WS_XC) FWS(float, aff, WS_AFF) FWS(float, gatev, WS_GATEV) FWS(int, idx, WS_IDX) FWS(int, inv, WS_INV)
    FWS(bf16_t, WinT, WS_WIN) FWS(bf16_t, WbrT, WS_WBR) FWS(bf16_t, WoutT, WS_WOUT) FWS(bf16_t, H, WS_H) FWS(bf16_t, KA, WS_KA) FWS(bf16_t, KB, WS_KB) FWS(bf16_t, VA, WS_VTA) FWS(bf16_t, VB, WS_VTB)
    FWS(bf16_t, QKV, WS_QKV) FWS(bf16_t, CONV, WS_CONV) FWS(bf16_t, GATE, WS_GATE) FWS(bf16_t, XS, WS_XS) FWS(bf16_t, HID, WS_HID) FWS(bf16_t, WGU, WS_WGU) FWS(bf16_t, WD, WS_WD) FWS(bf16_t, DELTA, WS_DELTA) FWS(unsigned char, H8, WS_H8)
#undef FWS
};

__device__ __forceinline__ void transpose_item(const float* W, int K, int N, bf16_t* WT, int k0, int n0, int drow0, LAS float* scr, int lane) {
    float tv[32];
#pragma unroll
    for (int i = 0; i < 32; ++i) tv[i] = W[(size_t)(k0 + 2 * i + (lane >> 5)) * N + n0 + (lane & 31)];
#pragma unroll
    for (int i = 0; i < 32; ++i) scr[(2 * i + (lane >> 5)) * 33 + (lane & 31)] = tv[i];
    LDS_WAIT(); asm volatile("" ::: "memory");
    const int c = lane & 7;
#pragma unroll
    for (int j = 0; j < 4; ++j) { const int n = (lane >> 3) + 8 * j; const LAS float* s = scr + (8 * c) * 33 + n;
        u32x4 o; o.x = cvt_pk_bf16(s[0 * 33], s[1 * 33]); o.y = cvt_pk_bf16(s[2 * 33], s[3 * 33]); o.z = cvt_pk_bf16(s[4 * 33], s[5 * 33]); o.w = cvt_pk_bf16(s[6 * 33], s[7 * 33]);
        *(u32x4*)(WT + (size_t)(drow0 + n) * K + k0 + 8 * c) = o; }
    LDS_WAIT(); asm volatile("" ::: "memory");
}
__device__ __forceinline__ void transpose_item_fp8(const float* W, int K, int N, unsigned char* WT, int k0, int n0, int drow0, float scale, LAS float* scr, int lane) {
    float tv[32];
#pragma unroll
    for (int i = 0; i < 32; ++i) tv[i] = W[(size_t)(k0 + 2 * i + (lane >> 5)) * N + n0 + (lane & 31)];
#pragma unroll
    for (int i = 0; i < 32; ++i) scr[(2 * i + (lane >> 5)) * 33 + (lane & 31)] = tv[i] * scale;
    LDS_WAIT(); asm volatile("" ::: "memory");
    const int n = lane >> 1, kh = lane & 1; const LAS float* sp = scr + (32 * kh) * 33 + n;
    unsigned w[8];
#pragma unroll
    for (int q = 0; q < 8; ++q) w[q] = pg8::pack4_fp8(sp[(4 * q) * 33], sp[(4 * q + 1) * 33], sp[(4 * q + 2) * 33], sp[(4 * q + 3) * 33]);
    unsigned char* dp = WT + (size_t)(drow0 + n) * K + k0 + 32 * kh;
    *(u32x4*)dp = (u32x4){w[0], w[1], w[2], w[3]}; *(u32x4*)(dp + 16) = (u32x4){w[4], w[5], w[6], w[7]};
    LDS_WAIT(); asm volatile("" ::: "memory");
}
constexpr int MIXER_ITEMS = 16 * 192 + 3 * 8 * 32 + 16 * 32, EXPERT_ITEMS = NE * 3 * 16 * 32;
__device__ __forceinline__ void convert_mixer_weights(const Frame& F, int l, int begin, int end, int first, int stride) {
    LAS float* scr = (LAS float*)(F.lds + F.wave * 8448);
    constexpr int I_IN = 16 * 192, I_BR = 8 * 32, I_OUT = 16 * 32;
    for (int it = begin + first; it < end; it += stride) {
        int r = it;
        if (r < I_IN) { const int kb = r / 192, nb = r % 192, n0 = 32 * nb;
            int drow = n0;
            if (n0 < 1536) drow = (n0 & ~255) + 128 * ((n0 & 63) >> 5) + 32 * ((n0 & 255) >> 6);
            else if (n0 >= 2048 && n0 < 3072) { const int isx = n0 >= 2560, ch = n0 - (isx ? 2560 : 2048); drow = (8 + (ch >> 7)) * 256 + 128 * isx + (ch & 127); }
            if (n0 >= 3072) transpose_item_fp8(F.w_in() + (size_t)l * D * PW, D, PW, (unsigned char*)F.WinT() + 6 * MiB, 64 * kb, n0, n0 - 3072, pg8::WSCALE, scr, F.lane);
            else transpose_item(F.w_in() + (size_t)l * D * PW, D, PW, F.WinT(), 64 * kb, n0, drow, scr, F.lane);
            continue; } r -= I_IN;
        if (r < 3 * I_BR) { const int k3 = r / I_BR, q = r % I_BR, kb = q / 32, nb = q % 32;
            transpose_item(F.w_branch() + ((size_t)l * 3 + k3) * 512 * D, 512, D, F.WbrT() + (size_t)k3 * D * 512, 64 * kb, 32 * nb, 32 * nb, scr, F.lane); continue; } r -= 3 * I_BR;
        { const int kb = r / 32, nb = r % 32; transpose_item(F.w_out() + (size_t)l * D * D, D, D, F.WoutT(), 64 * kb, 32 * nb, 32 * nb, scr, F.lane); }
    }
}
__device__ __forceinline__ void convert_expert_weights(const Frame& F, int l, int begin, int end, int first, int stride) {
    LAS float* scr = (LAS float*)(F.lds + F.wave * 8448);
    constexpr int PER = 16 * 32;
    for (int it = begin + first; it < end; it += stride) {
        const int e = it / (3 * PER), r = it % (3 * PER), which = r / PER, q = r % PER, kb = q / 32, nb = q % 32, n0 = 32 * nb;
        const size_t eo = ((size_t)l * NE + e) * (size_t)D * EH;
        unsigned char* const wgu = (unsigned char*)F.WGU(); unsigned char* const wd = (unsigned char*)F.WD();
        if (which == 0) transpose_item_fp8(F.w_eg() + eo, D, EH, wgu + (size_t)e * 2048 * D, 64 * kb, n0, (n0 >> 7) * 256 + (n0 & 127), pg8::WSCALE, scr, F.lane);
        else if (which == 1) transpose_item_fp8(F.w_eu() + eo, D, EH, wgu + (size_t)e * 2048 * D, 64 * kb, n0, (n0 >> 7) * 256 + 128 + (n0 & 127), pg8::WSCALE, scr, F.lane);
        else transpose_item_fp8(F.w_ed() + eo, EH, D, wd + (size_t)e * D * EH, 64 * kb, n0, n0, pg8::WSCALE, scr, F.lane);
    }
}

__device__ __forceinline__ void norm_mod(f32x4 (&v)[4], const float* g, const float* sh, const float* sc, int lane) {
    f32x4 gg[4], s1[4], s0[4];
#pragma unroll
    for (int j = 0; j < 4; ++j) { gg[j] = *(const f32x4*)(g + 4 * lane + 256 * j); s1[j] = *(const f32x4*)(sc + 4 * lane + 256 * j); s0[j] = *(const f32x4*)(sh + 4 * lane + 256 * j); }
    float ss = 0.f;
#pragma unroll
    for (int j = 0; j < 4; ++j) ss += (v[j].x * v[j].x + v[j].y * v[j].y) + (v[j].z * v[j].z + v[j].w * v[j].w);
    ss = wave_sum(ss);
    const float rinv = 1.0f / sqrtf(ss * (1.0f / D) + EPS);
#pragma unroll
    for (int j = 0; j < 4; ++j) v[j] = (v[j] * rinv * gg[j]) * (1.0f + s1[j]) + s0[j];
}
__device__ __forceinline__ void store_row_fp8(unsigned char* orow, const f32x4 (&v)[4], int lane) {
#pragma unroll
    for (int j = 0; j < 4; ++j) *(unsigned*)(orow + 4 * lane + 256 * j) = pg8::pack4_fp8(v[j].x, v[j].y, v[j].z, v[j].w);
}
__device__ __forceinline__ void store_row_bf16(bf16_t* orow, const f32x4 (&v)[4], int lane) {
#pragma unroll
    for (int j = 0; j < 4; ++j) { u32x2 w; w.x = cvt_pk_bf16(v[j].x, v[j].y); w.y = cvt_pk_bf16(v[j].z, v[j].w); *(u32x2*)(orow + 4 * lane + 256 * j) = w; }
}

__device__ const float kInvFreq[16] = { 1.0f, 0.5623413251903491f, 0.31622776601683794f, 0.17782794100389228f, 0.1f, 0.05623413251903491f, 0.031622776601683794f, 0.017782794100389228f,
                                        0.01f, 0.005623413251903491f, 0.0031622776601683794f, 0.0017782794100389228f, 0.001f, 0.0005623413251903491f, 0.00031622776601683794f, 0.00017782794100389228f };
__device__ __forceinline__ void phase_prologue(const Frame& F) {
    LAS float* sv = (LAS float*)F.lds;
    LAS float* red = (LAS float*)(F.lds + 20480);
    for (int i = F.tid; i < 5 * D; i += NTHR) { const int r = i >> 10, k = i & 1023; const float cv = r < 4 ? F.c()[r * D + k] : F.c_ctx()[k]; sv[i] = cv / (1.0f + __expf(-cv)); }
    __syncthreads();
    for (int item = F.bx; item < 2 * 96; item += F.G) {
        const int l = item / 96, col = (item % 96) * 64 + F.lane;
        const float* W = F.w_ada() + (size_t)l * D * PW + col;
        float a0 = 0.f, a1 = 0.f, a2 = 0.f, a3 = 0.f, a4 = 0.f;
#pragma unroll 16
        for (int kk = 0; kk < 128; ++kk) { const int k = F.wave * 128 + kk; const float w = W[(size_t)k * PW];
            a0 += sv[k] * w; a1 += sv[D + k] * w; a2 += sv[2 * D + k] * w; a3 += sv[3 * D + k] * w; a4 += sv[4 * D + k] * w; }
        red[(F.wave * 5 + 0) * 64 + F.lane] = a0; red[(F.wave * 5 + 1) * 64 + F.lane] = a1; red[(F.wave * 5 + 2) * 64 + F.lane] = a2; red[(F.wave * 5 + 3) * 64 + F.lane] = a3; red[(F.wave * 5 + 4) * 64 + F.lane] = a4;
        __syncthreads();
        if (F.wave < 5) { float s = 0.f;
#pragma unroll
            for (int w = 0; w < 8; ++w) s += red[(w * 5 + F.wave) * 64 + F.lane];
            F.mod()[(size_t)(l * 5 + F.wave) * PW + col] = s + F.b_ada()[l * PW + col]; }
        __syncthreads();
    }
    if (F.bx == 0) { float* gt = F.gains(); if (F.tid < 16) gt[512 + F.tid] = kInvFreq[F.tid];
        if (F.tid >= 64 && F.tid < 68) {
            const int l = (F.tid - 64) >> 1, br = (F.tid - 64) & 1; const float* gq = (br ? F.qg_b() : F.qg_a()) + l * 64; const float* gk = (br ? F.kg_b() : F.kg_a()) + l * 64; float mq = 0.f, mk = 0.f;
            for (int d = 0; d < 64; ++d) { mq = fmaxf(mq, fabsf(gq[d])); mk = fmaxf(mk, fabsf(gk[d])); }
            gt[528 + l * 2 + br] = QSCALE * 64.0f * mq * mk * 1.02f; } for (int i = F.tid; i < 2 * 4 * 64; i += NTHR) { const int l = i >> 8, w = (i >> 6) & 3, d = i & 63;
            const float* src = (w == 0) ? F.kg_a() : (w == 1) ? F.kg_b() : (w == 2) ? F.qg_a() : F.qg_b(); gt[i] = src[l * 64 + d]; } }
    __syncthreads();
    convert_mixer_weights(F, 0, 0, MIXER_ITEMS, F.gw, F.NGW);
}

__device__ __forceinline__ void phase_norm1(const Frame& F, int l, const float* xl, const float* xcsrc, int row_begin, int row_end, int gw, int ngw) {
    const float* modl = F.mod() + (size_t)l * 5 * PW;
    for (int r0 = row_begin + gw; r0 < row_end; r0 += 4 * ngw) {
        f32x4 v[4][4];
#pragma unroll
        for (int q = 0; q < 4; ++q) { const int row = r0 + q * ngw; const int rc = row < row_end ? row : r0;
            const float* xr = rc < ML ? xl + (size_t)rc * D : xcsrc + (size_t)(rc - ML) * D;
#pragma unroll
            for (int j = 0; j < 4; ++j) v[q][j] = *(const f32x4*)(xr + 4 * F.lane + 256 * j); }
#pragma unroll
        for (int q = 0; q < 4; ++q) { const int row = r0 + q * ngw;
            if (row < row_end) { const int mr = row < ML ? row / SEQ : 4;
                norm_mod(v[q], F.g_mix() + l * D, modl + mr * PW, modl + mr * PW + D, F.lane);
                store_row_bf16(F.H() + (size_t)row * D, v[q], F.lane); store_row_fp8(F.H8() + (size_t)row * D, v[q], F.lane); } }
    }
}

__device__ __forceinline__ void phase_elementwise(const Frame& F, int l, int g_begin, int g_end, int gw, int ngw, bool dummy = false) {
    const int lane = F.lane;
    f32x4 cw[3][2];
    { const float* cwp = F.conv_w() + (size_t)l * 3 * 512 + 8 * lane;
#pragma unroll
      for (int q = 0; q < 3; ++q) { cw[q][0] = *(const f32x4*)(cwp + q * 512); cw[q][1] = *(const f32x4*)(cwp + q * 512 + 4); } }
    bf16_t* const Cb = F.CONV();
    for (int g4 = g_begin + gw; g4 < g_end; g4 += ngw) {
        const int g0 = g4 * 4; const bool lat = g0 < ML;
        const int tw = lat ? g0 % SEQ : (g0 - ML) % CTX, nseq = lat ? SEQ : CTX;
        bf16_t* const crow0 = Cb + (size_t)g0 * QW;
        u32x4 uu[6], bg[4];
#pragma unroll
        for (int q = 0; q < 6; ++q) { const int tt = tw + q - 1; const bool ok = (tt >= 0) && (tt < nseq);
            uu[q] = ok ? *(const u32x4*)(crow0 + (ptrdiff_t)(q - 1) * QW + 512 + 8 * lane) : (u32x4){0u, 0u, 0u, 0u}; }
#pragma unroll
        for (int i = 0; i < 4; ++i) bg[i] = *(const u32x4*)(crow0 + (size_t)i * QW + 8 * lane);
        float u[6][8];
#pragma unroll
        for (int q = 0; q < 6; ++q) { u[q][0] = bf_lo(uu[q].x); u[q][1] = bf_hi(uu[q].x); u[q][2] = bf_lo(uu[q].y); u[q][3] = bf_hi(uu[q].y); u[q][4] = bf_lo(uu[q].z); u[q][5] = bf_hi(uu[q].z); u[q][6] = bf_lo(uu[q].w); u[q][7] = bf_hi(uu[q].w); }
#pragma unroll
        for (int i = 0; i < 4; ++i) {
            float o8[8];
#pragma unroll
            for (int e = 0; e < 8; ++e) { const float w0 = (e < 4) ? cw[0][0][e & 3] : cw[0][1][e & 3], w1 = (e < 4) ? cw[1][0][e & 3] : cw[1][1][e & 3], w2 = (e < 4) ? cw[2][0][e & 3] : cw[2][1][e & 3];
                o8[e] = w0 * u[i][e] + w1 * u[i + 1][e] + w2 * u[i + 2][e]; }
            const u32x4 bb = bg[i];
            u32x4 w; w.x = cvt_pk_bf16(o8[0] * bf_lo(bb.x), o8[1] * bf_hi(bb.x)); w.y = cvt_pk_bf16(o8[2] * bf_lo(bb.y), o8[3] * bf_hi(bb.y));
            w.z = cvt_pk_bf16(o8[4] * bf_lo(bb.z), o8[5] * bf_hi(bb.z)); w.w = cvt_pk_bf16(o8[6] * bf_lo(bb.w), o8[7] * bf_hi(bb.w));
            if (!dummy) *(u32x4*)(crow0 + (size_t)i * QW + 8 * lane) = w;
        }
    }
}

__device__ __forceinline__ void ctr_signal(unsigned* ctr) {
    asm volatile("s_waitcnt vmcnt(0)" ::: "memory"); __syncthreads();
    if (threadIdx.x == 0) { __builtin_amdgcn_fence(__ATOMIC_RELEASE, "agent"); asm volatile("s_waitcnt vmcnt(0)" ::: "memory"); (void)xb_add(ctr, 1u); }
}
__device__ __forceinline__ void ctr_wait(unsigned* ctr, unsigned n) {
    if (threadIdx.x == 0) { unsigned sp = 0u; while (xb_ld(ctr) < n) { __builtin_amdgcn_s_sleep(2); if (++sp > (1u << 22)) break; }
        __builtin_amdgcn_fence(__ATOMIC_ACQUIRE, "agent"); asm volatile("s_waitcnt vmcnt(0)" ::: "memory"); }
    __syncthreads();
}
#if defined(DUPMASK)
#define ATT_DUMMY(x) (x)
#else
#define ATT_DUMMY(x) false
#endif
constexpr int CTX_FUSED_G = 256;
__device__ __forceinline__ bool ctx_fused(const Frame& F, bool has_ctx) { return has_ctx && F.G == CTX_FUSED_G; }
__device__ __forceinline__ void phase_attention(const Frame& F, int l, bool has_ctx, bool first, bool dummy_out = false) {
    const float mA = F.gains()[528 + l * 2], mB = F.gains()[528 + l * 2 + 1];
    const bool fastA = mA < 80.0f; (void)mB;
    const bool fused = ctx_fused(F, has_ctx);
    const int v = F.vcu;
    const bool isM = fused && v >= 64 && v < 80, isO = fused && v >= 80 && v < 96;
    const int nwin = v < 64 ? 4 : v < 80 ? 0 : v < 96 ? 2 : v < 192 ? 5 : 4;
    const int wstart = v < 64 ? 4 * v : v < 80 ? 256 : v < 96 ? 256 + 2 * (v - 80) : v < 192 ? 288 + 5 * (v - 96) : 768 + 4 * (v - 192);
    unsigned* const ctrA = (unsigned*)F.wsp(WS_CTL) + 8192 + 64 * (2 * l), * const ctrM = ctrA + 64;
    enum { K_SKIP = 0, K_CONVCTX, K_CONV, K_GLOBAL, K_WINDOW, K_CTXATT, K_MERGE, K_OUT };
    for (int n = 0;; ++n) {
        int kind = K_SKIP, arg = 0;
        if (fused) {
            if (n == 0) kind = v < 32 ? K_CONVCTX : K_SKIP;
            else if (n == 1) { kind = v < 64 ? K_CTXATT : K_SKIP; arg = v; }
            else if (n == 2) kind = isM ? K_SKIP : K_CONV;
            else if (n == 3 || n == 4) { kind = K_GLOBAL; arg = (n - 3) * 256 + v; }
            else if (n == 5) kind = isM ? K_MERGE : K_SKIP;
            else if (n == 6 || n == 7) { kind = K_GLOBAL; arg = (n - 4) * 256 + v; }
            else if (n == 8) kind = isO ? K_OUT : K_SKIP;
            else { const int j = n - 9; if (j >= nwin) break; kind = K_WINDOW; arg = wstart + j; }
        } else {
            if (n == 0) kind = K_CONV;
            else { const int uid = (n - 1) * F.G + v; if (uid >= 2048 + (has_ctx ? 64 : 0)) break;
                if (uid < 1024) { kind = K_GLOBAL; arg = uid; } else if (uid < 2048) { kind = K_WINDOW; arg = uid - 1024; } else { kind = K_CTXATT; arg = uid - 2048; } }
        }
        if (kind == K_CONVCTX) { if (first) phase_elementwise(F, l, ML / 4, MT / 4, v * NWAVES + F.wave, 32 * NWAVES); }
        else if (kind == K_CONV) {
            if (first) { if (fused) { const int vv = v < 64 ? v : v - 16; phase_elementwise(F, l, 0, ML / 4, vv * NWAVES + F.wave, (CTX_FUSED_G - 16) * NWAVES); }
                         else phase_elementwise(F, l, 0, MT / 4, F.gw, F.NGW); }
        } else if (kind == K_GLOBAL) {
            const int uid = arg; const int b = uid >> 8, h = (uid >> 5) & 7, qb = uid & 31, kvh = h >> 2;
            ab::bf16* qo = (ab::bf16*)(F.QKV() + (size_t)(b * SEQ + qb * 256) * QW + OFF_QA + h * 64); ab::bf16* oo = ATT_DUMMY(dummy_out) ? (ab::bf16*)F.H() : qo;
            const ab::bf16* kp = (const ab::bf16*)(F.KA() + (size_t)(b * 2 + kvh) * KVROWS * 64); const ab::bf16* vp = (const ab::bf16*)(F.VA() + (size_t)(b * 2 + kvh) * KVROWS * 64);
            if (fastA) ab::attn_unit<8, false, false, true>(qo, kp, vp, oo, KVROWS / 64, (char*)F.lds, F.tid, 0, 0, 0.f, mA);
            else ab::attn_unit<8, false, false, false>(qo, kp, vp, oo, KVROWS / 64, (char*)F.lds, F.tid, 0, 0, 0.f, 0.f);
        } else if (kind == K_WINDOW) {
            const int w = arg; const int b = w >> 8, h = (w >> 5) & 7, qb = w & 31, kvh = h >> 2;
            ab::bf16* qo = (ab::bf16*)(F.QKV() + (size_t)(b * SEQ + qb * 256) * QW + OFF_QB + h * 64); ab::bf16* oo = ATT_DUMMY(dummy_out) ? (ab::bf16*)F.H() : qo;
            int lo = qb * 4 - 2, hi2 = qb * 4 + 6; if (lo < 0) lo = 0; if (hi2 > SEQ / 64) hi2 = SEQ / 64;
            const size_t ko = (size_t)(b * 2 + kvh) * KVROWS * 64; const float sk = F.sink_b()[l * 8 + h] * LOG2E;
            ab::attn_unit<8, true, true, false>(qo, (const ab::bf16*)(F.KB() + ko), (const ab::bf16*)(F.VB() + ko), oo, 4 + (hi2 - lo), (char*)F.lds, F.tid, lo, qb * 256, sk, 0.f);
        } else if (kind == K_CTXATT) {
            const int w = arg, isb = w >> 5, b = (w >> 3) & 3, h = w & 7, kvh = h >> 2;
            ab::bf16* qo = (ab::bf16*)(F.QKV() + (size_t)(ML + b * CTX) * QW + (isb ? OFF_QB : OFF_QA) + h * 64); ab::bf16* oo = ATT_DUMMY(dummy_out) ? (ab::bf16*)F.H() : qo;
            const size_t ko = ((size_t)(b * 2 + kvh) * KVROWS + SEQ) * 64;
            if (isb) ab::attn_unit<8, false, true, false>(qo, (const ab::bf16*)(F.KB() + ko), (const ab::bf16*)(F.VB() + ko), oo, CTX / 64, (char*)F.lds, F.tid, 0, 0, F.sink_b()[l * 8 + h] * LOG2E, 0.f);
            else ab::attn_unit<8, false, false, false>(qo, (const ab::bf16*)(F.KA() + ko), (const ab::bf16*)(F.VA() + ko), oo, CTX / 64, (char*)F.lds, F.tid, 0, 0, 0.f, 0.f);
            if (fused) ctr_signal(ctrA);
        } else if (kind == K_MERGE) {
            ctr_wait(ctrA, 64u);
            const int t = v - 64;
            pg8::SchedMergeOne S; S.pm = ML / 256 + (t >> 2); S.pn = t & 3; S.Q = (const char*)F.QKV(); S.C = (const char*)F.CONV(); S.W = (const char*)F.WbrT();
            pg8::EpiMerge E{(const unsigned char*)F.GATE(), F.H()};
            pg8::gemm_phase(F.lds, 512, QW, 512, S, E);
            ctr_signal(ctrM);
        } else if (kind == K_OUT) {
            ctr_wait(ctrM, 16u);
            const int t = v - 80;
            pg8::SchedPlainOne S; S.pm = ML / 256 + (t >> 2); S.pn = t & 3; S.pn0 = 0; S.A = (const char*)F.H(); S.B = (const char*)F.WoutT(); S.atile = (size_t)256 * D * 2; S.btile = (size_t)256 * D * 2;
            pg8::EpiOut E{F.DELTA(), F.mod() + (size_t)l * 5 * PW};
            pg8::gemm_phase(F.lds, D, D, D, S, E);
        }
    }
}

__device__ __forceinline__ void router_row(const Frame& F, f32x4 (&v)[4], int l, int row, int b, int pos, int mr, const float* modl, const LAS float* wrt, int lane) {
        norm_mod(v, F.g_ffn() + l * D, modl + mr * PW + 3 * D, modl + mr * PW + 4 * D, lane);
        store_row_fp8(F.H8() + (size_t)row * D, v, lane);
        float lg[16];
#pragma unroll
        for (int e = 0; e < 16; ++e) { float s = 0.f;
#pragma unroll
            for (int j = 0; j < 4; ++j) { const f32x4 w = *(const LAS f32x4*)(wrt + e * D + 4 * lane + 256 * j); s += (v[j].x * w.x + v[j].y * w.y) + (v[j].z * w.z + v[j].w * w.w); }
            lg[e] = s; }
        float w8[8], w4[4], w2[2], lgt;
        { const bool up = (lane & 32) != 0;
#pragma unroll
          for (int i = 0; i < 8; ++i) { const float mine = up ? lg[8 + i] : lg[i], oth = up ? lg[i] : lg[8 + i]; w8[i] = mine + __shfl_xor(oth, 32); } }
        { const bool up = (lane & 16) != 0;
#pragma unroll
          for (int i = 0; i < 4; ++i) { const float mine = up ? w8[4 + i] : w8[i], oth = up ? w8[i] : w8[4 + i]; w4[i] = mine + __shfl_xor(oth, 16); } }
        { const bool up = (lane & 8) != 0;
#pragma unroll
          for (int i = 0; i < 2; ++i) { const float mine = up ? w4[2 + i] : w4[i], oth = up ? w4[i] : w4[2 + i]; w2[i] = mine + __shfl_xor(oth, 8); } }
        { const bool up = (lane & 4) != 0; const float mine = up ? w2[1] : w2[0], oth = up ? w2[0] : w2[1]; lgt = mine + __shfl_xor(oth, 4); }
        lgt += __shfl_xor(lgt, 2); lgt += __shfl_xor(lgt, 1);
        float mx = lgt;
        mx = fmaxf(mx, __shfl_xor(mx, 4)); mx = fmaxf(mx, __shfl_xor(mx, 8)); mx = fmaxf(mx, __shfl_xor(mx, 16)); mx = fmaxf(mx, __shfl_xor(mx, 32));
        const float ex = __expf(lgt - mx); float sum = ex;
        sum += __shfl_xor(sum, 4); sum += __shfl_xor(sum, 8); sum += __shfl_xor(sum, 16); sum += __shfl_xor(sum, 32);
        if ((lane & 3) == 0) { const int e = ((lane >> 5) & 1) * 8 + ((lane >> 4) & 1) * 4 + ((lane >> 3) & 1) * 2 + ((lane >> 2) & 1);
            F.aff()[(size_t)(b * NE + e) * KVROWS + pos] = ex / sum; F.inv()[(size_t)row * NE + e] = -1; }
}
__device__ __forceinline__ void phase_norm2_router(const Frame& F, int l, bool has_ctx) {
    LAS float* wrt = (LAS float*)F.lds;
    for (int i = F.tid; i < D * NE; i += NTHR) { const int k = i >> 4, e = i & 15; wrt[e * D + k] = F.w_router()[(size_t)l * D * NE + i]; }
    __syncthreads();
    const float* modl = F.mod() + (size_t)l * 5 * PW; const int nrows = has_ctx ? MT : ML; const int lane = F.lane;
    const float* const xlat = (l == 0) ? F.x() : (const float*)F.out(); const float* const xctx = (l == 0) ? F.ctx() : (const float*)F.xc(); const bf16_t* const dlt = F.DELTA();
    for (int r0 = F.gw; r0 < nrows; r0 += 2 * F.NGW) {
        f32x4 v[2][4]; u32x2 dw[2][4];
#pragma unroll
        for (int q = 0; q < 2; ++q) { const int row = r0 + q * F.NGW; const int rc = row < nrows ? row : r0;
            const float* xr = rc < ML ? xlat + (size_t)rc * D : xctx + (size_t)(rc - ML) * D; const bf16_t* dr = dlt + (size_t)rc * D + 4 * lane;
#pragma unroll
            for (int j = 0; j < 4; ++j) { dw[q][j] = *(const u32x2*)(dr + 256 * j); v[q][j] = *(const f32x4*)(xr + 4 * lane + 256 * j); } }
#pragma unroll
        for (int q = 0; q < 2; ++q) { const int row = r0 + q * F.NGW;
            if (row < nrows) {
#pragma unroll
                for (int j = 0; j < 4; ++j) { v[q][j].x += bf_lo(dw[q][j].x); v[q][j].y += bf_hi(dw[q][j].x); v[q][j].z += bf_lo(dw[q][j].y); v[q][j].w += bf_hi(dw[q][j].y); }
                const bool lat = row < ML; const int b = lat ? row / SEQ : (row - ML) / CTX, pos = lat ? row % SEQ : SEQ + (row - ML) % CTX, mr = lat ? b : 4;
                router_row(F, v[q], l, row, b, pos, mr, modl, wrt, lane); } }
    }
}

__device__ __forceinline__ void topk_unit(const Frame& F, const float* affrow, int n, int k, int* idx_out, float* gate_out, int* inv_base) {
    LAS unsigned* keys = (LAS unsigned*)F.lds; LAS int* hist = (LAS int*)(F.lds + 32768);
    LAS int* misc = (LAS int*)(F.lds + 32768 + 65536);
    const int tid = F.tid, lane = F.lane, wid = F.wave;
    for (int i = tid; i < n; i += NTHR) keys[i] = __float_as_uint(affrow[i]);
    for (int i = tid; i < 8 * 2048; i += NTHR) hist[i] = 0;
    __syncthreads();
    unsigned prefix = 0u; int krem = k;
    {
        for (int i = tid; i < n; i += NTHR) __hip_atomic_fetch_add(&hist[wid * 2048 + (keys[i] >> 20)], 1, __ATOMIC_RELAXED, __HIP_MEMORY_SCOPE_WORKGROUP);
        __syncthreads();
        int h[4], s4 = 0;
#pragma unroll
        for (int q = 0; q < 4; ++q) { int c = 0;
#pragma unroll
            for (int w = 0; w < 8; ++w) c += hist[w * 2048 + 2047 - 4 * tid - q];
            h[q] = c; s4 += c; }
        int incl = s4;
#pragma unroll
        for (int o = 1; o < 64; o <<= 1) { const int tv = __shfl_up(incl, o); if (lane >= o) incl += tv; }
        if (lane == 63) misc[8 + wid] = incl;
        __syncthreads();
        int base = 0;
#pragma unroll
        for (int w = 0; w < 8; ++w) { const int tv = misc[8 + w]; if (w < wid) base += tv; }
        incl += base; const int excl = incl - s4;
        if (excl < krem && incl >= krem) { int c = excl, sel, nk;
            if (c + h[0] >= krem) { sel = 2047 - 4 * tid; nk = krem - c; }
            else { c += h[0]; if (c + h[1] >= krem) { sel = 2046 - 4 * tid; nk = krem - c; }
                else { c += h[1]; if (c + h[2] >= krem) { sel = 2045 - 4 * tid; nk = krem - c; } else { c += h[2]; sel = 2044 - 4 * tid; nk = krem - c; } } }
            misc[0] = sel; misc[1] = nk; }
        __syncthreads();
        prefix = (unsigned)misc[0]; krem = misc[1];
        __syncthreads();
    }
    for (int pass = 1; pass < 4; ++pass) {
        const int shift = (pass == 1) ? 12 : (pass == 2 ? 4 : 0), width = (pass == 3) ? 4 : 8, hs = shift + width; const unsigned bm = (1u << width) - 1u;
        if (tid < 256) hist[tid] = 0;
        __syncthreads();
        for (int i = tid; i < n; i += NTHR) { const unsigned key = keys[i]; if ((key >> hs) == prefix) __hip_atomic_fetch_add(&hist[(key >> shift) & bm], 1, __ATOMIC_RELAXED, __HIP_MEMORY_SCOPE_WORKGROUP); }
        __syncthreads();
        if (wid == 0) {
            const int h0 = hist[255 - 4 * lane], h1 = hist[254 - 4 * lane], h2 = hist[253 - 4 * lane], h3 = hist[252 - 4 * lane];
            const int s = h0 + h1 + h2 + h3; int incl = s;
#pragma unroll
            for (int o = 1; o < 64; o <<= 1) { const int tv = __shfl_up(incl, o); if (lane >= o) incl += tv; }
            const int excl = incl - s;
            if (excl < krem && incl >= krem) { int c = excl, sel, nk;
                if (c + h0 >= krem) { sel = 255 - 4 * lane; nk = krem - c; }
                else { c += h0; if (c + h1 >= krem) { sel = 254 - 4 * lane; nk = krem - c; }
                    else { c += h1; if (c + h2 >= krem) { sel = 253 - 4 * lane; nk = krem - c; } else { c += h2; sel = 252 - 4 * lane; nk = krem - c; } } }
                misc[0] = sel; misc[1] = nk; }
        }
        __syncthreads();
        prefix = (prefix << width) | (unsigned)misc[0]; krem = misc[1];
        __syncthreads();
    }
    const unsigned T = prefix; const int per = (n + NTHR - 1) / NTHR, i0 = tid * per;
    int cg = 0, ce = 0;
    for (int q = 0; q < per; ++q) { const int i = i0 + q; if (i < n) { const unsigned key = keys[i]; cg += (key > T); ce += (key == T); } }
    int pk = cg | (ce << 16), incl = pk;
#pragma unroll
    for (int o = 1; o < 64; o <<= 1) { const int tv = __shfl_up(incl, o); if (lane >= o) incl += tv; }
    if (lane == 63) misc[8 + wid] = incl;
    __syncthreads();
    int base = 0;
#pragma unroll
    for (int w = 0; w < 8; ++w) { const int tv = misc[8 + w]; if (w < wid) base += tv; }
    const int ex = base + incl - pk; int sg = ex & 0xffff, se = ex >> 16; const int ngt = k - krem;
    for (int q = 0; q < per; ++q) { const int i = i0 + q; if (i < n) { const unsigned key = keys[i]; int slot = -1;
        if (key > T) slot = sg++; else if (key == T) { if (se < krem) slot = ngt + se; ++se; }
        if (slot >= 0) { idx_out[slot] = i; gate_out[slot] = __uint_as_float(key); inv_base[(size_t)i * NE] = slot; } } }
    __syncthreads();
}
__device__ __forceinline__ void phase_topk(const Frame& F, int l, bool has_ctx) {
    const int nunits = has_ctx ? 128 : 64;
    for (int u = F.bx; u < nunits; u += F.G) {
        if (u < 64) { const int b = u >> 4, e = u & 15;
            topk_unit(F, F.aff() + (size_t)u * KVROWS, SEQ, CAP, F.idx() + u * CAP, F.gatev() + u * CAP, F.inv() + (size_t)(b * SEQ) * NE + e); }
        else { const int g = u - 64, b = g >> 4, e = g & 15;
            topk_unit(F, F.aff() + (size_t)g * KVROWS + SEQ, CTX, CAPC, F.idx() + MOE_ROWS_LAT + g * CAPC, F.gatev() + MOE_ROWS_LAT + g * CAPC, F.inv() + (size_t)(ML + b * CTX) * NE + e); }
    }
    __syncthreads();
    const int nfree = F.G - nunits, fr = F.bx - nunits;
    if (nfree <= 0) { convert_expert_weights(F, l, 0, EXPERT_ITEMS, F.gw, F.NGW); if (l + 1 < DEPTH) convert_mixer_weights(F, l + 1, 0, MIXER_ITEMS, F.gw, F.NGW); return; }
    if (l + 1 < DEPTH) {
        convert_expert_weights(F, l, 0, EXPERT_ITEMS, F.gw, F.NGW);
        if (fr >= 0) convert_mixer_weights(F, l + 1, 0, MIXER_ITEMS, fr * NWAVES + F.wave, nfree * NWAVES);
    } else {
        const int cut = (EXPERT_ITEMS / 4) * 3;
        convert_expert_weights(F, l, 0, cut, F.gw, F.NGW);
        if (fr >= 0) convert_expert_weights(F, l, cut, EXPERT_ITEMS, fr * NWAVES + F.wave, nfree * NWAVES);
    }
}

__device__ __forceinline__ void phase_combine(const Frame& F, int l, int row_begin, int row_end, int gw, int ngw, bool next_norm, bool dummy = false) {
    const float* modl = F.mod() + (size_t)l * 5 * PW; const int nrows = row_end; const int lane = F.lane;
    const bf16_t* const Y = F.XS(); const int* const invp = F.inv(); const float* const gvp = F.gatev(); float* const outp = F.out(); float* const xcp = F.xc();
    const float* const xlat = (l == 0) ? F.x() : (const float*)F.out(); const float* const xctx = (l == 0) ? F.ctx() : (const float*)F.xc(); const bf16_t* const dlt = F.DELTA();
    for (int r0 = row_begin + gw; r0 < nrows; r0 += 2 * ngw) {
        const int rA = r0; const bool hasB = (r0 + ngw) < nrows; const int rB = hasB ? r0 + ngw : r0;
        const bool latA = rA < ML, latB = rB < ML;
        const int bA = latA ? rA / SEQ : (rA - ML) / CTX, bB = latB ? rB / SEQ : (rB - ML) / CTX;
        float* xrA = latA ? outp + (size_t)rA * D : xcp + (size_t)(rA - ML) * D; float* xrB = latB ? outp + (size_t)rB * D : xcp + (size_t)(rB - ML) * D;
        const float* xoA = latA ? xlat + (size_t)rA * D : xctx + (size_t)(rA - ML) * D; const float* xoB = latB ? xlat + (size_t)rB * D : xctx + (size_t)(rB - ML) * D;
        int myinv = invp[(size_t)((lane & 16) ? rB : rA) * NE + (lane & 15)];
        if ((lane & 16) && !hasB) myinv = -1;
        f32x4 xa[4], xb[4];
#pragma unroll
        for (int j = 0; j < 4; ++j) { xa[j] = *(const f32x4*)(xoA + 4 * lane + 256 * j); xb[j] = *(const f32x4*)(xoB + 4 * lane + 256 * j);
            const u32x2 da = *(const u32x2*)(dlt + (size_t)rA * D + 4 * lane + 256 * j), db = *(const u32x2*)(dlt + (size_t)rB * D + 4 * lane + 256 * j);
            xa[j].x += bf_lo(da.x); xa[j].y += bf_hi(da.x); xa[j].z += bf_lo(da.y); xa[j].w += bf_hi(da.y); xb[j].x += bf_lo(db.x); xb[j].y += bf_hi(db.x); xb[j].z += bf_lo(db.y); xb[j].w += bf_hi(db.y); }
        const unsigned long long bal = __ballot(myinv >= 0);
        unsigned mA = (unsigned)(bal & 0xffffull), mB = (unsigned)((bal >> 16) & 0xffffull);
        f32x4 aa[4], ab2[4];
#pragma unroll
        for (int j = 0; j < 4; ++j) { aa[j] = (f32x4){0.f, 0.f, 0.f, 0.f}; ab2[j] = (f32x4){0.f, 0.f, 0.f, 0.f}; }
        while (mA | mB) {
            size_t yo[4]; float gv[4];
#pragma unroll
            for (int c = 0; c < 4; ++c) {
                const bool isB = c >= 2; unsigned& m = isB ? mB : mA; yo[c] = 0; gv[c] = 0.f;
                if (m) { const int e = __builtin_ctz(m); m &= m - 1u;
                    const int slot = __builtin_amdgcn_readlane(myinv, (isB ? 16 : 0) + e);
                    const bool lat = isB ? latB : latA; const int bb = isB ? bB : bA;
                    const int yrow = lat ? (bb * NE + e) * CAP + slot : MOE_ROWS_LAT + e * 256 + bb * 32 + slot;
                    gv[c] = lat ? gvp[(bb * NE + e) * CAP + slot] : gvp[MOE_ROWS_LAT + (bb * NE + e) * CAPC + slot];
                    yo[c] = (size_t)yrow * D; }
            }
            u32x2 yw[4][4];
#pragma unroll
            for (int c = 0; c < 4; ++c)
#pragma unroll
                for (int j = 0; j < 4; ++j) yw[c][j] = __builtin_nontemporal_load((const u32x2*)(Y + yo[c] + 4 * lane + 256 * j));
#pragma unroll
            for (int c = 0; c < 2; ++c)
#pragma unroll
                for (int j = 0; j < 4; ++j) { const u32x2 w = yw[c][j]; aa[j].x += gv[c] * bf_lo(w.x); aa[j].y += gv[c] * bf_hi(w.x); aa[j].z += gv[c] * bf_lo(w.y); aa[j].w += gv[c] * bf_hi(w.y); }
#pragma unroll
            for (int c = 2; c < 4; ++c)
#pragma unroll
                for (int j = 0; j < 4; ++j) { const u32x2 w = yw[c][j]; ab2[j].x += gv[c] * bf_lo(w.x); ab2[j].y += gv[c] * bf_hi(w.x); ab2[j].z += gv[c] * bf_lo(w.y); ab2[j].w += gv[c] * bf_hi(w.y); }
        }
        {
            const int mr = latA ? bA : 4; const float* gt2 = modl + mr * PW + 5 * D;
            float* dst = dummy ? (float*)F.HID() + (size_t)(latA ? rA : 0) * D : xrA;
#pragma unroll
            for (int j = 0; j < 4; ++j) { const f32x4 gg = *(const f32x4*)(gt2 + 4 * lane + 256 * j); xa[j] = xa[j] + gg * aa[j]; __builtin_nontemporal_store(xa[j], (f32x4*)(dst + 4 * lane + 256 * j)); }
            if (next_norm && !dummy) { const float* modn = F.mod() + (size_t)(l + 1) * 5 * PW;
                norm_mod(xa, F.g_mix() + (l + 1) * D, modn + mr * PW, modn + mr * PW + D, lane); store_row_bf16(F.H() + (size_t)rA * D, xa, lane); store_row_fp8(F.H8() + (size_t)rA * D, xa, lane); }
        }
        if (hasB) {
            const int mr = latB ? bB : 4; const float* gt2 = modl + mr * PW + 5 * D;
            float* dst = dummy ? (float*)F.HID() + (size_t)(latB ? rB : 0) * D : xrB;
#pragma unroll
            for (int j = 0; j < 4; ++j) { const f32x4 gg = *(const f32x4*)(gt2 + 4 * lane + 256 * j); xb[j] = xb[j] + gg * ab2[j]; __builtin_nontemporal_store(xb[j], (f32x4*)(dst + 4 * lane + 256 * j)); }
            if (next_norm && !dummy) { const float* modn = F.mod() + (size_t)(l + 1) * 5 * PW;
                norm_mod(xb, F.g_mix() + (l + 1) * D, modn + mr * PW, modn + mr * PW + D, lane); store_row_bf16(F.H() + (size_t)rB * D, xb, lane); store_row_fp8(F.H8() + (size_t)rB * D, xb, lane); }
        }
    }
}

__device__ __forceinline__ void phase_norm1_l0(const Frame& F) {
    if (F.G != CTX_FUSED_G) { phase_norm1(F, 0, F.x(), F.ctx(), 0, MT, F.gw, F.NGW); return; }
    const int v = F.vcu; unsigned* const ctrN = (unsigned*)F.wsp(WS_CTL) + 8192 + 64 * 4;
    if (v < 32) { phase_norm1(F, 0, F.x(), F.ctx(), ML, MT, v * NWAVES + F.wave, 32 * NWAVES); ctr_signal(ctrN); }
    if (v >= 64 && v < 160) {
        ctr_wait(ctrN, 32u);
        const int t = v - 64;
        if (t < 48) { pg8::SchedPlainOne S; S.pm = ML / 256 + t / 12; S.pn = t % 12; S.pn0 = 0; S.A = (const char*)F.H(); S.B = (const char*)F.WinT(); S.atile = (size_t)256 * D * 2; S.btile = (size_t)256 * D * 2;
            pg8::EpiInProj E{(bf16_t*)F.wsp(0), F.gains(), F.gains() + 512};
            pg8::gemm_phase(F.lds, D, D, D, S, E); }
        else { const int t8 = t - 48; pg8::SchedPlainOne S; S.pm = ML / 256 + t8 / 12; S.pn = 12 + t8 % 12; S.pn0 = 12; S.A = (const char*)F.H8(); S.B = (const char*)F.WinT() + 6 * MiB; S.atile = (size_t)256 * D; S.btile = (size_t)256 * D;
            pg8::EpiInProjGate E{(bf16_t*)F.wsp(0)};
            pg8::gemm_phase(F.lds, D / 2, D / 2, D / 2, S, E); }
    } else { const int vv = v < 64 ? v : v - 96; phase_norm1(F, 0, F.x(), F.ctx(), 0, ML, vv * NWAVES + F.wave, (CTX_FUSED_G - 96) * NWAVES); }
}
__device__ __forceinline__ void phase_combine_ctx(const Frame& F, int l, bool dummy) {
    if (F.G != CTX_FUSED_G) { phase_combine(F, l, 0, MT, F.gw, F.NGW, true, dummy); return; }
    const int v = F.vcu; unsigned* const ctrC = (unsigned*)F.wsp(WS_CTL) + 8192 + 64 * 5;
    if (v < 32) { phase_combine(F, l, ML, MT, v * NWAVES + F.wave, 32 * NWAVES, true, dummy); ctr_signal(ctrC); }
    if (v >= 64 && v < 72) {
        ctr_wait(ctrC, 32u);
        const int t = v - 64;
        pg8::SchedPlainOne S; S.pm = ML / 256 + (t >> 1); S.pn = t & 1; S.pn0 = 0; S.A = (const char*)F.H(); S.B = (const char*)F.WinT(); S.atile = (size_t)256 * D * 2; S.btile = (size_t)256 * D * 2;
        pg8::EpiInProj E{(bf16_t*)F.wsp(0), F.gains() + (l + 1) * 256, F.gains() + 512};
        pg8::gemm_phase(F.lds, D, D, D, S, E);
    } else { const int vv = v < 64 ? v : v - 8; phase_combine(F, l, 0, ML, vv * NWAVES + F.wave, (CTX_FUSED_G - 8) * NWAVES, true, dummy); }
}

__device__ __forceinline__ Frame mkframe(LAS unsigned char* lds) {
    Frame F; F.lds = lds;
    int t = threadIdx.x; asm volatile("" : "+v"(t)); int bx = blockIdx.x; asm volatile("" : "+s"(bx)); int G = gridDim.x; asm volatile("" : "+s"(G));
    F.tid = t; F.lane = t & 63; F.wave = __builtin_amdgcn_readfirstlane(t >> 6); F.G = G; F.bx = bx;
    F.vcu = (G % 8 == 0) ? (bx % 8) * (G / 8) + bx / 8 : bx; F.gw = F.vcu * NWAVES + F.wave; F.NGW = G * NWAVES;
    return F;
}
constexpr int PH_PER_LAYER = 9, NPHASES = 2 + DEPTH * PH_PER_LAYER;

__global__ void __launch_bounds__(NTHR, 2) fwd_kernel(Args args) {
    extern __shared__ __attribute__((aligned(16))) unsigned char lds_raw[];
    LAS unsigned char* const lds = (LAS unsigned char*)lds_raw;
    const int tid0 = threadIdx.x;
    volatile LAS unsigned* MISC = (volatile LAS unsigned*)(lds + MISC_OFF);
    if (tid0 < 32) MISC[tid0] = 0u;
    if (tid0 < 23) { const unsigned long long pv = (tid0 < 21) ? (unsigned long long)args.in[tid0 < 21 ? tid0 : 0] : (tid0 == 21 ? (unsigned long long)args.out : (unsigned long long)args.ws);
        ((LAS unsigned long long*)(lds + TAB_OFF))[tid0] = pv; }
    unsigned char* ws = args.ws;
    __syncthreads();
    XcdBarrier bar; bar.bar = (unsigned*)(ws + WS_CTL) + 1024; bar.x = 0; bar.st = nullptr;
#if MK_ONE_LAUNCH
    bar = xcd_barrier_post((unsigned*)(ws + WS_CTL) + 1024, MISC + 8);
#endif
    const int lo = args.ph_lo, hi = args.ph_hi;
#ifndef PHMASK
#define PHMASK 0xFFFFFFFFu
#endif
#define IN(k) (lo <= (k) && (k) < hi)
#define PM(j) ((PHMASK >> (j)) & 1u)
#ifndef DUPMASK
#define DUPMASK 0u
#endif
#define REPS(j) (((DUPMASK >> (j)) & 1u) ? 2 : 1)
#if MK_ONE_LAUNCH
#ifndef SEAMREP
#define SEAMREP 1
#endif
#define SEAM(k) do { if (IN(k) && IN((k) + 1)) { for (int sr_ = 0; sr_ < SEAMREP; ++sr_) xcd_barrier(bar); } } while (0)
#else
#define SEAM(k) do { } while (0)
#endif

    for (int rp = 0; rp < REPS(11); ++rp) if (PM(11) && IN(0)) { const Frame F = mkframe(lds); phase_prologue(F); }
    SEAM(0);
    for (int rp = 0; rp < REPS(12); ++rp) if (PM(12) && IN(1)) { const Frame F = mkframe(lds); phase_norm1_l0(F); }
    SEAM(1);

    for (int l = 0; l < DEPTH; ++l) {
        const int pb = 2 + l * PH_PER_LAYER; const bool has_ctx = (l + 1 < DEPTH);
        for (int rp = 0; rp < REPS(0); ++rp) if (PM(0) && IN(pb + 0)) { const Frame F = mkframe(lds);
            { pg8::SchedPlain S; S.T.init((F.G == CTX_FUSED_G ? ML : MT) / 256, 12, F.G, F.bx);     S.A = (const char*)F.H(); S.B = (const char*)F.WinT(); S.atile = (size_t)256 * D * 2; S.btile = (size_t)256 * D * 2; S.pn0 = 0;
              pg8::EpiInProj E{(bf16_t*)F.wsp(0), F.gains() + l * 256, F.gains() + 512};
              pg8::gemm_phase(F.lds, D, D, D, S, E); }
            { pg8::SchedPlain S; S.T.init((has_ctx && F.G != CTX_FUSED_G ? MT : ML) / 256, 12, F.G, F.G - 1 - F.bx); S.A = (const char*)F.H8();     S.B = (const char*)F.WinT() + 6 * MiB; S.atile = (size_t)256 * D; S.btile = (size_t)256 * D; S.pn0 = 12;
              pg8::EpiInProjGate E{(bf16_t*)F.wsp(0)};
              pg8::gemm_phase(F.lds, D / 2, D / 2, D / 2, S, E); }
        }
        SEAM(pb + 0);
        for (int rp = 0; rp < REPS(1); ++rp) if (PM(1) && IN(pb + 1)) { const Frame F = mkframe(lds); phase_attention(F, l, has_ctx, rp == 0, rp > 0); }
        SEAM(pb + 1);
        for (int rp = 0; rp < REPS(2); ++rp) if (PM(2) && IN(pb + 2)) { const Frame F = mkframe(lds);
            pg8::SchedMerge S; S.T.init((has_ctx && !ctx_fused(F, has_ctx) ? MT : ML) / 256, D / 256, F.G, F.bx);     S.Q = (const char*)F.QKV(); S.C = (const char*)F.CONV(); S.W = (const char*)F.WbrT();
            pg8::EpiMerge E{(const unsigned char*)F.GATE(), F.H()};
            pg8::gemm_phase(F.lds, 512, QW, 512, S, E);
        }
        SEAM(pb + 2);
        for (int rp = 0; rp < REPS(3); ++rp) if (PM(3) && IN(pb + 3)) { const Frame F = mkframe(lds);
            pg8::SchedPlain S; S.T.init((has_ctx && !ctx_fused(F, has_ctx) ? MT : ML) / 256, D / 256, F.G, F.bx); S.A = (const char*)F.H(); S.B = (const char*)F.WoutT(); S.atile = (size_t)256 * D * 2; S.btile = (size_t)256 * D * 2; S.pn0 = 0;
            pg8::EpiOut E{F.DELTA(), F.mod() + (size_t)l * 5 * PW};
            pg8::gemm_phase(F.lds, D, D, D, S, E);
        }
        SEAM(pb + 3);
        for (int rp = 0; rp < REPS(4); ++rp) if (PM(4) && IN(pb + 4)) { const Frame F = mkframe(lds); phase_norm2_router(F, l, has_ctx); }
        SEAM(pb + 4);
        for (int rp = 0; rp < REPS(5); ++rp) if (PM(5) && IN(pb + 5)) { const Frame F = mkframe(lds); phase_topk(F, l, has_ctx); }
        SEAM(pb + 5);
        for (int rp = 0; rp < REPS(6); ++rp) if (PM(6) && IN(pb + 6)) { const Frame F = mkframe(lds);
            pg8::SchedMoE<true> S; S.G = F.G; S.v = F.vcu; S.nN = 8; S.has_ctx = has_ctx; S.A = (const char*)F.H8(); S.W = (const char*)F.WGU(); S.wexp = (size_t)2048 * D; S.idx = F.idx(); S.rb = D;
            pg8::EpiGU E{(unsigned char*)F.HID()};
            pg8::gemm_phase(F.lds, D / 2, D / 2, D / 2, S, E);
        }
        SEAM(pb + 6);
        for (int rp = 0; rp < REPS(7); ++rp) if (PM(7) && IN(pb + 7)) { const Frame F = mkframe(lds);
            pg8::SchedMoE<false> S; S.G = F.G; S.v = F.vcu; S.nN = 4; S.has_ctx = has_ctx; S.A = (const char*)F.HID(); S.W = (const char*)F.WD(); S.wexp = (size_t)D * EH; S.idx = nullptr; S.rb = EH;
            pg8::EpiDown E{F.XS()};
            pg8::gemm_phase(F.lds, EH / 2, EH / 2, EH / 2, S, E);
        }
        SEAM(pb + 7);
        for (int rp = 0; rp < REPS(8); ++rp) if (PM(8) && IN(pb + 8)) { const Frame F = mkframe(lds); if (has_ctx) phase_combine_ctx(F, l, rp > 0); else phase_combine(F, l, 0, ML, F.gw, F.NGW, l + 1 < DEPTH, rp > 0); }
        SEAM(pb + 8);
    }
}

extern "C" void kernel_launch(void* const* d_in, const int* in_sizes, int n_in, void* d_out, int out_size, void* d_ws, size_t ws_size, hipStream_t stream) {
    static int grid = 0;
    if (grid == 0) {
        if (n_in != 21 || out_size != ML * D || ws_size < WS_END) { fprintf(stderr, "kernel_launch: unexpected shapes (n_in %d, out %d, ws %zu)\n", n_in, out_size, ws_size); grid = -1; return; }
        int dev = 0, cus = 0, per_cu = 0;
        if (hipGetDevice(&dev) != hipSuccess || hipDeviceGetAttribute(&cus, hipDeviceAttributeMultiprocessorCount, dev) != hipSuccess) { grid = -1; return; }
        if (hipFuncSetAttribute((const void*)fwd_kernel, hipFuncAttributeMaxDynamicSharedMemorySize, LDS_BYTES) != hipSuccess) { fprintf(stderr, "kernel_launch: hipFuncSetAttribute failed\n"); grid = -1; return; }
        if (hipOccupancyMaxActiveBlocksPerMultiprocessor(&per_cu, (const void*)fwd_kernel, NTHR, LDS_BYTES) != hipSuccess || per_cu < 1) { fprintf(stderr, "kernel_launch: occupancy query reports %d\n", per_cu); }
        (void)hipGetLastError();
        grid = cus;
    }
    if (grid < 0) return;
    (void)hipMemsetAsync((char*)d_ws + WS_CTL, 0, CTL_ZERO_BYTES, stream);
    Args a{};
    for (int i = 0; i < 21; ++i) a.in[i] = (const float*)d_in[i];
    a.out = (float*)d_out; a.ws = (unsigned char*)d_ws;
#if MK_ONE_LAUNCH
    a.ph_lo = 0; a.ph_hi = NPHASES;
    hipLaunchKernelGGL(fwd_kernel, dim3(grid), dim3(NTHR), LDS_BYTES, stream, a);
#else
    for (int p = 0; p < NPHASES; ++p) { a.ph_lo = p; a.ph_hi = p + 1; hipLaunchKernelGGL(fwd_kernel, dim3(grid), dim3(NTHR), LDS_BYTES, stream, a); }
#endif
}
```

```cpp
#include <hip/hip_runtime.h>
#include <hip/hip_bf16.h>
#include <cmath>
#include <cstdio>
#include <cstdint>

#define GAS __attribute__((address_space(1)))
#define LAS __attribute__((address_space(3)))
typedef unsigned short bf16_t;
typedef short bf16x8 __attribute__((ext_vector_type(8)));
typedef short s16x4 __attribute__((ext_vector_type(4)));
typedef float f32x4 __attribute__((ext_vector_type(4)));
typedef float f32x16 __attribute__((ext_vector_type(16)));
typedef unsigned u32x4 __attribute__((ext_vector_type(4)));
typedef unsigned u32x2 __attribute__((ext_vector_type(2)));
typedef int v4i32 __attribute__((ext_vector_type(4)));
typedef int v8i32 __attribute__((ext_vector_type(8)));

#ifndef MK_ONE_LAUNCH
#define MK_ONE_LAUNCH 1
#endif

constexpr int D = 1024, NB = 4, SEQ = 8192, CTX = 256, DEPTH = 2;
constexpr int ML = NB * SEQ, MC = NB * CTX, MT = ML + MC;
constexpr int PW = 6144;
constexpr int QW = 1024, GW = 3072;
constexpr int OFF_QA = 0, OFF_QB = 512;
constexpr int KVROWS = SEQ + CTX;
constexpr int NE = 16, CAP = 1024, CAPC = 32, EH = 1024;
constexpr float EPS = 1e-6f;
constexpr float LOG2E = 1.4426950408889634f;
constexpr float QSCALE = 0.125f * LOG2E;
constexpr int NWAVES = 8, NTHR = 512;

constexpr size_t MiB = 1u << 20;
constexpr size_t WS_CTL = 0, CTL_ZERO_BYTES = 64 * 1024;
constexpr size_t WS_MOD = 1 * MiB;
constexpr size_t WS_GAINS = 1 * MiB + 768 * 1024;
constexpr size_t WS_XC = 2 * MiB;
constexpr size_t WS_AFF = 6 * MiB;
constexpr size_t WS_IDX = 9 * MiB;
constexpr size_t WS_GATEV = 11 * MiB;
constexpr size_t WS_INV = 13 * MiB;
constexpr size_t WS_WIN = 16 * MiB;
constexpr size_t WS_WBR = 28 * MiB;
constexpr size_t WS_WOUT = 31 * MiB;
constexpr size_t WS_H = 33 * MiB;
constexpr size_t WS_KA = 99 * MiB, WS_KB = 108 * MiB, WS_VTA = 117 * MiB, WS_VTB = 126 * MiB;
constexpr size_t WS_QKV = 135 * MiB;
constexpr size_t WS_CONV = 234 * MiB;
constexpr size_t WS_GATE = 333 * MiB;
constexpr size_t WS_XS = 135 * MiB;
constexpr size_t WS_HID = 271 * MiB;
constexpr size_t WS_WGU = 407 * MiB;
constexpr size_t WS_WD = 471 * MiB;
constexpr size_t WS_DELTA = 531 * MiB;
constexpr size_t WS_H8 = 597 * MiB;
constexpr size_t WS_XB16 = 432 * MiB;
constexpr size_t WS_END = 630 * MiB;
constexpr int MOE_ROWS_LAT = NB * NE * CAP;
constexpr int MOE_ROWS = MOE_ROWS_LAT + NE * 256;

constexpr int RING_BYTES = 131072, MISC_OFF = RING_BYTES, LDS_BYTES = 147456;

__device__ __forceinline__ unsigned cvt_pk_bf16(float lo, float hi) { unsigned r; asm("v_cvt_pk_bf16_f32 %0, %1, %2" : "=v"(r) : "v"(lo), "v"(hi)); return r; }
__device__ __forceinline__ float bf_lo(unsigned w) { return __uint_as_float(w << 16); }
__device__ __forceinline__ float bf_hi(unsigned w) { return __uint_as_float(w & 0xffff0000u); }
__device__ __forceinline__ float wave_sum(float v) {
#pragma unroll
    for (int o = 1; o < 64; o <<= 1) v += __shfl_xor(v, o);
    return v;
}
__device__ __forceinline__ float fast_sigmoid(float v) { return __builtin_amdgcn_rcpf(1.0f + __builtin_amdgcn_exp2f(-v * LOG2E)); }
#define LDS_WAIT() asm volatile("s_waitcnt lgkmcnt(0)" ::: "memory")

#define XB_TMO      128
#define XB_XCNT(j)  (256  + 64 * (j))
#define XB_XSUB(j)  (1280 + 64 * (j))
#define XB_XGEN(j)  (2304 + 64 * (j))
#define XB_TOP      3328
#define XB_TOPGEN   3392
#define XCD_BAR_WORDS 3456
#define XB_SPIN_CAP (1u << 18)

__device__ __forceinline__ unsigned xb_ld(unsigned* p)              { return __hip_atomic_load(p, __ATOMIC_RELAXED, __HIP_MEMORY_SCOPE_AGENT); }
__device__ __forceinline__ unsigned xb_add(unsigned* p, unsigned v) { return __hip_atomic_fetch_add(p, v, __ATOMIC_RELAXED, __HIP_MEMORY_SCOPE_AGENT); }
__device__ __forceinline__ unsigned xb_xcc_id() { return (unsigned)__builtin_amdgcn_s_getreg((3 << 11) | 20) & 0xFu; }
#define XB_SPIN(cond, bar) do { unsigned _sp = 0; while (cond) { __builtin_amdgcn_s_sleep(1); \
    if ((++_sp & 255u) == 0u) { if (xb_ld(&(bar)[XB_TMO])) break; if (_sp > XB_SPIN_CAP) { atomicAdd(&(bar)[XB_TMO], 1u); break; } } } } while (0)

struct XcdBarrier { unsigned* bar; unsigned x; volatile LAS unsigned* st; };

__device__ __forceinline__ XcdBarrier xcd_barrier_post(unsigned* bar, volatile LAS unsigned* st) {
    XcdBarrier b; b.bar = bar; b.x = xb_xcc_id(); b.st = st;
    if (threadIdx.x == 0) (void)xb_add(&bar[XB_XCNT(b.x)], 1u);
    return b;
}
__device__ __forceinline__ void xcd_barrier_complete(unsigned* bar, unsigned x, unsigned& nloc, unsigned& nx) {
    const unsigned G = gridDim.x * gridDim.y * gridDim.z;
    unsigned sum, cnt, mine, sp = 0u;
    for (;;) {
        sum = 0u; cnt = 0u; mine = 0u;
#pragma unroll
        for (unsigned j = 0; j < 16; ++j) { const unsigned c = xb_ld(&bar[XB_XCNT(j)]); sum += c; cnt += (c > 0u) ? 1u : 0u; mine = (j == x) ? c : mine; }
        if (sum == G) break;
        __builtin_amdgcn_s_sleep(1);
        if ((++sp & 255u) == 0u) { if (xb_ld(&bar[XB_TMO])) break; if (sp > XB_SPIN_CAP) { atomicAdd(&bar[XB_TMO], 1u); break; } }
    }
    nloc = mine > 0u ? mine : 1u; nx = cnt > 0u ? cnt : 1u;
}
__device__ __forceinline__ void xcd_barrier(const XcdBarrier& b) {
    asm volatile("s_waitcnt vmcnt(0)" ::: "memory");
    __syncthreads();
    if (threadIdx.x == 0) {
        unsigned* bar = b.bar;
        __builtin_amdgcn_s_waitcnt(0);
        unsigned nloc = b.st[0], nx = b.st[1];
        if (nloc == 0u) { xcd_barrier_complete(bar, b.x, nloc, nx); b.st[0] = nloc; b.st[1] = nx; }
        const unsigned old = xb_add(&bar[XB_XSUB(b.x)], 1u);
        const unsigned gen = old / nloc;
        if (old + 1u == (gen + 1u) * nloc) {
            __builtin_amdgcn_fence(__ATOMIC_RELEASE, "agent");
            asm volatile("s_waitcnt vmcnt(0)" ::: "memory");
            const unsigned og = xb_add(&bar[XB_TOP], 1u);
            const unsigned tg = og / nx;
            if (og + 1u == (tg + 1u) * nx) xb_add(&bar[XB_TOPGEN], 1u);
            else XB_SPIN(xb_ld(&bar[XB_TOPGEN]) == tg, bar);
            __builtin_amdgcn_fence(__ATOMIC_ACQUIRE, "agent");
            xb_add(&bar[XB_XGEN(b.x)], 1u);
            asm volatile("s_waitcnt vmcnt(0)" ::: "memory");
        } else {
            XB_SPIN(xb_ld(&bar[XB_XGEN(b.x)]) == gen, bar);
            __builtin_amdgcn_fence(__ATOMIC_ACQUIRE, "agent");
            asm volatile("s_waitcnt vmcnt(0)" ::: "memory");
        }
    }
    __syncthreads();
}

#ifndef PG8_ALIGN_EPI
#define PG8_ALIGN_EPI 1
#endif
#ifndef PG8_SP2
#define PG8_SP2 1
#endif
namespace pg8 {
constexpr int BM = 256, BK = 64, HALF = 128, HTB = HALF * BK * 2, STAGE_BYTES = 8 * HTB, NXCD = 8, WGM = 8;
__host__ __device__ __forceinline__ int lds_byte(int r, int c) { const int st = (r >> 4) * 2 + (c >> 5), rr = r & 15, cc = c & 31, ob = rr * 64 + cc * 2; return st * 1024 + (ob ^ (((ob >> 9) & 1) << 5)); }
__host__ __device__ __forceinline__ void stage_rc(int b, int& R, int& C) { const int st = b / 1024, sb = b % 1024, swz = sb ^ (((sb >> 9) & 1) << 5); R = (st >> 1) * 16 + swz / 64; C = (st & 1) * 32 + (swz % 64) / 2; }
__host__ __device__ __forceinline__ int perm32(int rho) { const int n = rho >> 4, i = rho & 15; return 8 * (i >> 2) + 4 * n + (i & 3); }

__device__ __forceinline__ void glds16_saddr(unsigned voff, const void* sbase, unsigned lds_dst) { unsigned keep;
    asm volatile("s_mov_b32 %0, m0\n\ts_mov_b32 m0, %3\n\ts_nop 0\n\tglobal_load_lds_dwordx4 %1, %2\n\ts_mov_b32 m0, %0" : "=&s"(keep) : "v"(voff), "s"(sbase), "s"(lds_dst) : "memory"); }
struct Unit { const char* a; const char* b; int pm, pn, aux; };

struct TileOrder {
    int nM, nN, nwg, G, c;
    __device__ __forceinline__ void init(int nM_, int nN_, int G_, int c_) { nM = nM_; nN = nN_; nwg = nM * nN; G = G_; c = c_; }
    __device__ __forceinline__ bool tile(int i, int& pm, int& pn) const { return tileL((long)i * G + c, pm, pn); }
    __device__ __forceinline__ bool tileL(const long L, int& pm, int& pn) const {
        if (L >= nwg) return false;
        int wgid = (int)L; { const int q = nwg / NXCD, r = nwg % NXCD, xcd = wgid % NXCD, off = wgid / NXCD; wgid = (xcd < r ? xcd * (q + 1) : r * (q + 1) + (xcd - r) * q) + off; }
        const int nig = WGM * nN, gid = wgid / nig, fm = gid * WGM, gsz = (nM - fm) < WGM ? (nM - fm) : WGM;
        pm = fm + ((wgid % nig) % gsz); pn = (wgid % nig) / gsz; return true;
    }
};

template <class Epi, class Sched>
__device__ __forceinline__ void gemm_phase(LAS unsigned char* lds, const int K, const int lda, const int ldb, const Sched& S, const Epi& E) {
    int tid_ = threadIdx.x; asm volatile("" : "+v"(tid_));
    const int tid = tid_, wid = __builtin_amdgcn_readfirstlane(tid >> 6), lane = tid & 63, wr = wid >> 2, wc = wid & 3, fr = lane & 15, fq = lane >> 4;
    const int nt = K / BK;
    unsigned voffA[2], voffB[2]; int Rr[2];
#pragma unroll
    for (int i = 0; i < 2; ++i) { int R, C; stage_rc(tid * 16 + i * 8192, R, C); const int Rb = Epi::PERM ? ((R & ~31) + perm32(R & 31)) : R;
        voffA[i] = Sched::GATHER ? (unsigned)C * 2u : (unsigned)(R * lda + C) * 2u; voffB[i] = (unsigned)(Rb * ldb + C) * 2u; Rr[i] = R; }
    unsigned gA0 = 0u, gA1 = 0u, nG0 = 0u, nG1 = 0u;
    const size_t kstep = (size_t)(BK * 2);
    const size_t hstepA = (size_t)HALF * lda * 2, hstepB = (size_t)HALF * ldb * 2;
    const unsigned ldsw = (unsigned)wid * 1024u;
    const unsigned ldsbase = (unsigned)__builtin_amdgcn_readfirstlane((int)((unsigned)(uintptr_t)lds + ldsw));
    const int aoff = lds_byte(wr * 64 + fr, fq * 8), boff = lds_byte(wc * 32 + fr, fq * 8);
#define PG8_SA(b, h) (((b) * 2 + (h)) * HTB)
#define PG8_SB(b, h) ((4 + (b) * 2 + (h)) * HTB)
#define PG8_STAGE(bufoff, gbase, voff) do { _Pragma("unroll") for (int _i = 0; _i < 2; ++_i) \
        glds16_saddr((voff)[_i], (const void*)(gbase), ldsbase + (unsigned)((bufoff) + _i * 8192)); } while (0)
#define PG8_STAGE_A(b, h, ptr_plain, ptr_gather, GO) do { if constexpr (Sched::GATHER) { const unsigned go_[2] = { ((GO) & 0xffffu) * S.rowbytes() + voffA[0], ((GO) >> 16) * S.rowbytes() + voffA[1] }; PG8_STAGE(PG8_SA(b, h), ptr_gather, go_); } \
        else PG8_STAGE(PG8_SA(b, h), ptr_plain, voffA); } while (0)
#define PG8_LDA(dst, b, h) do { _Pragma("unroll") for (int m = 0; m < 4; ++m) { \
        if constexpr (Epi::FP8) dst##8[m] = __builtin_shufflevector(*(const LAS v4i32*)(lds + PG8_SA(b, h) + aoff + m * 2048), *(const LAS v4i32*)(lds + PG8_SA(b, h) + aoff + m * 2048 + 1024), 0, 1, 2, 3, 4, 5, 6, 7); \
        else { _Pragma("unroll") for (int k = 0; k < 2; ++k) dst[m][k] = *(const LAS bf16x8*)(lds + PG8_SA(b, h) + aoff + m * 2048 + k * 1024); } } } while (0)
#define PG8_LDB(dst, b, h) do { _Pragma("unroll") for (int n = 0; n < 2; ++n) { \
        if constexpr (Epi::FP8) dst##8[n] = __builtin_shufflevector(*(const LAS v4i32*)(lds + PG8_SB(b, h) + boff + n * 2048), *(const LAS v4i32*)(lds + PG8_SB(b, h) + boff + n * 2048 + 1024), 0, 1, 2, 3, 4, 5, 6, 7); \
        else { _Pragma("unroll") for (int k = 0; k < 2; ++k) dst[n][k] = *(const LAS bf16x8*)(lds + PG8_SB(b, h) + boff + n * 2048 + k * 1024); } } } while (0)
#define PG8_MMA(ai, bj, At, Bt) do { __builtin_amdgcn_s_setprio(1); \
        if constexpr (Epi::FP8) {     \
            _Pragma("unroll") for (int m = 0; m < 4; ++m) _Pragma("unroll") for (int n = 0; n < 2; ++n) { \
                asm volatile("v_mfma_scale_f32_16x16x128_f8f6f4 %0, %1, %2, %0, %3, %3 op_sel_hi:[0,0,0]" : "+v"(acc[ai][bj][m][n]) : "v"(Bt##8[n]), "v"(At##8[m]), "v"(sc8)); }   \
        } else { \
            _Pragma("unroll") for (int m = 0; m < 4; ++m) _Pragma("unroll") for (int n = 0; n < 2; ++n) _Pragma("unroll") for (int k = 0; k < 2; ++k) \
                acc[ai][bj][m][n] = __builtin_amdgcn_mfma_f32_16x16x32_bf16(Bt[n][k], At[m][k], acc[ai][bj][m][n], 0, 0, 0); } \
        __builtin_amdgcn_s_setprio(0); } while (0)
#define PG8_WAIT_V(n) asm volatile("s_waitcnt vmcnt(" #n ")" ::: "memory")
#define PG8_WAIT_L(n) asm volatile("s_waitcnt lgkmcnt(" #n ")" ::: "memory")
#define PG8_BAR __builtin_amdgcn_s_barrier()
#define PG8_SCHED __builtin_amdgcn_sched_barrier(0)
    Unit cur, nxt; int ui = 0;
    if (!S.next(0, cur)) return;
    f32x4 acc[2][2][4][2];
#pragma unroll
    for (int a = 0; a < 2; ++a)
#pragma unroll
        for (int b = 0; b < 2; ++b)
#pragma unroll
            for (int m = 0; m < 4; ++m)
#pragma unroll
                for (int n = 0; n < 2; ++n) acc[a][b][m][n] = (f32x4){0.f, 0.f, 0.f, 0.f};
    const int sc8 = 0x7F7F7F7F;
    bf16x8 At[4][2], B0[2][2], B1[2][2]; v8i32 At8[4], B08[2], B18[2];
    const char* cA = cur.a; const char* cB = cur.b;
    if constexpr (Sched::GATHER) { S.rows(cur, tid, gA0, gA1); }
#if PG8_SP2
    PG8_STAGE(PG8_SB(0, 0), cB, voffB); PG8_STAGE(PG8_SB(0, 1), cB + hstepB, voffB); PG8_STAGE_A(0, 0, cA, cA, gA0); PG8_STAGE_A(0, 1, cA + hstepA, cA, gA1);
    if (wr == 1) PG8_BAR;
    PG8_WAIT_V(2); PG8_BAR;
    PG8_STAGE(PG8_SB(1, 0), cB + kstep, voffB); PG8_STAGE_A(1, 0, cA + kstep, cA + kstep, gA0); PG8_STAGE(PG8_SB(1, 1), cB + hstepB + kstep, voffB);
    PG8_WAIT_V(6); PG8_BAR;
#else
    PG8_STAGE(PG8_SB(0, 0), cB, voffB); PG8_STAGE_A(0, 0, cA, cA, gA0); PG8_STAGE(PG8_SB(0, 1), cB + hstepB, voffB); PG8_STAGE_A(0, 1, cA + hstepA, cA, gA1);
    if (wr == 1) PG8_BAR;
    PG8_WAIT_V(4); PG8_BAR;
    PG8_STAGE(PG8_SB(1, 0), cB + kstep, voffB); PG8_STAGE_A(1, 0, cA + kstep, cA + kstep, gA0); PG8_STAGE(PG8_SB(1, 1), cB + hstepB + kstep, voffB);
    PG8_WAIT_V(6); PG8_BAR;
#endif
    for (;;) {
        const bool has_next = S.next(ui + 1, nxt);
        const char* nA = has_next ? nxt.a : cA; const char* nB = has_next ? nxt.b : cB;
        if constexpr (Sched::GATHER) { if (has_next) S.rows(nxt, tid, nG0, nG1); else { nG0 = gA0; nG1 = gA1; } }
#pragma unroll 1
        for (int t = 0; t < nt; t += 2) {
            const bool last = (t == nt - 2);
            const char* a1 = cA + (size_t)(t + 1) * kstep;
            const char* a2 = last ? nA : cA + (size_t)(t + 2) * kstep; const char* b2 = last ? nB : cB + (size_t)(t + 2) * kstep;
            const char* a3 = a2 + kstep; const char* b3 = b2 + kstep;
            const unsigned s0 = last ? nG0 : gA0, s1 = last ? nG1 : gA1;
#if PG8_SP2
            PG8_LDB(B0, 0, 0); PG8_LDB(B1, 0, 1); PG8_SCHED; PG8_LDA(At, 0, 0); PG8_STAGE_A(1, 1, a1 + hstepA, a1, gA1);
            PG8_WAIT_V(8); PG8_WAIT_L(0); PG8_BAR; PG8_MMA(0, 0, At, B0); PG8_MMA(0, 1, At, B1); PG8_BAR; PG8_SCHED;
            PG8_LDA(At, 0, 1); PG8_STAGE(PG8_SB(0, 0), b2, voffB); PG8_STAGE(PG8_SB(0, 1), b2 + hstepB, voffB); PG8_STAGE_A(0, 0, a2, a2, s0);
            PG8_WAIT_V(8); PG8_WAIT_L(0); PG8_BAR; PG8_MMA(1, 0, At, B0); PG8_MMA(1, 1, At, B1); PG8_BAR; PG8_SCHED;
            PG8_LDB(B0, 1, 0); PG8_LDB(B1, 1, 1); PG8_SCHED; PG8_LDA(At, 1, 0); PG8_STAGE_A(0, 1, a2 + hstepA, a2, s1);
            PG8_WAIT_V(8); PG8_WAIT_L(0); PG8_BAR; PG8_MMA(0, 0, At, B0); PG8_MMA(0, 1, At, B1); PG8_BAR; PG8_SCHED;
            PG8_LDA(At, 1, 1); PG8_STAGE(PG8_SB(1, 0), b3, voffB); PG8_STAGE(PG8_SB(1, 1), b3 + hstepB, voffB); PG8_STAGE_A(1, 0, a3, a3, s0);
            PG8_WAIT_V(8); PG8_WAIT_L(0); PG8_BAR; PG8_MMA(1, 0, At, B0); PG8_MMA(1, 1, At, B1); PG8_BAR; PG8_SCHED;
#else
            PG8_LDB(B0, 0, 0); PG8_SCHED; PG8_LDA(At, 0, 0); PG8_STAGE_A(1, 1, a1 + hstepA, a1, gA1);
            PG8_WAIT_L(8); PG8_BAR; PG8_WAIT_L(0); PG8_MMA(0, 0, At, B0); PG8_BAR; PG8_SCHED;
            PG8_LDB(B1, 0, 1); PG8_STAGE(PG8_SB(0, 0), b2, voffB);
            PG8_BAR; PG8_WAIT_L(0); PG8_MMA(0, 1, At, B1); PG8_BAR;
            PG8_LDA(At, 0, 1); PG8_STAGE_A(0, 0, a2, a2, s0);
            PG8_BAR; PG8_WAIT_L(0); PG8_MMA(1, 0, At, B0); PG8_BAR; PG8_SCHED;
            PG8_STAGE(PG8_SB(0, 1), b2 + hstepB, voffB);
            PG8_WAIT_V(6); PG8_BAR; PG8_MMA(1, 1, At, B1); PG8_BAR;
            PG8_LDB(B0, 1, 0); PG8_SCHED; PG8_LDA(At, 1, 0); PG8_STAGE_A(0, 1, a2 + hstepA, a2, s1);
            PG8_WAIT_L(8); PG8_BAR; PG8_WAIT_L(0); PG8_MMA(0, 0, At, B0); PG8_BAR; PG8_SCHED;
            PG8_LDB(B1, 1, 1); PG8_STAGE(PG8_SB(1, 0), b3, voffB);
            PG8_BAR; PG8_WAIT_L(0); PG8_MMA(0, 1, At, B1); PG8_BAR;
            PG8_LDA(At, 1, 1); PG8_STAGE_A(1, 0, a3, a3, s0);
            PG8_BAR; PG8_WAIT_L(0); PG8_MMA(1, 0, At, B0); PG8_BAR; PG8_SCHED;
            PG8_STAGE(PG8_SB(1, 1), b3 + hstepB, voffB);
            PG8_WAIT_V(6); PG8_BAR; PG8_MMA(1, 1, At, B1); PG8_BAR;
#endif
        }
#if PG8_ALIGN_EPI
        if (wr == 0) PG8_BAR;
#endif
        if constexpr (Epi::FP8) asm volatile("s_nop 15\n\ts_nop 15" ::: "memory");
        { int t_ = tid; asm volatile("" : "+v"(t_)); const int fr_ = t_ & 15, fq_ = (t_ >> 4) & 3;
          E(acc, cur, wr, wc, fr_, fq_); }
        if (!has_next) break;
        bool keep_acc = false; if constexpr (Epi::CHAIN) keep_acc = E.keep(cur);
        if (!keep_acc) {
#pragma unroll
        for (int a = 0; a < 2; ++a)
#pragma unroll
            for (int b = 0; b < 2; ++b)
#pragma unroll
                for (int m = 0; m < 4; ++m)
#pragma unroll
                    for (int n = 0; n < 2; ++n) acc[a][b][m][n] = (f32x4){0.f, 0.f, 0.f, 0.f};
        }
        cur = nxt; cA = nA; cB = nB; ++ui;
        if constexpr (Sched::GATHER) { gA0 = nG0; gA1 = nG1; }
#if PG8_ALIGN_EPI
        if (wr == 1) PG8_BAR;
#endif
    }
    PG8_WAIT_V(0);
#if !PG8_ALIGN_EPI
    if (wr == 0) PG8_BAR;
#endif
    PG8_BAR;
#undef PG8_SA
#undef PG8_SB
#undef PG8_STAGE
#undef PG8_STAGE_A
#undef PG8_LDA
#undef PG8_LDB
#undef PG8_MMA
#undef PG8_WAIT_V
#undef PG8_WAIT_L
#undef PG8_BAR
#undef PG8_SCHED
}

struct SchedPlain {
    static constexpr bool GATHER = false;
    TileOrder T; const char* A; const char* B; size_t atile, btile; int pn0;
    int deal = 0, bx = 0;
    __device__ __forceinline__ bool next(int i, Unit& u) const {
        if (deal) { long L;
            if (i < 5) L = (long)i * 256 + bx;
            else if (i == 5) { if (bx < 48) return false; L = 1280 + (bx - 48); }
            else if (i == 6) { if (bx >= 48 && bx < 96) L = 1488 + (bx - 48); else if (bx >= 208) L = 1536 + (bx - 208); else return false; }
            else return false;
            if (!T.tileL(L, u.pm, u.pn)) return false; }
        else if (!T.tile(i, u.pm, u.pn)) return false;
        u.a = A + (size_t)u.pm * atile; u.b = B + (size_t)u.pn * btile; u.pn += pn0; u.aux = 0; return true; }
};
struct SchedMerge {
    static constexpr bool GATHER = false;
    TileOrder T; const char* Q; const char* C; const char* W;
    __device__ __forceinline__ bool next(int i, Unit& u) const { const int k = i % 3; if (!T.tile(i / 3, u.pm, u.pn)) return false;
        u.a = (k < 2 ? Q + (size_t)(512 * k) * 2 : C) + (size_t)u.pm * 256 * QW * 2; u.b = W + ((size_t)(k * 1024 + u.pn * 256) * 512) * 2; u.aux = k; return true; }
};
struct SchedMergeOne {
    static constexpr bool GATHER = false;
    int pm, pn; const char* Q; const char* C; const char* W;
    __device__ __forceinline__ bool next(int i, Unit& u) const { if (i >= 3) return false; const int k = i; u.pm = pm; u.pn = pn;
        u.a = (k < 2 ? Q + (size_t)(512 * k) * 2 : C) + (size_t)u.pm * 256 * QW * 2; u.b = W + ((size_t)(k * 1024 + u.pn * 256) * 512) * 2; u.aux = k; return true; }
};
struct SchedPlainOne {
    static constexpr bool GATHER = false;
    int pm, pn; const char* A; const char* B; size_t atile, btile;
    __device__ __forceinline__ bool next(int i, Unit& u) const { if (i >= 1) return false; u.pm = pm; u.pn = pn; u.a = A + (size_t)pm * atile; u.b = B + (size_t)pn * btile; u.aux = 0; return true; }
};
template <bool GATHER_> struct SchedMoE {
    static constexpr bool GATHER = GATHER_;
    int G, v, nN, has_ctx; const char* A; const char* W; size_t wexp; const int* idx; int rb;
    __device__ __forceinline__ bool next(int i, Unit& u) const {
        const int L = i * G + v, per = 4 * nN, nlat = 64 * per; int tm, e, pn;
        if (L < nlat) { const int g = L / per, r = L % per; tm = g * 4 + r / nN; pn = r % nN; e = g & 15; }
        else { const int L2 = L - nlat; if (!has_ctx || L2 >= 16 * nN) return false; e = L2 / nN; pn = L2 % nN; tm = 256 + e; }
        u.a = GATHER_ ? A : A + (size_t)tm * 256 * rb; u.b = W + (size_t)e * wexp + (size_t)pn * 256 * rb; u.pm = tm; u.pn = pn; u.aux = e; return true;
    }
    __device__ __forceinline__ unsigned srcrow(int tm, int j) const {
        const bool latent = tm < 256; const int e = tm - 256, b = (j >> 5) & 3, sl = j & 31;
        const int ix = latent ? tm * 256 + j : MOE_ROWS_LAT + (b * NE + e) * CAPC + sl;
        const int base = latent ? (tm >> 6) * SEQ : ML + b * CTX;
        const int v = idx[ix];
        return (latent || j < 128) ? (unsigned)(base + v) : 0u;
    }
    __device__ __forceinline__ unsigned rowbytes() const { return (unsigned)rb; }
    __device__ __forceinline__ void rows(const Unit& u, const int tid, unsigned& p0, unsigned& p1) const {
        int t_ = tid; asm volatile("" : "+v"(t_)); int r0, r1, c_; stage_rc(t_ * 16, r0, c_); stage_rc(t_ * 16 + 8192, r1, c_);
        p0 = srcrow(u.pm, r0) | (srcrow(u.pm, r1) << 16); p1 = srcrow(u.pm, 128 + r0) | (srcrow(u.pm, 128 + r1) << 16);
    }
};

__device__ __forceinline__ unsigned pack4_fp8(float a, float b, float c, float d) {
    unsigned w; asm("v_cvt_pk_fp8_f32 %0, %1, %2" : "=v"(w) : "v"(a), "v"(b)); asm("v_cvt_pk_fp8_f32 %0, %1, %2 op_sel:[0,0,1]" : "+v"(w) : "v"(c), "v"(d)); return w; }
constexpr float WSCALE = 32.0f, WDESCALE = 1.0f / 32.0f;
#ifndef EPI_NT
#define EPI_NT 1
#endif
#if EPI_NT
#define EPI_ST16(p, v) __builtin_nontemporal_store((v), (u32x4*)(p))
#else
#define EPI_ST16(p, v) (*(u32x4*)(p) = (v))
#endif
struct EpiInProj {
    static constexpr bool PERM = true, CHAIN = false, FP8 = false;
    bf16_t* W0;
    const float* gains;
    const float* rope;
    __device__ __forceinline__ void operator()(f32x4 (&acc)[2][2][4][2], const Unit& u, int wr, int wc, int fr, int fq) const {
        if (u.pn < 6) {
            const int hg = u.pn * 4 + wc;
            const bool isv = (hg < 8) && ((hg & 2) != 0), isq = hg >= 8, lat = u.pm < 128;
            const int b = lat ? (u.pm >> 5) : (u.pm - 128);
            const int gsel = (hg < 8) ? ((hg & 4) ? 1 : 0) : (hg < 16 ? 2 : 3);
            const float* gp = gains + gsel * 64 + 8 * fq;
            const f32x4 g1a = *(const f32x4*)gp, g1b = *(const f32x4*)(gp + 4), g2a = *(const f32x4*)(gp + 32), g2b = *(const f32x4*)(gp + 36);
            float frq[8];
            { const f32x4 fa = *(const f32x4*)(rope + 8 * (fq & 1)), fb = *(const f32x4*)(rope + 8 * (fq & 1) + 4); frq[0] = fa[0]; frq[1] = fa[1]; frq[2] = fa[2]; frq[3] = fa[3]; frq[4] = fb[0]; frq[5] = fb[1]; frq[6] = fb[2]; frq[7] = fb[3]; }
            bf16_t* dbase; size_t dpitch; int prow0;
            if (isq) { dbase = W0 + WS_QKV / 2 + OFF_QA + (hg - 8) * 64 + 8 * fq; dpitch = QW; prow0 = u.pm * BM; }
            else { const size_t off = (hg & 4) ? (isv ? WS_VTB : WS_KB) : (isv ? WS_VTA : WS_KA);
                dbase = W0 + off / 2 + (size_t)(b * 2 + (hg & 1)) * KVROWS * 64 + 8 * fq; dpitch = 64; prow0 = lat ? (u.pm & 31) * BM : SEQ; }
#pragma unroll
            for (int ai = 0; ai < 2; ++ai)
#pragma unroll
                for (int m = 0; m < 4; ++m) {
                    const int rt = ai * HALF + wr * 64 + m * 16 + fr;
                    float x1[8], x2[8];
#pragma unroll
                    for (int e = 0; e < 4; ++e) { x1[e] = acc[ai][0][m][0][e]; x1[4 + e] = acc[ai][0][m][1][e]; x2[e] = acc[ai][1][m][0][e]; x2[4 + e] = acc[ai][1][m][1][e]; }
                    if (!isv) {
                        float ss = 0.f;
#pragma unroll
                        for (int e = 0; e < 8; ++e) ss += x1[e] * x1[e] + x2[e] * x2[e];
                        ss += __shfl_xor(ss, 16); ss += __shfl_xor(ss, 32);
                        const float rinv = 1.0f / sqrtf(ss * (1.0f / 64.0f) + EPS);
#pragma unroll
                        for (int e = 0; e < 4; ++e) { x1[e] *= rinv * g1a[e]; x1[4 + e] *= rinv * g1b[e]; x2[e] *= rinv * g2a[e]; x2[4 + e] *= rinv * g2b[e]; }
                        if (lat) {
                            const int rowpos = 4 * (u.pm & 31) + 2 * ai + wr, colpos = 16 * m + fr;
                            const float posf = (float)((fq < 2) ? rowpos : colpos);
#pragma unroll
                            for (int e = 0; e < 8; ++e) { const float ang = posf * frq[e];
                                const float rev = ang * 0.15915494309189535f, cse = __builtin_amdgcn_cosf(rev), sne = __builtin_amdgcn_sinf(rev);
                                const float a1 = x1[e], a2 = x2[e]; x1[e] = a1 * cse - a2 * sne; x2[e] = a2 * cse + a1 * sne; }
                        }
                        if (isq) {
#pragma unroll
                            for (int e = 0; e < 8; ++e) { x1[e] *= QSCALE; x2[e] *= QSCALE; }
                        }
                    }
                    u32x4 w1, w2; w1.x = cvt_pk_bf16(x1[0], x1[1]); w1.y = cvt_pk_bf16(x1[2], x1[3]); w1.z = cvt_pk_bf16(x1[4], x1[5]); w1.w = cvt_pk_bf16(x1[6], x1[7]);
                    w2.x = cvt_pk_bf16(x2[0], x2[1]); w2.y = cvt_pk_bf16(x2[2], x2[3]); w2.z = cvt_pk_bf16(x2[4], x2[5]); w2.w = cvt_pk_bf16(x2[6], x2[7]);
                    bf16_t* dp = dbase + (size_t)(prow0 + rt) * dpitch;
                    *(u32x4*)dp = w1; *(u32x4*)(dp + 32) = w2;
                }
            return;
        }
        if (u.pn >= 8 && u.pn < 12) {
            const int row0 = u.pm * BM + wr * 64 + fr, col0 = 512 + (u.pn - 8) * HALF + wc * 32 + 8 * fq;
#pragma unroll
            for (int ai = 0; ai < 2; ++ai)
#pragma unroll
                for (int m = 0; m < 4; ++m) { const f32x4 c0 = acc[ai][0][m][0], c1 = acc[ai][0][m][1], x0 = acc[ai][1][m][0], x1v = acc[ai][1][m][1];
                    u32x4 w; w.x = cvt_pk_bf16(c0[0] * x0[0], c0[1] * x0[1]); w.y = cvt_pk_bf16(c0[2] * x0[2], c0[3] * x0[3]); w.z = cvt_pk_bf16(c1[0] * x1v[0], c1[1] * x1v[1]); w.w = cvt_pk_bf16(c1[2] * x1v[2], c1[3] * x1v[3]);
                    EPI_ST16(W0 + WS_CONV / 2 + (size_t)(row0 + ai * HALF + m * 16) * QW + col0, w); }
            return;
        }
        const int pnl = u.pn - 6;
        const int row0 = u.pm * BM + wr * 64 + fr, col0 = pnl * BM + wc * 32 + 8 * fq;
        bf16_t* const cbase = W0 + WS_CONV / 2;
#pragma unroll
        for (int ai = 0; ai < 2; ++ai)
#pragma unroll
            for (int m = 0; m < 4; ++m) { bf16_t* rowp = cbase + (size_t)(row0 + ai * HALF + m * 16) * QW + col0;
#pragma unroll
                for (int bj = 0; bj < 2; ++bj) { const f32x4 v0 = acc[ai][bj][m][0], v1 = acc[ai][bj][m][1];
                    u32x4 w; w.x = cvt_pk_bf16(v0[0], v0[1]); w.y = cvt_pk_bf16(v0[2], v0[3]); w.z = cvt_pk_bf16(v1[0], v1[1]); w.w = cvt_pk_bf16(v1[2], v1[3]);
                    EPI_ST16(rowp + bj * HALF, w); } }
    }
};
struct EpiInProjGate {
    static constexpr bool PERM = true, CHAIN = false, FP8 = true;
    bf16_t* W0;
    __device__ __forceinline__ void operator()(f32x4 (&acc)[2][2][4][2], const Unit& u, int wr, int wc, int fr, int fq) const {
        unsigned char* const gt8 = (unsigned char*)W0 + WS_GATE + ((size_t)(u.pm * 12 + (u.pn - 12)) << 16) + (size_t)(((wr * 4 + wc) * 64) + fq * 16 + fr) * 16;
#pragma unroll
        for (int ai = 0; ai < 2; ++ai)
#pragma unroll
            for (int m = 0; m < 4; ++m) { unsigned qb[4];
#pragma unroll
                for (int bj = 0; bj < 2; ++bj)
#pragma unroll
                    for (int n = 0; n < 2; ++n) { unsigned wv = 0u;
#pragma unroll
                        for (int j = 0; j < 4; ++j) { const float ex = __builtin_amdgcn_exp2f(acc[ai][bj][m][n][j] * (-WDESCALE * LOG2E));
                            const float r256 = __builtin_amdgcn_rcpf(__builtin_fmaf(ex, 1.0f / 256.0f, 1.0f / 256.0f)); const unsigned q = (unsigned)fminf(r256, 255.0f); wv |= q << (8 * j); }
                        qb[bj * 2 + n] = wv; }
                EPI_ST16(gt8 + (size_t)((ai * 4 + m) * 512) * 16, ((u32x4){qb[0], qb[1], qb[2], qb[3]})); }
    }
};
struct EpiMerge {
    static constexpr bool PERM = true, CHAIN = true, FP8 = false;
    const unsigned char* Gt; bf16_t* Mg;
    __device__ __forceinline__ bool keep(const Unit& u) const { return u.aux < 2; }
    __device__ __forceinline__ void operator()(f32x4 (&acc)[2][2][4][2], const Unit& u, int wr, int wc, int fr, int fq) const {
        const int row0 = u.pm * BM + wr * 64 + fr, col0 = u.pn * BM + wc * 32 + 8 * fq; const int k = u.aux;
        const unsigned char* const gt8 = Gt + ((size_t)(u.pm * 12 + 4 * k + u.pn) << 16) + (size_t)(((wr * 4 + wc) * 64) + fq * 16 + fr) * 16;
        u32x4 g[2][4], q[2][4];
#pragma unroll
        for (int ai = 0; ai < 2; ++ai)
#pragma unroll
            for (int m = 0; m < 4; ++m) { const unsigned char* gp = gt8 + (size_t)((ai * 4 + m) * 512) * 16;
                g[ai][m] = *(const u32x4*)gp; if (k < 2) q[ai][m] = *(const u32x4*)(gp + ((size_t)4 << 16)); }
        asm volatile("" ::: "memory");
#pragma unroll
        for (int ai = 0; ai < 2; ++ai)
#pragma unroll
            for (int m = 0; m < 4; ++m)
#pragma unroll
                for (int bj = 0; bj < 2; ++bj) {
                    const unsigned g0w = bj ? g[ai][m].z : g[ai][m].x, g1w = bj ? g[ai][m].w : g[ai][m].y;
                    float gk[8];
#pragma unroll
                    for (int j = 0; j < 4; ++j) { gk[j] = ((float)((g0w >> (8 * j)) & 255u) + 0.5f) * (1.0f / 256.0f); gk[4 + j] = ((float)((g1w >> (8 * j)) & 255u) + 0.5f) * (1.0f / 256.0f); }
                    if (k < 2) {
                        const unsigned q0w = bj ? q[ai][m].z : q[ai][m].x, q1w = bj ? q[ai][m].w : q[ai][m].y;
#pragma unroll
                        for (int j = 0; j < 4; ++j) { const float d0 = (float)((q0w >> (8 * j)) & 255u) + 0.5f, d1 = (float)((q1w >> (8 * j)) & 255u) + 0.5f;
                            acc[ai][bj][m][0][j] *= (gk[j] * 256.0f) * __builtin_amdgcn_rcpf(d0); acc[ai][bj][m][1][j] *= (gk[4 + j] * 256.0f) * __builtin_amdgcn_rcpf(d1); }
                    } else {
                        const f32x4 v0 = acc[ai][bj][m][0], v1 = acc[ai][bj][m][1];
                        u32x4 w; w.x = cvt_pk_bf16(v0[0] * gk[0], v0[1] * gk[1]); w.y = cvt_pk_bf16(v0[2] * gk[2], v0[3] * gk[3]); w.z = cvt_pk_bf16(v1[0] * gk[4], v1[1] * gk[5]); w.w = cvt_pk_bf16(v1[2] * gk[6], v1[3] * gk[7]);
                        *(u32x4*)(Mg + (size_t)(row0 + ai * HALF + m * 16) * D + col0 + bj * HALF) = w;
                    }
                }
    }
};
struct EpiOut {
    static constexpr bool PERM = true, CHAIN = false, FP8 = false;
    bf16_t* Dl; const float* modl;
    const float* xf; const float* xcf; const bf16_t* xb16;
    __device__ __forceinline__ void operator()(f32x4 (&acc)[2][2][4][2], const Unit& u, int wr, int wc, int fr, int fq) const {
        const int mr = (u.pm < 128) ? (u.pm >> 5) : 4;
        const float* gt = modl + mr * PW + 2 * D;
        const int row0 = u.pm * BM + wr * 64 + fr, col0 = u.pn * BM + wc * 32 + 8 * fq;
        f32x4 gv[2][2];
#pragma unroll
        for (int bj = 0; bj < 2; ++bj)
#pragma unroll
            for (int n = 0; n < 2; ++n) gv[bj][n] = *(const f32x4*)(gt + col0 + bj * HALF + 4 * n);
#pragma unroll
        for (int ai = 0; ai < 2; ++ai)
#pragma unroll
            for (int m = 0; m < 4; ++m) { const int row = row0 + ai * HALF + m * 16; bf16_t* rowp = Dl + (size_t)row * D + col0;
                f32x4 xa[2], xb[2];
                if (xb16) {
#pragma unroll
                    for (int bj = 0; bj < 2; ++bj) { const u32x4 t = *(const u32x4*)(xb16 + (size_t)row * D + col0 + bj * HALF); xa[bj] = (f32x4){bf_lo(t.x), bf_hi(t.x), bf_lo(t.y), bf_hi(t.y)}; xb[bj] = (f32x4){bf_lo(t.z), bf_hi(t.z), bf_lo(t.w), bf_hi(t.w)}; }
                } else { const float* xr = (u.pm < 128 ? xf + (size_t)row * D : xcf + (size_t)(row - ML) * D) + col0;
#pragma unroll
                    for (int bj = 0; bj < 2; ++bj) { xa[bj] = *(const f32x4*)(xr + bj * HALF); xb[bj] = *(const f32x4*)(xr + bj * HALF + 4); } }
#pragma unroll
                for (int bj = 0; bj < 2; ++bj) { const f32x4 v0 = xa[bj] + acc[ai][bj][m][0] * gv[bj][0], v1 = xb[bj] + acc[ai][bj][m][1] * gv[bj][1];
                    u32x4 w; w.x = cvt_pk_bf16(v0[0], v0[1]); w.y = cvt_pk_bf16(v0[2], v0[3]); w.z = cvt_pk_bf16(v1[0], v1[1]); w.w = cvt_pk_bf16(v1[2], v1[3]);
                    *(u32x4*)(rowp + bj * HALF) = w; } }
    }
};
struct EpiGU {
    static constexpr bool PERM = true, CHAIN = false, FP8 = true;
    unsigned char* Hd;
    __device__ __forceinline__ void operator()(f32x4 (&acc)[2][2][4][2], const Unit& u, int wr, int wc, int fr, int fq) const {
        const int row0 = u.pm * BM + wr * 64 + fr, col0 = u.pn * HALF + wc * 32 + 8 * fq;
#pragma unroll
        for (int ai = 0; ai < 2; ++ai)
#pragma unroll
            for (int m = 0; m < 4; ++m) { unsigned char* rowp = Hd + (size_t)(row0 + ai * HALF + m * 16) * EH + col0;
                float o[8];
#pragma unroll
                for (int n = 0; n < 2; ++n)
#pragma unroll
                    for (int j = 0; j < 4; ++j) { const float a = acc[ai][0][m][n][j] * WDESCALE, uu = acc[ai][1][m][n][j] * WDESCALE; o[4 * n + j] = a * fast_sigmoid(a) * uu; }
                u32x2 w; w.x = pack4_fp8(o[0], o[1], o[2], o[3]); w.y = pack4_fp8(o[4], o[5], o[6], o[7]);
                __builtin_nontemporal_store(w, (u32x2*)rowp); }
    }
};
struct EpiDown {
    static constexpr bool PERM = true, CHAIN = false, FP8 = true;
    bf16_t* Y;
    __device__ __forceinline__ void operator()(f32x4 (&acc)[2][2][4][2], const Unit& u, int wr, int wc, int fr, int fq) const {
        const int row0 = u.pm * BM + wr * 64 + fr, col0 = u.pn * BM + wc * 32 + 8 * fq;
#pragma unroll
        for (int ai = 0; ai < 2; ++ai)
#pragma unroll
            for (int m = 0; m < 4; ++m) { bf16_t* rowp = Y + (size_t)(row0 + ai * HALF + m * 16) * D + col0;
#pragma unroll
                for (int bj = 0; bj < 2; ++bj) { const f32x4 v0 = acc[ai][bj][m][0] * WDESCALE, v1 = acc[ai][bj][m][1] * WDESCALE;
                    u32x4 w; w.x = cvt_pk_bf16(v0[0], v0[1]); w.y = cvt_pk_bf16(v0[2], v0[3]); w.z = cvt_pk_bf16(v1[0], v1[1]); w.w = cvt_pk_bf16(v1[2], v1[3]);
                    EPI_ST16(rowp + bj * HALF, w); } }
    }
};
}

namespace ab {
using bf16=__hip_bfloat16;
using bf16x8=__attribute__((ext_vector_type(8)))short;
using s16x4=__attribute__((ext_vector_type(4)))short;
using f32x16=__attribute__((ext_vector_type(16)))float;
using u32x4=__attribute__((ext_vector_type(4)))unsigned;
constexpr int D=64, QP=1024, KP=64;
constexpr int NW=8,QBLK=32,QB=QBLK*NW,KVBLK=64;
__device__ __forceinline__ int crow(int r,int hi){return (r&3)+8*(r>>2)+4*hi;}
#define SBAR() __builtin_amdgcn_sched_barrier(0)
constexpr int NSLOT=3, SLOTB=8192;
constexpr int LDS_K=0, LDS_V=NSLOT*SLOTB, LDS_WS=2*NSLOT*SLOTB, LDS_OST=LDS_WS+NW*64*4, LDS_BYTES=LDS_OST+NW*4096;
constexpr float C2=0.125f*1.4426950408889634f;
__device__ __forceinline__ void glds16(const void*gsrc,unsigned lds_dst){unsigned keep;
  asm volatile("s_mov_b32 %0, m0\n\ts_mov_b32 m0, %2\n\ts_nop 0\n\tglobal_load_lds_dwordx4 %1, off\n\ts_mov_b32 m0, %0":"=&s"(keep):"v"(gsrc),"s"(lds_dst):"memory");}
__device__ __forceinline__ float max3f(float a,float b,float c){float r;asm("v_max3_f32 %0, %1, %2, %3":"=v"(r):"v"(a),"v"(b),"v"(c));return r;}
__device__ __forceinline__ float max2f(float a,float b){float r;asm("v_max_f32_e32 %0, %1, %2":"=v"(r):"v"(a),"v"(b));return r;}
__device__ __forceinline__ float fadd_s(float a,float b){float r;asm("v_add_f32_e32 %0, %1, %2":"=v"(r):"v"(a),"v"(b));return r;}
__device__ __forceinline__ float fsub_s(float a,float b){float r;asm("v_sub_f32_e32 %0, %1, %2":"=v"(r):"v"(a),"v"(b));return r;}
typedef float f32x2_t __attribute__((ext_vector_type(2))); typedef __bf16 bf16x2_t __attribute__((ext_vector_type(2)));
__device__ __forceinline__ unsigned cvtpk_s(float lo,float hi){f32x2_t v={lo,hi};bf16x2_t b=__builtin_convertvector(v,bf16x2_t);return __builtin_bit_cast(unsigned,b);}
#define WAIT_BAR(N) asm volatile("s_waitcnt vmcnt(" #N ") lgkmcnt(0)\n\ts_barrier":::"memory")

__device__ __forceinline__ void qkt(f32x16&p0,f32x16&p1,const char*Kslot,const bf16x8*qr,const f32x16&negm,int r32,int hi){
  const char*kb=Kslot+hi*1024+r32*16;
  #pragma unroll
  for(int d0=0;d0<4;++d0){
    const bf16x8 b0=*reinterpret_cast<const bf16x8*>(kb+d0*2048);
    const bf16x8 b1=*reinterpret_cast<const bf16x8*>(kb+d0*2048+512);
    if(d0==0){p0=__builtin_amdgcn_mfma_f32_32x32x16_bf16(b0,qr[0],negm,0,0,0);p1=__builtin_amdgcn_mfma_f32_32x32x16_bf16(b1,qr[0],negm,0,0,0);}
    else{p0=__builtin_amdgcn_mfma_f32_32x32x16_bf16(b0,qr[d0],p0,0,0,0);p1=__builtin_amdgcn_mfma_f32_32x32x16_bf16(b1,qr[d0],p1,0,0,0);}}
}
typedef __attribute__((address_space(3))) const char* lds_cptr;
typedef short v4i16_t __attribute__((ext_vector_type(4)));
__device__ __forceinline__ void kload8(bf16x8*kf,lds_cptr kp){
  kf[0]=*(const __attribute__((address_space(3))) bf16x8*)(kp);      kf[1]=*(const __attribute__((address_space(3))) bf16x8*)(kp+512);
  kf[2]=*(const __attribute__((address_space(3))) bf16x8*)(kp+2048); kf[3]=*(const __attribute__((address_space(3))) bf16x8*)(kp+2560);
  kf[4]=*(const __attribute__((address_space(3))) bf16x8*)(kp+4096); kf[5]=*(const __attribute__((address_space(3))) bf16x8*)(kp+4608);
  kf[6]=*(const __attribute__((address_space(3))) bf16x8*)(kp+6144); kf[7]=*(const __attribute__((address_space(3))) bf16x8*)(kp+6656);
}
__device__ __forceinline__ void kload2(bf16x8*kf,lds_cptr kp,int j){ kf[2*j]=*(const __attribute__((address_space(3))) bf16x8*)(kp+j*2048); kf[2*j+1]=*(const __attribute__((address_space(3))) bf16x8*)(kp+j*2048+512); }
__device__ __forceinline__ s16x4 vtr(lds_cptr p){ return __builtin_bit_cast(s16x4,__builtin_amdgcn_ds_read_tr16_b64_v4i16((__attribute__((address_space(3))) v4i16_t*)p)); }
__device__ __forceinline__ float rowmax(const f32x16&p0,const f32x16&p1){
  float a=max3f(p0[0],p0[1],p1[0]),b=max3f(p0[2],p0[3],p1[1]);a=max3f(a,p1[2],p1[3]);
  #pragma unroll
  for(int r=4;r<16;r+=4){a=max3f(a,p0[r],p0[r+1]);b=max3f(b,p0[r+2],p0[r+3]);a=max3f(a,p1[r],p1[r+1]);b=max3f(b,p1[r+2],p1[r+3]);}
  const float m=max2f(a,b);
  auto rr=__builtin_amdgcn_permlane32_swap(__float_as_uint(m),__float_as_uint(m),false,false);
  return max2f(__uint_as_float(rr[0]),__uint_as_float(rr[1]));
}
__device__ __forceinline__ void pv(f32x16*o,int vb,bf16x8 pa0,bf16x8 pa1,bf16x8 pa2,bf16x8 pa3){
  #pragma unroll
  for(int d0=0;d0<2;++d0){s16x4 lo[4],hi[4];
    #pragma unroll
    for(int ks=0;ks<4;++ks){
      asm volatile("ds_read_b64_tr_b16 %0,%1 offset:%c2":"=&v"(lo[ks]):"v"(vb),"i"(d0*4096+ks*1024):"memory");
      asm volatile("ds_read_b64_tr_b16 %0,%1 offset:%c2":"=&v"(hi[ks]):"v"(vb),"i"(d0*4096+ks*1024+512):"memory");}
    asm volatile("s_waitcnt lgkmcnt(0)":::"memory");SBAR();
    #define PK(k) (bf16x8){lo[k][0],lo[k][1],lo[k][2],lo[k][3],hi[k][0],hi[k][1],hi[k][2],hi[k][3]}
    o[d0]=__builtin_amdgcn_mfma_f32_32x32x16_bf16(pa0,PK(0),o[d0],0,0,0);
    o[d0]=__builtin_amdgcn_mfma_f32_32x32x16_bf16(pa1,PK(1),o[d0],0,0,0);
    o[d0]=__builtin_amdgcn_mfma_f32_32x32x16_bf16(pa2,PK(2),o[d0],0,0,0);
    o[d0]=__builtin_amdgcn_mfma_f32_32x32x16_bf16(pa3,PK(3),o[d0],0,0,0);
    #undef PK
  }
}

#ifndef ATTN_STORE16
#define ATTN_STORE16(p,v) (*(u32x4*)(p)=(v))
#endif
template<int THRL,bool WIN,bool HAS_SINK,bool NOMAX> __device__ __forceinline__ void attn_unit(const bf16*Qu,const bf16*__restrict__ Kh,const bf16*__restrict__ Vh,bf16*Ou,const int NT,char*shm,const int tid_in,const int lo,const int q0,const float sink2,const float mfix){
  int tid_o=tid_in; asm volatile("":"+v"(tid_o)); const int tid=tid_o;
  const int lane=tid&63,r32=lane&31,hi=lane>>5; const int wid=__builtin_amdgcn_readfirstlane(tid>>6);
  const bf16*Qw=Qu+(long)(wid*QBLK)*QP;
  const unsigned lds0=(unsigned)(uintptr_t)shm;
  float*wsf=(float*)(shm+LDS_WS)+wid*64;
  const bf16*ksrc=Kh+(long)lane*KP+wid*8;
  const bf16*vsrc=Vh+(long)(16*(wid&3)+(lane>>2))*KP+(wid>>2)*32+(lane&3)*8;
  const unsigned kdst=lds0+LDS_K+wid*1024, vdst=lds0+LDS_V+wid*1024;
  #define KVROW(t) (WIN ? (((t)<4) ? (long)(::SEQ+64*(t)) : (long)(64*(lo-4+(t)))) : (long)(t)*KVBLK)
  #define DMA_K(t,slot) glds16(ksrc+KVROW(t)*KP,(unsigned)__builtin_amdgcn_readfirstlane(kdst+(slot)))
  #define DMA_V(t,slot) glds16(vsrc+KVROW(t)*KP,(unsigned)__builtin_amdgcn_readfirstlane(vdst+(slot)))
  const int vb0=(int)(lds0+LDS_V)+((lane>>4)&1)*32+(lane&3)*8+(4*hi+((lane&15)>>2))*64;
  const char*Kbase=shm+LDS_K; bf16x8 kf[8];
  const lds_cptr shm3=(lds_cptr)shm; const lds_cptr kp0=shm3+LDS_K+hi*1024+r32*16; const lds_cptr vp0=shm3+LDS_V+((lane>>4)&1)*32+(lane&3)*8+(4*hi+((lane&15)>>2))*64;
  DMA_K(0,0);DMA_V(0,0);DMA_K(1,SLOTB);
  bf16x8 qr[4];
  #pragma unroll
  for(int d0=0;d0<4;++d0)qr[d0]=*reinterpret_cast<const bf16x8*>(&Qw[(long)r32*QP+d0*16+hi*8]);
  float mhat=NOMAX?mfix:0.f,l_reg=0.f;f32x16 o[2];o[0]=f32x16{};o[1]=f32x16{};f32x16 negm=f32x16{};
  if constexpr(NOMAX){ _Pragma("unroll") for(int r=0;r<16;++r)negm[r]=-mfix; }
  asm volatile("":"+v"(negm));
  const int qpos_=q0+wid*QBLK+r32;
  #define CMASK(P0,P1,t) do{ if(WIN && (t)>=4){ const int d0_=64*(lo-4+(t))+4*hi-qpos_; \
      _Pragma("unroll") for(int r=0;r<16;++r){ const int d_=d0_+(r&3)+8*(r>>2); if(d_>128||d_<-128)P0[r]=-INFINITY; if(d_+32>128||d_+32<-128)P1[r]=-INFINITY; } } }while(0)
  bool resc=false;
  #define START(P0,P1) do{ resc=false; if constexpr(!NOMAX) { const float rm=rowmax(P0,P1); \
      const float dl=rm; mhat=fadd_s(mhat,dl); \
      _Pragma("unroll") for(int r=0;r<16;++r){P0[r]=fsub_s(P0[r],dl);P1[r]=fsub_s(P1[r],dl);} \
      _Pragma("unroll") for(int r=0;r<16;++r)negm[r]=-mhat; asm volatile("":"+v"(negm)); } \
    _Pragma("unroll") for(int r=0;r<16;++r)P0[r]=__builtin_amdgcn_exp2f(P0[r]); }while(0)
  #define RESC() do{ if(resc){ asm volatile("s_waitcnt lgkmcnt(0)":::"memory"); \
      _Pragma("unroll") for(int d_=0;d_<2;++d_) _Pragma("unroll") for(int r=0;r<16;++r)o[d_][r]*=wsf[crow(r,hi)]; } }while(0)
  f32x16 pA0,pA1,pB0,pB1;
  int sl_prev=0,sl_cur=0,sl_next=SLOTB;
  #define ROT() do{sl_prev=sl_cur;sl_cur=sl_next;sl_next=(sl_next==(NSLOT-1)*SLOTB)?0:sl_next+SLOTB;}while(0)
  DMA_K(2,2*SLOTB);
  WAIT_BAR(3);
  qkt(pA0,pA1,Kbase,qr,negm,r32,hi);asm volatile("s_nop 15\n\ts_nop 7":"+v"(pA0),"+v"(pA1));CMASK(pA0,pA1,0);
  START(pA0,pA1);
  _Pragma("unroll") for(int r=0;r<16;++r)pA1[r]=__builtin_amdgcn_exp2f(pA1[r]);
  WAIT_BAR(0);
  DMA_K(3,0);DMA_V(1,SLOTB);
  ROT();
  kload8(kf,kp0+sl_cur);
  WAIT_BAR(2);
  s16x4 vlo[8],vhi[8]; u32x4 pw0,pw1,pw2,pw3;
  #define PKW(P,B) cvtpk_s(P[B],P[B+1])
  #define PAF(k) __builtin_bit_cast(bf16x8,pw##k)
  #define VFR(i) (bf16x8){vlo[i][0],vlo[i][1],vlo[i][2],vlo[i][3],vhi[i][0],vhi[i][1],vhi[i][2],vhi[i][3]}
  #define PIN(x) asm volatile("":"+v"(x))
  #define MX3(a,b,c) __builtin_fmaxf(__builtin_fmaxf((a),(b)),(c))
  #define GAPA(MF,A0,A1,A2,A3,W0,W1,PW) do{ MF; sacc+=A0; sacc+=A1; sacc+=A2; sacc+=A3; PIN(sacc); W0; W1; PIN(PW); SBAR(); }while(0)
  #define EX(v) __builtin_amdgcn_exp2f(v)
  #define GAPB(MF,X,B) do{ MF; X[B]=EX(X[B]); X[B+1]=EX(X[B+1]); X[B+2]=EX(X[B+2]); X[B+3]=EX(X[B+3]); PIN(X); SBAR(); }while(0)
  #define VRD(i) do{ vlo[i]=vtr(vp_+(((i)>>2)*4096+((i)&3)*1024)); vhi[i]=vtr(vp_+(((i)>>2)*4096+((i)&3)*1024+512)); }while(0)
  #define KRD(G,j) do{ if(G){ kload2(kf,kp0+sl_next,j); SBAR(); } }while(0)
  #define STEP(C0,C1,P0,P1,t,GK,GV,GL) do{ SBAR(); \
    const lds_cptr vp_=vp0+sl_prev; \
    VRD(0); SBAR(); float sacc=(P0[0]+P0[1]); \
    GAPA(C0=__builtin_amdgcn_mfma_f32_32x32x16_bf16(kf[0],qr[0],negm,0,0,0), P0[2],P0[3],P0[4],P0[5],     pw0[0]=PKW(P0,0), pw0[1]=PKW(P0,2), pw0); \
    VRD(4); SBAR(); GAPA(C1=__builtin_amdgcn_mfma_f32_32x32x16_bf16(kf[1],qr[0],negm,0,0,0), P0[6],P0[7],P0[8],P0[9],     pw0[2]=PKW(P0,4), pw0[3]=PKW(P0,6), pw0); \
    VRD(1); SBAR(); GAPA(C0=__builtin_amdgcn_mfma_f32_32x32x16_bf16(kf[2],qr[1],C0,0,0,0),   P0[10],P0[11],P0[12],P0[13], pw1[0]=PKW(P0,8), pw1[1]=PKW(P0,10), pw1); \
    VRD(5); SBAR(); GAPA(C1=__builtin_amdgcn_mfma_f32_32x32x16_bf16(kf[3],qr[1],C1,0,0,0),   P0[14],P0[15],P1[0],P1[1],   pw1[2]=PKW(P0,12),pw1[3]=PKW(P0,14), pw1); \
    VRD(2); SBAR(); GAPA(C0=__builtin_amdgcn_mfma_f32_32x32x16_bf16(kf[4],qr[2],C0,0,0,0),   P1[2],P1[3],P1[4],P1[5],     pw2[0]=PKW(P1,0), pw2[1]=PKW(P1,2), pw2); \
    VRD(6); SBAR(); GAPA(C1=__builtin_amdgcn_mfma_f32_32x32x16_bf16(kf[5],qr[2],C1,0,0,0),   P1[6],P1[7],P1[8],P1[9],     pw2[2]=PKW(P1,4), pw2[3]=PKW(P1,6), pw2); \
    VRD(3); SBAR(); GAPA(C0=__builtin_amdgcn_mfma_f32_32x32x16_bf16(kf[6],qr[3],C0,0,0,0),   P1[10],P1[11],P1[12],P1[13], pw3[0]=PKW(P1,8), pw3[1]=PKW(P1,10), pw3); \
    VRD(7); SBAR(); GAPA(C1=__builtin_amdgcn_mfma_f32_32x32x16_bf16(kf[7],qr[3],C1,0,0,0),   P1[14],P1[15],0.f,0.f,       pw3[2]=PKW(P1,12),pw3[3]=PKW(P1,14), pw3); \
    l_reg+=sacc; \
    if(GK){DMA_K((t)+3,sl_cur);} if(GV){DMA_V((t)+1,sl_next);} \
    CMASK(C0,C1,t); \
    if constexpr(NOMAX) { resc=false; if(__builtin_expect(NT<0,0)){ const float dl=1.f; mhat+=dl;   \
        _Pragma("unroll") for(int r=0;r<16;++r){C0[r]-=dl;C1[r]-=dl;} \
        _Pragma("unroll") for(int r=0;r<16;++r)negm[r]=-mhat; asm volatile("":"+v"(negm)); \
        const float f=__builtin_amdgcn_exp2f(-dl); l_reg*=f; if(hi==0)wsf[r32]=f; resc=true; } } \
    if constexpr(!NOMAX) { float a=MX3(C0[0],C0[1],C1[0]),b=MX3(C0[2],C0[3],C1[1]); a=MX3(a,C1[2],C1[3]); \
      _Pragma("unroll") for(int r=4;r<16;r+=4){a=MX3(a,C0[r],C0[r+1]);b=MX3(b,C0[r+2],C0[r+3]);a=MX3(a,C1[r],C1[r+1]);b=MX3(b,C1[r+2],C1[r+3]);} \
      float rm=__builtin_fmaxf(a,b); { auto rr=__builtin_amdgcn_permlane32_swap(__float_as_uint(rm),__float_as_uint(rm),false,false); rm=__builtin_fmaxf(__uint_as_float(rr[0]),__uint_as_float(rr[1])); } \
      resc=false; \
      if(__builtin_expect(__any(rm>(float)THRL),0)){ const float dl=__builtin_fmaxf(rm,0.f); mhat+=dl; \
        _Pragma("unroll") for(int r=0;r<16;++r){C0[r]-=dl;C1[r]-=dl;} \
        _Pragma("unroll") for(int r=0;r<16;++r)negm[r]=-mhat; asm volatile("":"+v"(negm)); \
        const float f=__builtin_amdgcn_exp2f(-dl); l_reg*=f; if(hi==0)wsf[r32]=f; resc=true; } } \
    SBAR(); \
    GAPB(o[0]=__builtin_amdgcn_mfma_f32_32x32x16_bf16(PAF(0),VFR(0),o[0],0,0,0), C0,0); \
    GAPB(o[1]=__builtin_amdgcn_mfma_f32_32x32x16_bf16(PAF(0),VFR(4),o[1],0,0,0), C0,4); \
    KRD(GL,0); GAPB(o[0]=__builtin_amdgcn_mfma_f32_32x32x16_bf16(PAF(1),VFR(1),o[0],0,0,0), C0,8); \
    KRD(GL,1); GAPB(o[1]=__builtin_amdgcn_mfma_f32_32x32x16_bf16(PAF(1),VFR(5),o[1],0,0,0), C0,12); \
    KRD(GL,2); GAPB(o[0]=__builtin_amdgcn_mfma_f32_32x32x16_bf16(PAF(2),VFR(2),o[0],0,0,0), C1,0); \
    KRD(GL,3); GAPB(o[1]=__builtin_amdgcn_mfma_f32_32x32x16_bf16(PAF(2),VFR(6),o[1],0,0,0), C1,4); \
    GAPB(o[0]=__builtin_amdgcn_mfma_f32_32x32x16_bf16(PAF(3),VFR(3),o[0],0,0,0), C1,8); \
    GAPB(o[1]=__builtin_amdgcn_mfma_f32_32x32x16_bf16(PAF(3),VFR(7),o[1],0,0,0), C1,12); \
    }while(0)
  int t=1;
  for(;t+5<NT;t+=2){
    STEP(pB0,pB1,pA0,pA1,t,true,true,true);     WAIT_BAR(2); RESC(); ROT();
    STEP(pA0,pA1,pB0,pB1,t+1,true,true,true);   WAIT_BAR(2); RESC(); ROT();
  }
  #define ENDW(tt) do{ if((tt)+3<NT){WAIT_BAR(2);} else if((tt)+2<NT){WAIT_BAR(1);} else {WAIT_BAR(0);} }while(0)
  for(;t+1<NT;t+=2){
    STEP(pB0,pB1,pA0,pA1,t,(t+3<NT),(t+1<NT),(t+1<NT));       ENDW(t);   RESC(); ROT();
    STEP(pA0,pA1,pB0,pB1,t+1,(t+4<NT),(t+2<NT),(t+2<NT));     ENDW(t+1); RESC(); ROT();
  }
  STEP(pB0,pB1,pA0,pA1,NT-1,false,false,false); RESC();
  { float sacc=pB0[0]+pB0[1]; _Pragma("unroll") for(int r=2;r<16;++r)sacc+=pB0[r]; _Pragma("unroll") for(int r=0;r<16;++r)sacc+=pB1[r]; l_reg+=sacc;
    pw0=(u32x4){PKW(pB0,0),PKW(pB0,2),PKW(pB0,4),PKW(pB0,6)};pw1=(u32x4){PKW(pB0,8),PKW(pB0,10),PKW(pB0,12),PKW(pB0,14)};pw2=(u32x4){PKW(pB1,0),PKW(pB1,2),PKW(pB1,4),PKW(pB1,6)};pw3=(u32x4){PKW(pB1,8),PKW(pB1,10),PKW(pB1,12),PKW(pB1,14)};
    SBAR(); pv(o,vb0+sl_cur,PAF(0),PAF(1),PAF(2),PAF(3)); }
  #undef PKW
  #undef PAF
  #undef VFR
  #undef PIN
  #undef MX3
  #undef GAPA
  #undef GAPB
  #undef EX
  #undef VRD
  #undef KRD
  #undef STEP
  #undef ENDW
  {auto rr=__builtin_amdgcn_permlane32_swap(__float_as_uint(l_reg),__float_as_uint(l_reg),false,false);l_reg=__uint_as_float(rr[0])+__uint_as_float(rr[1]);}
  if(HAS_SINK) l_reg+=__builtin_amdgcn_exp2f(sink2-mhat);
  if(hi==0)wsf[32+r32]=l_reg;asm volatile("s_waitcnt lgkmcnt(0)":::"memory");
  float rli[16];
  #pragma unroll
  for(int r=0;r<16;++r)rli[r]=__builtin_amdgcn_rcpf(wsf[32+crow(r,hi)]);
  bf16*Ow=Ou+(long)(wid*QBLK)*QP;
  { bf16*stg=(bf16*)(shm+LDS_OST)+wid*2048;
    #pragma unroll
    for(int r=0;r<16;++r){const int orow=crow(r,hi);
      #pragma unroll
      for(int d0=0;d0<2;++d0)stg[orow*64+d0*32+r32]=__float2bfloat16(o[d0][r]*rli[r]);}
    asm volatile("s_waitcnt lgkmcnt(0)":::"memory");
    #pragma unroll
    for(int i=0;i<4;++i){const int row=i*8+(lane>>3),ch=lane&7; const u32x4 v=*(const u32x4*)(stg+row*64+ch*8); ATTN_STORE16(Ow+(long)row*QP+ch*8,v);} }
  asm volatile("s_waitcnt lgkmcnt(0)\n\ts_barrier":::"memory");
  #undef DMA_K
  #undef DMA_V
  #undef KVROW
  #undef CMASK
  #undef START
  #undef RESC
  #undef ROT
}
constexpr int ATTN_LDS_BYTES=LDS_BYTES;
#undef SBAR
#undef WAIT_BAR
}

struct Args { const float* in[21]; float* out; unsigned char* ws; int ph_lo, ph_hi; };

constexpr int TAB_OFF = MISC_OFF + 256;
struct Frame {
    LAS unsigned char* lds; int tid, lane, wave, G, bx, vcu, gw, NGW;
    __device__ __forceinline__ unsigned long long tab(int i) const { const u32x2 v = ((const LAS u32x2*)(lds + TAB_OFF))[i];
        const unsigned lo = __builtin_amdgcn_readfirstlane(v.x), hi = __builtin_amdgcn_readfirstlane(v.y); return ((unsigned long long)hi << 32) | lo; }
    __device__ __forceinline__ const float* in(int i) const { return (const float*)(const GAS float*)tab(i); }
    __device__ __forceinline__ unsigned char* wsp(size_t off) const { return (unsigned char*)(GAS unsigned char*)(tab(22) + off); }
#define FIN(name, i) __device__ __forceinline__ const float* name() const { return in(i); }
    FIN(x, 0) FIN(c, 1) FIN(ctx, 2) FIN(c_ctx, 3) FIN(w_ada, 4) FIN(b_ada, 5) FIN(g_mix, 6) FIN(g_ffn, 7) FIN(w_in, 8) FIN(qg_a, 9) FIN(kg_a, 10) FIN(qg_b, 11) FIN(kg_b, 12)
    FIN(sink_b, 13) FIN(conv_w, 14) FIN(w_branch, 15) FIN(w_out, 16) FIN(w_router, 17) FIN(w_eg, 18) FIN(w_eu, 19) FIN(w_ed, 20)
#undef FIN
    __device__ __forceinline__ float* out() const { return (float*)(GAS float*)tab(21); }
#define FWS(type, name, off) __device__ __forceinline__ type* name() const { return (type*)wsp(off); }
    FWS(float, mod, WS_MOD) FWS(float, gains, WS_GAINS) FWS(float, xc, WS_XC) FWS(float, aff, WS_AFF) FWS(float, gatev, WS_GATEV) FWS(int, idx, WS_IDX) FWS(int, inv, WS_INV)
    FWS(bf16_t, WinT, WS_WIN) FWS(bf16_t, WbrT, WS_WBR) FWS(bf16_t, WoutT, WS_WOUT) FWS(bf16_t, H, WS_H) FWS(bf16_t, KA, WS_KA) FWS(bf16_t, KB, WS_KB) FWS(bf16_t, VA, WS_VTA) FWS(bf16_t, VB, WS_VTB)
    FWS(bf16_t, QKV, WS_QKV) FWS(bf16_t, CONV, WS_CONV) FWS(bf16_t, GATE, WS_GATE) FWS(bf16_t, XS, WS_XS) FWS(bf16_t, HID, WS_HID) FWS(bf16_t, WGU, WS_WGU) FWS(bf16_t, WD, WS_WD) FWS(bf16_t, DELTA, WS_DELTA) FWS(unsigned char, H8, WS_H8)
#undef FWS
};

__device__ __forceinline__ void transpose_item(const float* W, int K, int N, bf16_t* WT, int k0, int n0, int drow0, LAS float* scr, int lane) {
    float tv[32];
#pragma unroll
    for (int i = 0; i < 32; ++i) tv[i] = W[(size_t)(k0 + 2 * i + (lane >> 5)) * N + n0 + (lane & 31)];
#pragma unroll
    for (int i = 0; i < 32; ++i) scr[(2 * i + (lane >> 5)) * 33 + (lane & 31)] = tv[i];
    LDS_WAIT(); asm volatile("" ::: "memory");
    const int c = lane & 7;
#pragma unroll
    for (int j = 0; j < 4; ++j) { const int n = (lane >> 3) + 8 * j; const LAS float* s = scr + (8 * c) * 33 + n;
        u32x4 o; o.x = cvt_pk_bf16(s[0 * 33], s[1 * 33]); o.y = cvt_pk_bf16(s[2 * 33], s[3 * 33]); o.z = cvt_pk_bf16(s[4 * 33], s[5 * 33]); o.w = cvt_pk_bf16(s[6 * 33], s[7 * 33]);
        *(u32x4*)(WT + (size_t)(drow0 + n) * K + k0 + 8 * c) = o; }
    LDS_WAIT(); asm volatile("" ::: "memory");
}
__device__ __forceinline__ void transpose_item_fp8(const float* W, int K, int N, unsigned char* WT, int k0, int n0, int drow0, float scale, LAS float* scr, int lane) {
    float tv[32];
#pragma unroll
    for (int i = 0; i < 32; ++i) tv[i] = W[(size_t)(k0 + 2 * i + (lane >> 5)) * N + n0 + (lane & 31)];
#pragma unroll
    for (int i = 0; i < 32; ++i) scr[(2 * i + (lane >> 5)) * 33 + (lane & 31)] = tv[i] * scale;
    LDS_WAIT(); asm volatile("" ::: "memory");
    const int n = lane >> 1, kh = lane & 1; const LAS float* sp = scr + (32 * kh) * 33 + n;
    unsigned w[8];
#pragma unroll
    for (int q = 0; q < 8; ++q) w[q] = pg8::pack4_fp8(sp[(4 * q) * 33], sp[(4 * q + 1) * 33], sp[(4 * q + 2) * 33], sp[(4 * q + 3) * 33]);
    unsigned char* dp = WT + (size_t)(drow0 + n) * K + k0 + 32 * kh;
    *(u32x4*)dp = (u32x4){w[0], w[1], w[2], w[3]}; *(u32x4*)(dp + 16) = (u32x4){w[4], w[5], w[6], w[7]};
    LDS_WAIT(); asm volatile("" ::: "memory");
}
constexpr int MIXER_ITEMS = 16 * 192 + 3 * 8 * 32 + 16 * 32, EXPERT_ITEMS = NE * 3 * 16 * 32;
__device__ __forceinline__ void convert_mixer_weights(const Frame& F, int l, int begin, int end, int first, int stride) {
    LAS float* scr = (LAS float*)(F.lds + F.wave * 8448);
    constexpr int I_IN = 16 * 192, I_BR = 8 * 32, I_OUT = 16 * 32;
    for (int it = begin + first; it < end; it += stride) {
        int r = it;
        if (r < I_IN) { const int kb = r / 192, nb = r % 192, n0 = 32 * nb;
            int drow = n0;
            if (n0 < 1536) drow = (n0 & ~255) + 128 * ((n0 & 63) >> 5) + 32 * ((n0 & 255) >> 6);
            else if (n0 >= 2048 && n0 < 3072) { const int isx = n0 >= 2560, ch = n0 - (isx ? 2560 : 2048); drow = (8 + (ch >> 7)) * 256 + 128 * isx + (ch & 127); }
            if (n0 >= 3072) transpose_item_fp8(F.w_in() + (size_t)l * D * PW, D, PW, (unsigned char*)F.WinT() + 6 * MiB, 64 * kb, n0, n0 - 3072, pg8::WSCALE, scr, F.lane);
            else transpose_item(F.w_in() + (size_t)l * D * PW, D, PW, F.WinT(), 64 * kb, n0, drow, scr, F.lane);
            continue; } r -= I_IN;
        if (r < 3 * I_BR) { const int k3 = r / I_BR, q = r % I_BR, kb = q / 32, nb = q % 32;
            transpose_item(F.w_branch() + ((size_t)l * 3 + k3) * 512 * D, 512, D, F.WbrT() + (size_t)k3 * D * 512, 64 * kb, 32 * nb, 32 * nb, scr, F.lane); continue; } r -= 3 * I_BR;
        { const int kb = r / 32, nb = r % 32; transpose_item(F.w_out() + (size_t)l * D * D, D, D, F.WoutT(), 64 * kb, 32 * nb, 32 * nb, scr, F.lane); }
    }
}
__device__ __forceinline__ void convert_expert_weights(const Frame& F, int l, int begin, int end, int first, int stride) {
    LAS float* scr = (LAS float*)(F.lds + F.wave * 8448);
    constexpr int PER = 16 * 32;
    for (int it = begin + first; it < end; it += stride) {
        const int e = it / (3 * PER), r = it % (3 * PER), which = r / PER, q = r % PER, kb = q / 32, nb = q % 32, n0 = 32 * nb;
        const size_t eo = ((size_t)l * NE + e) * (size_t)D * EH;
        unsigned char* const wgu = (unsigned char*)F.WGU(); unsigned char* const wd = (unsigned char*)F.WD();
        if (which == 0) transpose_item_fp8(F.w_eg() + eo, D, EH, wgu + (size_t)e * 2048 * D, 64 * kb, n0, (n0 >> 7) * 256 + (n0 & 127), pg8::WSCALE, scr, F.lane);
        else if (which == 1) transpose_item_fp8(F.w_eu() + eo, D, EH, wgu + (size_t)e * 2048 * D, 64 * kb, n0, (n0 >> 7) * 256 + 128 + (n0 & 127), pg8::WSCALE, scr, F.lane);
        else transpose_item_fp8(F.w_ed() + eo, EH, D, wd + (size_t)e * D * EH, 64 * kb, n0, n0, pg8::WSCALE, scr, F.lane);
    }
}

__device__ __forceinline__ void norm_mod(f32x4 (&v)[4], const float* g, const float* sh, const float* sc, int lane) {
    f32x4 gg[4], s1[4], s0[4];
#pragma unroll
    for (int j = 0; j < 4; ++j) { gg[j] = *(const f32x4*)(g + 4 * lane + 256 * j); s1[j] = *(const f32x4*)(sc + 4 * lane + 256 * j); s0[j] = *(const f32x4*)(sh + 4 * lane + 256 * j); }
    float ss = 0.f;
#pragma unroll
    for (int j = 0; j < 4; ++j) ss += (v[j].x * v[j].x + v[j].y * v[j].y) + (v[j].z * v[j].z + v[j].w * v[j].w);
    ss = wave_sum(ss);
    const float rinv = 1.0f / sqrtf(ss * (1.0f / D) + EPS);
#pragma unroll
    for (int j = 0; j < 4; ++j) v[j] = (v[j] * rinv * gg[j]) * (1.0f + s1[j]) + s0[j];
}
__device__ __forceinline__ void norm_mod_lds(f32x4 (&v)[4], const LAS float* g, const LAS float* sh, const LAS float* sc, int lane) {
    float ss = 0.f;
#pragma unroll
    for (int j = 0; j < 4; ++j) ss += (v[j].x * v[j].x + v[j].y * v[j].y) + (v[j].z * v[j].z + v[j].w * v[j].w);
    ss = wave_sum(ss);
    const float rinv = 1.0f / sqrtf(ss * (1.0f / D) + EPS);
#pragma unroll
    for (int j = 0; j < 4; ++j) { const f32x4 gg = *(const LAS f32x4*)(g + 4 * lane + 256 * j), s1 = *(const LAS f32x4*)(sc + 4 * lane + 256 * j), s0 = *(const LAS f32x4*)(sh + 4 * lane + 256 * j);
        v[j] = (v[j] * rinv * gg) * (1.0f + s1) + s0; }
}
__device__ __forceinline__ void norm_mod_reg(f32x4 (&v)[4], const f32x4 (&gg)[4], const f32x4 (&s0)[4], const f32x4 (&s1)[4]) {
    float ss = 0.f;
#pragma unroll
    for (int j = 0; j < 4; ++j) ss += (v[j].x * v[j].x + v[j].y * v[j].y) + (v[j].z * v[j].z + v[j].w * v[j].w);
    ss = wave_sum(ss);
    const float rinv = 1.0f / sqrtf(ss * (1.0f / D) + EPS);
#pragma unroll
    for (int j = 0; j < 4; ++j) v[j] = (v[j] * rinv * gg[j]) * (1.0f + s1[j]) + s0[j];
}
__device__ __forceinline__ void store_row_fp8(unsigned char* orow, const f32x4 (&v)[4], int lane) {
#pragma unroll
    for (int j = 0; j < 4; ++j) *(unsigned*)(orow + 4 * lane + 256 * j) = pg8::pack4_fp8(v[j].x, v[j].y, v[j].z, v[j].w);
}
__device__ __forceinline__ void store_row_bf16(bf16_t* orow, const f32x4 (&v)[4], int lane) {
#pragma unroll
    for (int j = 0; j < 4; ++j) { u32x2 w; w.x = cvt_pk_bf16(v[j].x, v[j].y); w.y = cvt_pk_bf16(v[j].z, v[j].w); *(u32x2*)(orow + 4 * lane + 256 * j) = w; }
}

__device__ const float kInvFreq[16] = { 1.0f, 0.5623413251903491f, 0.31622776601683794f, 0.17782794100389228f, 0.1f, 0.05623413251903491f, 0.031622776601683794f, 0.017782794100389228f,
                                        0.01f, 0.005623413251903491f, 0.0031622776601683794f, 0.0017782794100389228f, 0.001f, 0.0005623413251903491f, 0.00031622776601683794f, 0.00017782794100389228f };
__device__ __forceinline__ void phase_prologue(const Frame& F) {
    LAS float* sv = (LAS float*)F.lds;
    LAS float* red = (LAS float*)(F.lds + 20480);
    { const float* cp = F.c(); const float* cc = F.c_ctx(); float cv[10];
#pragma unroll
      for (int j = 0; j < 8; ++j) cv[j] = cp[F.tid + NTHR * j];
      cv[8] = cc[F.tid]; cv[9] = cc[F.tid + NTHR];
#pragma unroll
      for (int j = 0; j < 10; ++j) sv[F.tid + NTHR * j] = cv[j] / (1.0f + __expf(-cv[j])); }
    __syncthreads();
    for (int item = F.bx; item < 2 * 96; item += F.G) {
        const int l = item / 96, col = (item % 96) * 64 + F.lane;
        const float* W = F.w_ada() + (size_t)l * D * PW + col;
        float a0 = 0.f, a1 = 0.f, a2 = 0.f, a3 = 0.f, a4 = 0.f;
#pragma unroll 16
        for (int kk = 0; kk < 128; ++kk) { const int k = F.wave * 128 + kk; const float w = W[(size_t)k * PW];
            a0 += sv[k] * w; a1 += sv[D + k] * w; a2 += sv[2 * D + k] * w; a3 += sv[3 * D + k] * w; a4 += sv[4 * D + k] * w; }
        red[(F.wave * 5 + 0) * 64 + F.lane] = a0; red[(F.wave * 5 + 1) * 64 + F.lane] = a1; red[(F.wave * 5 + 2) * 64 + F.lane] = a2; red[(F.wave * 5 + 3) * 64 + F.lane] = a3; red[(F.wave * 5 + 4) * 64 + F.lane] = a4;
        __syncthreads();
        if (F.wave < 5) { float s = 0.f;
#pragma unroll
            for (int w = 0; w < 8; ++w) s += red[(w * 5 + F.wave) * 64 + F.lane];
            F.mod()[(size_t)(l * 5 + F.wave) * PW + col] = s + F.b_ada()[l * PW + col]; }
        __syncthreads();
    }
    if (F.bx == 0) { float* gt = F.gains(); if (F.tid < 16) gt[512 + F.tid] = kInvFreq[F.tid];
        if (F.tid >= 64 && F.tid < 68) {
            const int l = (F.tid - 64) >> 1, br = (F.tid - 64) & 1; const float* gq = (br ? F.qg_b() : F.qg_a()) + l * 64; const float* gk = (br ? F.kg_b() : F.kg_a()) + l * 64; float mq = 0.f, mk = 0.f;
            for (int d = 0; d < 64; ++d) { mq = fmaxf(mq, fabsf(gq[d])); mk = fmaxf(mk, fabsf(gk[d])); }
            gt[528 + l * 2 + br] = QSCALE * 64.0f * mq * mk * 1.02f; } for (int i = F.tid; i < 2 * 4 * 64; i += NTHR) { const int l = i >> 8, w = (i >> 6) & 3, d = i & 63;
            const float* src = (w == 0) ? F.kg_a() : (w == 1) ? F.kg_b() : (w == 2) ? F.qg_a() : F.qg_b(); gt[i] = src[l * 64 + d]; } }
    __syncthreads();
    convert_mixer_weights(F, 0, 0, MIXER_ITEMS, F.gw, F.NGW);
}

__device__ __forceinline__ void phase_norm1(const Frame& F, int l, const float* xl, const float* xcsrc) {
    LAS float* const nvl = (LAS float*)F.lds;
    { const float* modv = F.mod() + (size_t)l * 5 * PW; const float* gm = F.g_mix() + l * D; float nv[22];
#pragma unroll
      for (int j = 0; j < 22; ++j) { const int i = F.tid + NTHR * j, r = i >> 10, k = i & 1023; nv[j] = (r == 0) ? gm[k] : (r <= 5 ? modv[(size_t)(r - 1) * PW + k] : modv[(size_t)(r - 6) * PW + D + k]); }
#pragma unroll
      for (int j = 0; j < 22; ++j) nvl[F.tid + NTHR * j] = nv[j]; }
    __syncthreads();
    const int lane = F.lane;
#define N1_LOAD(V, RB) do { _Pragma("unroll") for (int q = 0; q < 4; ++q) { const int row = (RB) + q * F.NGW; const int rc = row < MT ? row : (RB); \
            const float* xr = rc < ML ? xl + (size_t)rc * D : xcsrc + (size_t)(rc - ML) * D; \
            _Pragma("unroll") for (int j = 0; j < 4; ++j) V[q][j] = *(const f32x4*)(xr + 4 * lane + 256 * j); } } while (0)
    int r0 = F.gw; if (r0 >= MT) return;
    f32x4 v[4][4], vn[4][4];
    N1_LOAD(v, r0);
    for (;;) {
        const int rn = r0 + 4 * F.NGW; const bool more = rn < MT;
        { const int rl = more ? rn : r0; N1_LOAD(vn, rl); }
        __builtin_amdgcn_sched_barrier(0);
#pragma unroll
        for (int q = 0; q < 4; ++q) { const int row = r0 + q * F.NGW;
            if (row < MT) { const int mr = row < ML ? row / SEQ : 4;
                norm_mod_lds(v[q], nvl, nvl + (1 + mr) * D, nvl + (6 + mr) * D, lane);
                store_row_bf16(F.H() + (size_t)row * D, v[q], lane); store_row_fp8(F.H8() + (size_t)row * D, v[q], lane); } }
        if (!more) break;
#pragma unroll
        for (int q = 0; q < 4; ++q)
#pragma unroll
            for (int j = 0; j < 4; ++j) v[q][j] = vn[q][j];
        r0 = rn;
    }
#undef N1_LOAD
}

__device__ __forceinline__ void phase_elementwise(const Frame& F, int l, int g_begin, int g_end, int gw, int ngw, bool dummy = false) {
    const int lane = F.lane;
    f32x4 cw[3][2];
    { const float* cwp = F.conv_w() + (size_t)l * 3 * 512 + 8 * lane;
#pragma unroll
      for (int q = 0; q < 3; ++q) { cw[q][0] = *(const f32x4*)(cwp + q * 512); cw[q][1] = *(const f32x4*)(cwp + q * 512 + 4); } }
    bf16_t* const Cb = F.CONV();
    for (int g4 = g_begin + gw; g4 < g_end; g4 += ngw) {
        const int g0 = g4 * 4; const bool lat = g0 < ML;
        const int tw = lat ? g0 % SEQ : (g0 - ML) % CTX, nseq = lat ? SEQ : CTX;
        bf16_t* const crow0 = Cb + (size_t)g0 * QW;
        u32x4 uu[6], bg[4];
#pragma unroll
        for (int q = 0; q < 6; ++q) { const int tt = tw + q - 1; const bool ok = (tt >= 0) && (tt < nseq);
            uu[q] = ok ? *(const u32x4*)(crow0 + (ptrdiff_t)(q - 1) * QW + 512 + 8 * lane) : (u32x4){0u, 0u, 0u, 0u}; }
#pragma unroll
        for (int i = 0; i < 4; ++i) bg[i] = *(const u32x4*)(crow0 + (size_t)i * QW + 8 * lane);
        float u[6][8];
#pragma unroll
        for (int q = 0; q < 6; ++q) { u[q][0] = bf_lo(uu[q].x); u[q][1] = bf_hi(uu[q].x); u[q][2] = bf_lo(uu[q].y); u[q][3] = bf_hi(uu[q].y); u[q][4] = bf_lo(uu[q].z); u[q][5] = bf_hi(uu[q].z); u[q][6] = bf_lo(uu[q].w); u[q][7] = bf_hi(uu[q].w); }
#pragma unroll
        for (int i = 0; i < 4; ++i) {
            float o8[8];
#pragma unroll
            for (int e = 0; e < 8; ++e) { const float w0 = (e < 4) ? cw[0][0][e & 3] : cw[0][1][e & 3], w1 = (e < 4) ? cw[1][0][e & 3] : cw[1][1][e & 3], w2 = (e < 4) ? cw[2][0][e & 3] : cw[2][1][e & 3];
                o8[e] = w0 * u[i][e] + w1 * u[i + 1][e] + w2 * u[i + 2][e]; }
            const u32x4 bb = bg[i];
            u32x4 w; w.x = cvt_pk_bf16(o8[0] * bf_lo(bb.x), o8[1] * bf_hi(bb.x)); w.y = cvt_pk_bf16(o8[2] * bf_lo(bb.y), o8[3] * bf_hi(bb.y));
            w.z = cvt_pk_bf16(o8[4] * bf_lo(bb.z), o8[5] * bf_hi(bb.z)); w.w = cvt_pk_bf16(o8[6] * bf_lo(bb.w), o8[7] * bf_hi(bb.w));
            if (!dummy) *(u32x4*)(crow0 + (size_t)i * QW + 8 * lane) = w;
        }
    }
}

__device__ __forceinline__ void ctr_signal(unsigned* ctr) {
    asm volatile("s_waitcnt vmcnt(0)" ::: "memory"); __syncthreads();
    if (threadIdx.x == 0) { __builtin_amdgcn_fence(__ATOMIC_RELEASE, "agent"); asm volatile("s_waitcnt vmcnt(0)" ::: "memory"); (void)xb_add(ctr, 1u); }
}
__device__ __forceinline__ void ctr_wait(unsigned* ctr, unsigned n) {
    if (threadIdx.x == 0) { unsigned sp = 0u; while (xb_ld(ctr) < n) { __builtin_amdgcn_s_sleep(2); if (++sp > (1u << 22)) break; }
        __builtin_amdgcn_fence(__ATOMIC_ACQUIRE, "agent"); asm volatile("s_waitcnt vmcnt(0)" ::: "memory"); }
    __syncthreads();
}
#if defined(DUPMASK)
#define ATT_DUMMY(x) (x)
#else
#define ATT_DUMMY(x) false
#endif
constexpr int CTX_FUSED_G = 256;
__device__ __forceinline__ bool ctx_fused(const Frame& F, bool has_ctx) { return has_ctx && F.G == CTX_FUSED_G; }
__device__ __forceinline__ void phase_attention(const Frame& F, int l, bool has_ctx, bool first, bool dummy_out = false) {
    const float mA = F.gains()[528 + l * 2], mB = F.gains()[528 + l * 2 + 1];
    const bool fastA = mA < 80.0f; (void)mB;
    const bool fused = ctx_fused(F, has_ctx);
    const int v = F.vcu;
    const bool isM = fused && v >= 64 && v < 80, isO = fused && v >= 80 && v < 96;
    const int nwin = v < 64 ? 4 : v < 80 ? 0 : v < 96 ? 2 : v < 192 ? 5 : 4;
    const int wstart = v < 64 ? 4 * v : v < 80 ? 256 : v < 96 ? 256 + 2 * (v - 80) : v < 192 ? 288 + 5 * (v - 96) : 768 + 4 * (v - 192);
    unsigned* const ctrA = (unsigned*)F.wsp(WS_CTL) + 8192 + 64 * (2 * l), * const ctrM = ctrA + 64;
    enum { K_SKIP = 0, K_CONVCTX, K_CONV, K_GLOBAL, K_WINDOW, K_CTXATT, K_MERGE, K_OUT };
    for (int n = 0;; ++n) {
        int kind = K_SKIP, arg = 0;
        if (fused) {
            if (n == 0) kind = v < 32 ? K_CONVCTX : K_SKIP;
            else if (n == 1) { kind = v < 64 ? K_CTXATT : K_SKIP; arg = v; }
            else if (n == 2) kind = isM ? K_SKIP : K_CONV;
            else if (n == 3 || n == 4) { kind = K_GLOBAL; arg = (n - 3) * 256 + v; }
            else if (n == 5) kind = isM ? K_MERGE : K_SKIP;
            else if (n == 6 || n == 7) { kind = K_GLOBAL; arg = (n - 4) * 256 + v; }
            else if (n == 8) kind = isO ? K_OUT : K_SKIP;
            else { const int j = n - 9; if (j >= nwin) break; kind = K_WINDOW; arg = wstart + j; }
        } else {
            if (n == 0) kind = K_CONV;
            else { const int uid = (n - 1) * F.G + v; if (uid >= 2048 + (has_ctx ? 64 : 0)) break;
                if (uid < 1024) { kind = K_GLOBAL; arg = uid; } else if (uid < 2048) { kind = K_WINDOW; arg = uid - 1024; } else { kind = K_CTXATT; arg = uid - 2048; } }
        }
        if (kind == K_CONVCTX) { if (first) phase_elementwise(F, l, ML / 4, MT / 4, v * NWAVES + F.wave, 32 * NWAVES); }
        else if (kind == K_CONV) {
            if (first) { if (fused) { const int vv = v < 64 ? v : v - 16; phase_elementwise(F, l, 0, ML / 4, vv * NWAVES + F.wave, (CTX_FUSED_G - 16) * NWAVES); }
                         else phase_elementwise(F, l, 0, MT / 4, F.gw, F.NGW); }
        } else if (kind == K_GLOBAL) {
            const int uid = arg; const int b = uid >> 8, h = (uid >> 5) & 7, qb = uid & 31, kvh = h >> 2;
            ab::bf16* qo = (ab::bf16*)(F.QKV() + (size_t)(b * SEQ + qb * 256) * QW + OFF_QA + h * 64); ab::bf16* oo = ATT_DUMMY(dummy_out) ? (ab::bf16*)F.H() : qo;
            const ab::bf16* kp = (const ab::bf16*)(F.KA() + (size_t)(b * 2 + kvh) * KVROWS * 64); const ab::bf16* vp = (const ab::bf16*)(F.VA() + (size_t)(b * 2 + kvh) * KVROWS * 64);
            if (fastA) ab::attn_unit<8, false, false, true>(qo, kp, vp, oo, KVROWS / 64, (char*)F.lds, F.tid, 0, 0, 0.f, mA);
            else ab::attn_unit<8, false, false, false>(qo, kp, vp, oo, KVROWS / 64, (char*)F.lds, F.tid, 0, 0, 0.f, 0.f);
        } else if (kind == K_WINDOW) {
            const int w = arg; const int b = w >> 8, h = (w >> 5) & 7, qb = w & 31, kvh = h >> 2;
            ab::bf16* qo = (ab::bf16*)(F.QKV() + (size_t)(b * SEQ + qb * 256) * QW + OFF_QB + h * 64); ab::bf16* oo = ATT_DUMMY(dummy_out) ? (ab::bf16*)F.H() : qo;
            int lo = qb * 4 - 2, hi2 = qb * 4 + 6; if (lo < 0) lo = 0; if (hi2 > SEQ / 64) hi2 = SEQ / 64;
            const size_t ko = (size_t)(b * 2 + kvh) * KVROWS * 64; const float sk = F.sink_b()[l * 8 + h] * LOG2E;
            ab::attn_unit<8, true, true, false>(qo, (const ab::bf16*)(F.KB() + ko), (const ab::bf16*)(F.VB() + ko), oo, 4 + (hi2 - lo), (char*)F.lds, F.tid, lo, qb * 256, sk, 0.f);
        } else if (kind == K_CTXATT) {
            const int w = arg, isb = w >> 5, b = (w >> 3) & 3, h = w & 7, kvh = h >> 2;
            ab::bf16* qo = (ab::bf16*)(F.QKV() + (size_t)(ML + b * CTX) * QW + (isb ? OFF_QB : OFF_QA) + h * 64); ab::bf16* oo = ATT_DUMMY(dummy_out) ? (ab::bf16*)F.H() : qo;
            const size_t ko = ((size_t)(b * 2 + kvh) * KVROWS + SEQ) * 64;
            if (isb) ab::attn_unit<8, false, true, false>(qo, (const ab::bf16*)(F.KB() + ko), (const ab::bf16*)(F.VB() + ko), oo, CTX / 64, (char*)F.lds, F.tid, 0, 0, F.sink_b()[l * 8 + h] * LOG2E, 0.f);
            else ab::attn_unit<8, false, false, false>(qo, (const ab::bf16*)(F.KA() + ko), (const ab::bf16*)(F.VA() + ko), oo, CTX / 64, (char*)F.lds, F.tid, 0, 0, 0.f, 0.f);
            if (fused) ctr_signal(ctrA);
        } else if (kind == K_MERGE) {
            ctr_wait(ctrA, 64u);
            const int t = v - 64;
            pg8::SchedMergeOne S; S.pm = ML / 256 + (t >> 2); S.pn = t & 3; S.Q = (const char*)F.QKV(); S.C = (const char*)F.CONV(); S.W = (const char*)F.WbrT();
            pg8::EpiMerge E{(const unsigned char*)F.GATE(), F.H()};
            pg8::gemm_phase(F.lds, 512, QW, 512, S, E);
            ctr_signal(ctrM);
        } else if (kind == K_OUT) {
            ctr_wait(ctrM, 16u);
            const int t = v - 80;
            pg8::SchedPlainOne S; S.pm = ML / 256 + (t >> 2); S.pn = t & 3; S.A = (const char*)F.H(); S.B = (const char*)F.WoutT(); S.atile = (size_t)256 * D * 2; S.btile = (size_t)256 * D * 2;
            pg8::EpiOut E{F.DELTA(), F.mod() + (size_t)l * 5 * PW, F.x(), F.ctx(), (l == 0) ? (const bf16_t*)nullptr : (const bf16_t*)F.wsp(WS_XB16)};
            pg8::gemm_phase(F.lds, D, D, D, S, E);
        }
    }
}

__device__ __forceinline__ void router_row(const Frame& F, f32x4 (&v)[4], int l, int row, int b, int pos, int mr, const float* modl, const LAS float* wrt, int lane) {
        norm_mod(v, F.g_ffn() + l * D, modl + mr * PW + 3 * D, modl + mr * PW + 4 * D, lane);
        store_row_fp8(F.H8() + (size_t)row * D, v, lane);
        float lg[16];
#pragma unroll
        for (int e = 0; e < 16; ++e) { float s = 0.f;
#pragma unroll
            for (int j = 0; j < 4; ++j) { const f32x4 w = *(const LAS f32x4*)(wrt + e * D + 4 * lane + 256 * j); s += (v[j].x * w.x + v[j].y * w.y) + (v[j].z * w.z + v[j].w * w.w); }
            lg[e] = s; }
        float w8[8], w4[4], w2[2], lgt;
        { const bool up = (lane & 32) != 0;
#pragma unroll
          for (int i = 0; i < 8; ++i) { const float mine = up ? lg[8 + i] : lg[i], oth = up ? lg[i] : lg[8 + i]; w8[i] = mine + __shfl_xor(oth, 32); } }
        { const bool up = (lane & 16) != 0;
#pragma unroll
          for (int i = 0; i < 4; ++i) { const float mine = up ? w8[4 + i] : w8[i], oth = up ? w8[i] : w8[4 + i]; w4[i] = mine + __shfl_xor(oth, 16); } }
        { const bool up = (lane & 8) != 0;
#pragma unroll
          for (int i = 0; i < 2; ++i) { const float mine = up ? w4[2 + i] : w4[i], oth = up ? w4[i] : w4[2 + i]; w2[i] = mine + __shfl_xor(oth, 8); } }
        { const bool up = (lane & 4) != 0; const float mine = up ? w2[1] : w2[0], oth = up ? w2[0] : w2[1]; lgt = mine + __shfl_xor(oth, 4); }
        lgt += __shfl_xor(lgt, 2); lgt += __shfl_xor(lgt, 1);
        float mx = lgt;
        mx = fmaxf(mx, __shfl_xor(mx, 4)); mx = fmaxf(mx, __shfl_xor(mx, 8)); mx = fmaxf(mx, __shfl_xor(mx, 16)); mx = fmaxf(mx, __shfl_xor(mx, 32));
        const float ex = __expf(lgt - mx); float sum = ex;
        sum += __shfl_xor(sum, 4); sum += __shfl_xor(sum, 8); sum += __shfl_xor(sum, 16); sum += __shfl_xor(sum, 32);
        if ((lane & 3) == 0) { const int e = ((lane >> 5) & 1) * 8 + ((lane >> 4) & 1) * 4 + ((lane >> 3) & 1) * 2 + ((lane >> 2) & 1);
            F.aff()[(size_t)(b * NE + e) * KVROWS + pos] = ex / sum; F.inv()[(size_t)row * NE + e] = -1; }
}
__device__ __forceinline__ void router_finish(const Frame& F, const float (&lg)[16], int row, int b, int pos, int lane) {
    float w8[8], w4[4], w2[2], lgt;
    { const bool up = (lane & 32) != 0;
#pragma unroll
      for (int i = 0; i < 8; ++i) { const float mine = up ? lg[8 + i] : lg[i], oth = up ? lg[i] : lg[8 + i]; w8[i] = mine + __shfl_xor(oth, 32); } }
    { const bool up = (lane & 16) != 0;
#pragma unroll
      for (int i = 0; i < 4; ++i) { const float mine = up ? w8[4 + i] : w8[i], oth = up ? w8[i] : w8[4 + i]; w4[i] = mine + __shfl_xor(oth, 16); } }
    { const bool up = (lane & 8) != 0;
#pragma unroll
      for (int i = 0; i < 2; ++i) { const float mine = up ? w4[2 + i] : w4[i], oth = up ? w4[i] : w4[2 + i]; w2[i] = mine + __shfl_xor(oth, 8); } }
    { const bool up = (lane & 4) != 0; const float mine = up ? w2[1] : w2[0], oth = up ? w2[0] : w2[1]; lgt = mine + __shfl_xor(oth, 4); }
    lgt += __shfl_xor(lgt, 2); lgt += __shfl_xor(lgt, 1);
    float mx = lgt;
    mx = fmaxf(mx, __shfl_xor(mx, 4)); mx = fmaxf(mx, __shfl_xor(mx, 8)); mx = fmaxf(mx, __shfl_xor(mx, 16)); mx = fmaxf(mx, __shfl_xor(mx, 32));
    const float ex = __expf(lgt - mx); float sum = ex;
    sum += __shfl_xor(sum, 4); sum += __shfl_xor(sum, 8); sum += __shfl_xor(sum, 16); sum += __shfl_xor(sum, 32);
    if ((lane & 3) == 0) { const int e = ((lane >> 5) & 1) * 8 + ((lane >> 4) & 1) * 4 + ((lane >> 3) & 1) * 2 + ((lane >> 2) & 1);
        F.aff()[(size_t)(b * NE + e) * KVROWS + pos] = ex / sum; F.inv()[(size_t)row * NE + e] = -1; }
}
constexpr int WRP = 1028;
__device__ __forceinline__ void phase_norm2_mfma(const Frame& F, int l, bool has_ctx) {
    LAS float* wrt = (LAS float*)F.lds;
    { const f32x4* wsrc = (const f32x4*)(F.w_router() + (size_t)l * D * NE) + F.tid * 8;
      f32x4 wv[8];
#pragma unroll
      for (int i = 0; i < 8; ++i) wv[i] = wsrc[i];
#pragma unroll
      for (int i = 0; i < 8; ++i) { const int k = 2 * F.tid + (i >> 2), e0 = (i & 3) * 4; wrt[(e0 + 0) * WRP + k] = wv[i].x; wrt[(e0 + 1) * WRP + k] = wv[i].y; wrt[(e0 + 2) * WRP + k] = wv[i].z; wrt[(e0 + 3) * WRP + k] = wv[i].w; } }
    LAS float* const nvl = wrt + NE * WRP;
    { const float* modv = F.mod() + (size_t)l * 5 * PW; const float* gf = F.g_ffn() + l * D; float nv[22];
#pragma unroll
      for (int j = 0; j < 22; ++j) { const int i = F.tid + NTHR * j, r = i >> 10, k = i & 1023; nv[j] = (r == 0) ? gf[k] : (r <= 5 ? modv[(size_t)(r - 1) * PW + 3 * D + k] : modv[(size_t)(r - 6) * PW + 4 * D + k]); }
#pragma unroll
      for (int j = 0; j < 22; ++j) nvl[F.tid + NTHR * j] = nv[j]; }
    __syncthreads();
    const int nrows = has_ctx ? MT : ML, ngroups = nrows / 16, lane = F.lane, r = lane & 15, g = lane >> 4;
    const bf16_t* const xm = F.DELTA();
    for (int it = 0;; ++it) {
        int gi;
        if (it == 0) gi = F.gw; else { if (F.wave != 0) break; gi = F.NGW + F.vcu + (it - 1) * F.G; }
        if (gi >= ngroups) break;
        const int row = gi * 16 + r; const bool lat = row < ML;
        const int b = lat ? row / SEQ : (row - ML) / CTX, pos = lat ? row % SEQ : SEQ + (row - ML) % CTX, mr = lat ? b : 4;
        u32x4 xw[32];
        { const bf16_t* xr = xm + (size_t)row * D + 8 * g;
#pragma unroll
          for (int t = 0; t < 32; ++t) xw[t] = *(const u32x4*)(xr + 32 * t); }
        float ss = 0.f;
#pragma unroll
        for (int t = 0; t < 32; ++t) { const u32x4 w = xw[t];
            const float a0 = bf_lo(w.x), a1 = bf_hi(w.x), a2 = bf_lo(w.y), a3 = bf_hi(w.y), a4 = bf_lo(w.z), a5 = bf_hi(w.z), a6 = bf_lo(w.w), a7 = bf_hi(w.w);
            ss += (a0 * a0 + a1 * a1) + (a2 * a2 + a3 * a3) + (a4 * a4 + a5 * a5) + (a6 * a6 + a7 * a7); }
        ss += __shfl_xor(ss, 16); ss += __shfl_xor(ss, 32);
        const float rinv = 1.0f / sqrtf(ss * (1.0f / D) + EPS);
#pragma unroll
        for (int t = 0; t < 32; ++t) asm volatile("" : "+v"(xw[t]));
        const LAS float* const gl = nvl + 8 * g; const LAS float* const shl = nvl + (1 + mr) * D + 8 * g; const LAS float* const scl = nvl + (6 + mr) * D + 8 * g;
        const LAS float* const wl = wrt + r * WRP + 8 * g;
        unsigned char* const h8 = F.H8() + (size_t)row * D + 8 * g;
        f32x4 acc = (f32x4){0.f, 0.f, 0.f, 0.f};
#pragma unroll
        for (int t = 0; t < 32; ++t) { const u32x4 w = xw[t];
            const f32x4 g0 = *(const LAS f32x4*)(gl + 32 * t), g1 = *(const LAS f32x4*)(gl + 32 * t + 4), s00 = *(const LAS f32x4*)(shl + 32 * t), s01 = *(const LAS f32x4*)(shl + 32 * t + 4),
                        s10 = *(const LAS f32x4*)(scl + 32 * t), s11 = *(const LAS f32x4*)(scl + 32 * t + 4), w0 = *(const LAS f32x4*)(wl + 32 * t), w1 = *(const LAS f32x4*)(wl + 32 * t + 4);
            float h[8];
            h[0] = (bf_lo(w.x) * rinv * g0.x) * (1.0f + s10.x) + s00.x; h[1] = (bf_hi(w.x) * rinv * g0.y) * (1.0f + s10.y) + s00.y; h[2] = (bf_lo(w.y) * rinv * g0.z) * (1.0f + s10.z) + s00.z; h[3] = (bf_hi(w.y) * rinv * g0.w) * (1.0f + s10.w) + s00.w;
            h[4] = (bf_lo(w.z) * rinv * g1.x) * (1.0f + s11.x) + s01.x; h[5] = (bf_hi(w.z) * rinv * g1.y) * (1.0f + s11.y) + s01.y; h[6] = (bf_lo(w.w) * rinv * g1.z) * (1.0f + s11.z) + s01.z; h[7] = (bf_hi(w.w) * rinv * g1.w) * (1.0f + s11.w) + s01.w;
            u32x2 pk; pk.x = pg8::pack4_fp8(h[0], h[1], h[2], h[3]); pk.y = pg8::pack4_fp8(h[4], h[5], h[6], h[7]);
            *(u32x2*)(h8 + 32 * t) = pk;
            acc = __builtin_amdgcn_mfma_f32_16x16x4f32(w0.x, h[0], acc, 0, 0, 0); acc = __builtin_amdgcn_mfma_f32_16x16x4f32(w0.y, h[1], acc, 0, 0, 0);
            acc = __builtin_amdgcn_mfma_f32_16x16x4f32(w0.z, h[2], acc, 0, 0, 0); acc = __builtin_amdgcn_mfma_f32_16x16x4f32(w0.w, h[3], acc, 0, 0, 0);
            acc = __builtin_amdgcn_mfma_f32_16x16x4f32(w1.x, h[4], acc, 0, 0, 0); acc = __builtin_amdgcn_mfma_f32_16x16x4f32(w1.y, h[5], acc, 0, 0, 0);
            acc = __builtin_amdgcn_mfma_f32_16x16x4f32(w1.z, h[6], acc, 0, 0, 0); acc = __builtin_amdgcn_mfma_f32_16x16x4f32(w1.w, h[7], acc, 0, 0, 0);
            __builtin_amdgcn_sched_barrier(0); }
        float mx = fmaxf(fmaxf(acc.x, acc.y), fmaxf(acc.z, acc.w));
        mx = fmaxf(mx, __shfl_xor(mx, 16)); mx = fmaxf(mx, __shfl_xor(mx, 32));
        const float e0 = __expf(acc.x - mx), e1 = __expf(acc.y - mx), e2 = __expf(acc.z - mx), e3 = __expf(acc.w - mx);
        float sum = (e0 + e1) + (e2 + e3);
        sum += __shfl_xor(sum, 16); sum += __shfl_xor(sum, 32);
        const float rs = 1.0f / sum;
        float* const ap = F.aff() + (size_t)(b * NE + 4 * g) * KVROWS + pos;
        ap[0] = e0 * rs; ap[KVROWS] = e1 * rs; ap[2 * KVROWS] = e2 * rs; ap[3 * KVROWS] = e3 * rs;
        { int m1 = -1; asm volatile("" : "+v"(m1));
          *(v4i32*)(F.inv() + (size_t)row * NE + 4 * g) = (v4i32){m1, m1, m1, m1}; }
    }
}

template <bool XBF>
__device__ __forceinline__ void phase_norm2_router(const Frame& F, int l, bool has_ctx) {
    LAS float* wrt = (LAS float*)F.lds;
    { const f32x4* wsrc = (const f32x4*)(F.w_router() + (size_t)l * D * NE) + F.tid * 8;
      f32x4 wv[8];
#pragma unroll
      for (int i = 0; i < 8; ++i) wv[i] = wsrc[i];
#pragma unroll
      for (int i = 0; i < 8; ++i) { const int k = 2 * F.tid + (i >> 2), e0 = (i & 3) * 4; wrt[(e0 + 0) * D + k] = wv[i].x; wrt[(e0 + 1) * D + k] = wv[i].y; wrt[(e0 + 2) * D + k] = wv[i].z; wrt[(e0 + 3) * D + k] = wv[i].w; } }
    LAS float* const nvl = wrt + NE * D;
    { const float* modv = F.mod() + (size_t)l * 5 * PW; const float* gf = F.g_ffn() + l * D; float nv[22];
#pragma unroll
      for (int j = 0; j < 22; ++j) { const int i = F.tid + NTHR * j, r = i >> 10, k = i & 1023; nv[j] = (r == 0) ? gf[k] : (r <= 5 ? modv[(size_t)(r - 1) * PW + 3 * D + k] : modv[(size_t)(r - 6) * PW + 4 * D + k]); }
#pragma unroll
      for (int j = 0; j < 22; ++j) nvl[F.tid + NTHR * j] = nv[j]; }
    __syncthreads();
    const float* modl = F.mod() + (size_t)l * 5 * PW; const int nrows = has_ctx ? MT : ML; const int lane = F.lane;
    const bf16_t* const xb16 = (const bf16_t*)F.wsp(WS_XB16);
    const float* const xlat = (l == 0) ? F.x() : (const float*)F.out(); const float* const xctx = (l == 0) ? F.ctx() : (const float*)F.xc(); const bf16_t* const dlt = F.DELTA();
    constexpr int R = 2;
#define N2_LOAD(V, DW, RB) do { _Pragma("unroll") for (int q = 0; q < R; ++q) { const int row = (RB) + q * F.NGW; const int rc = row < nrows ? row : (RB); \
            const bf16_t* dr = dlt + (size_t)rc * D + 4 * lane; \
            _Pragma("unroll") for (int j = 0; j < 4; ++j) DW[q][j] = *(const u32x2*)(dr + 256 * j); } } while (0)
    int r0 = F.gw; if (r0 >= nrows) return;
    f32x4 gR[4], shR[4], scR[4]; int mrc = -1;
#pragma unroll
    for (int j = 0; j < 4; ++j) gR[j] = *(const LAS f32x4*)(nvl + 4 * lane + 256 * j);
    f32x4 v[R][4]; u32x2 dw[R][4], dn[R][4];
    N2_LOAD(v, dw, r0);
    for (;;) {
        const int rn = r0 + R * F.NGW; const bool more = rn < nrows;
        { const int rl = more ? rn : r0; N2_LOAD(v, dn, rl); }
        __builtin_amdgcn_sched_barrier(0);
#pragma unroll
        for (int q = 0; q < R; ++q) { const int row = r0 + q * F.NGW; const int rc = row < nrows ? row : r0; const int mr = rc < ML ? rc / SEQ : 4;
#pragma unroll
            for (int j = 0; j < 4; ++j) v[q][j] = (f32x4){bf_lo(dw[q][j].x), bf_hi(dw[q][j].x), bf_lo(dw[q][j].y), bf_hi(dw[q][j].y)};
            if (mr != mrc) { mrc = mr;
#pragma unroll
                for (int j = 0; j < 4; ++j) { shR[j] = *(const LAS f32x4*)(nvl + (1 + mr) * D + 4 * lane + 256 * j); scR[j] = *(const LAS f32x4*)(nvl + (6 + mr) * D + 4 * lane + 256 * j); } }
            norm_mod_reg(v[q], gR, shR, scR);
            if (row < nrows) store_row_fp8(F.H8() + (size_t)row * D, v[q], lane); }
        typedef float f32x2 __attribute__((ext_vector_type(2)));
        f32x2 vp[4][4];
#pragma unroll
        for (int j = 0; j < 4; ++j) { vp[j][0] = (f32x2){v[0][j].x, v[1][j].x}; vp[j][1] = (f32x2){v[0][j].y, v[1][j].y}; vp[j][2] = (f32x2){v[0][j].z, v[1][j].z}; vp[j][3] = (f32x2){v[0][j].w, v[1][j].w}; }
        float lg[R][16];
#pragma unroll
        for (int e = 0; e < 16; ++e) { f32x2 acc = (f32x2){0.f, 0.f};
#pragma unroll
            for (int j = 0; j < 4; ++j) { const f32x4 w = *(const LAS f32x4*)(wrt + e * D + 4 * lane + 256 * j); const f32x2 w01 = (f32x2){w.x, w.y}, w23 = (f32x2){w.z, w.w};
                asm("v_pk_fma_f32 %0, %1, %2, %0 op_sel_hi:[1,0,1]" : "+v"(acc) : "v"(vp[j][0]), "v"(w01));
                asm("v_pk_fma_f32 %0, %1, %2, %0 op_sel:[0,1,0] op_sel_hi:[1,1,1]" : "+v"(acc) : "v"(vp[j][1]), "v"(w01));
                asm("v_pk_fma_f32 %0, %1, %2, %0 op_sel_hi:[1,0,1]" : "+v"(acc) : "v"(vp[j][2]), "v"(w23));
                asm("v_pk_fma_f32 %0, %1, %2, %0 op_sel:[0,1,0] op_sel_hi:[1,1,1]" : "+v"(acc) : "v"(vp[j][3]), "v"(w23)); }
            lg[0][e] = acc.x; lg[1][e] = acc.y;
            if ((e & 3) == 3) __builtin_amdgcn_sched_barrier(0); }
#pragma unroll
        for (int q = 0; q < R; ++q) { const int row = r0 + q * F.NGW;
            if (row < nrows) { const bool lat = row < ML; const int b = lat ? row / SEQ : (row - ML) / CTX, pos = lat ? row % SEQ : SEQ + (row - ML) % CTX;
                router_finish(F, lg[q], row, b, pos, lane); } }
        if (!more) break;
#pragma unroll
        for (int q = 0; q < R; ++q)
#pragma unroll
            for (int j = 0; j < 4; ++j) dw[q][j] = dn[q][j];
        r0 = rn;
    }
#undef N2_LOAD
}

__device__ __forceinline__ void topk_unit(const Frame& F, const float* affrow, int n, int k, int* idx_out, float* gate_out, int* inv_base) {
    LAS unsigned* keys = (LAS unsigned*)F.lds; LAS int* hist = (LAS int*)(F.lds + 32768);
    LAS int* misc = (LAS int*)(F.lds + 32768 + 65536);
    const int tid = F.tid, lane = F.lane, wid = F.wave;
    for (int i0 = 0; i0 < n; i0 += 8 * NTHR) { float kv[8];
#pragma unroll
        for (int j = 0; j < 8; ++j) { const int i = i0 + tid + j * NTHR; kv[j] = affrow[i < n ? i : 0]; }
#pragma unroll
        for (int j = 0; j < 8; ++j) { const int i = i0 + tid + j * NTHR; if (i < n) keys[i] = __float_as_uint(kv[j]); } }
    for (int i = tid; i < 8 * 2048; i += NTHR) hist[i] = 0;
    __syncthreads();
    unsigned prefix = 0u; int krem = k;
    {
        for (int i = tid; i < n; i += NTHR) __hip_atomic_fetch_add(&hist[wid * 2048 + (keys[i] >> 20)], 1, __ATOMIC_RELAXED, __HIP_MEMORY_SCOPE_WORKGROUP);
        __syncthreads();
        int h[4], s4 = 0;
#pragma unroll
        for (int q = 0; q < 4; ++q) { int c = 0;
#pragma unroll
            for (int w = 0; w < 8; ++w) c += hist[w * 2048 + 2047 - 4 * tid - q];
            h[q] = c; s4 += c; }
        int incl = s4;
#pragma unroll
        for (int o = 1; o < 64; o <<= 1) { const int tv = __shfl_up(incl, o); if (lane >= o) incl += tv; }
        if (lane == 63) misc[8 + wid] = incl;
        __syncthreads();
        int base = 0;
#pragma unroll
        for (int w = 0; w < 8; ++w) { const int tv = misc[8 + w]; if (w < wid) base += tv; }
        incl += base; const int excl = incl - s4;
        if (excl < krem && incl >= krem) { int c = excl, sel, nk;
            if (c + h[0] >= krem) { sel = 2047 - 4 * tid; nk = krem - c; }
            else { c += h[0]; if (c + h[1] >= krem) { sel = 2046 - 4 * tid; nk = krem - c; }
                else { c += h[1]; if (c + h[2] >= krem) { sel = 2045 - 4 * tid; nk = krem - c; } else { c += h[2]; sel = 2044 - 4 * tid; nk = krem - c; } } }
            misc[0] = sel; misc[1] = nk; }
        __syncthreads();
        prefix = (unsigned)misc[0]; krem = misc[1];
        __syncthreads();
    }
    for (int pass = 1; pass < 4; ++pass) {
        const int shift = (pass == 1) ? 12 : (pass == 2 ? 4 : 0), width = (pass == 3) ? 4 : 8, hs = shift + width; const unsigned bm = (1u << width) - 1u;
        if (tid < 256) hist[tid] = 0;
        __syncthreads();
        for (int i = tid; i < n; i += NTHR) { const unsigned key = keys[i]; if ((key >> hs) == prefix) __hip_atomic_fetch_add(&hist[(key >> shift) & bm], 1, __ATOMIC_RELAXED, __HIP_MEMORY_SCOPE_WORKGROUP); }
        __syncthreads();
        if (wid == 0) {
            const int h0 = hist[255 - 4 * lane], h1 = hist[254 - 4 * lane], h2 = hist[253 - 4 * lane], h3 = hist[252 - 4 * lane];
            const int s = h0 + h1 + h2 + h3; int incl = s;
#pragma unroll
            for (int o = 1; o < 64; o <<= 1) { const int tv = __shfl_up(incl, o); if (lane >= o) incl += tv; }
            const int excl = incl - s;
            if (excl < krem && incl >= krem) { int c = excl, sel, nk;
                if (c + h0 >= krem) { sel = 255 - 4 * lane; nk = krem - c; }
                else { c += h0; if (c + h1 >= krem) { sel = 254 - 4 * lane; nk = krem - c; }
                    else { c += h1; if (c + h2 >= krem) { sel = 253 - 4 * lane; nk = krem - c; } else { c += h2; sel = 252 - 4 * lane; nk = krem - c; } } }
                misc[0] = sel; misc[1] = nk; }
        }
        __syncthreads();
        prefix = (prefix << width) | (unsigned)misc[0]; krem = misc[1];
        __syncthreads();
    }
    const unsigned T = prefix; const int per = (n + NTHR - 1) / NTHR, i0 = tid * per;
    int cg = 0, ce = 0;
    for (int q = 0; q < per; ++q) { const int i = i0 + q; if (i < n) { const unsigned key = keys[i]; cg += (key > T); ce += (key == T); } }
    int pk = cg | (ce << 16), incl = pk;
#pragma unroll
    for (int o = 1; o < 64; o <<= 1) { const int tv = __shfl_up(incl, o); if (lane >= o) incl += tv; }
    if (lane == 63) misc[8 + wid] = incl;
    __syncthreads();
    int base = 0;
#pragma unroll
    for (int w = 0; w < 8; ++w) { const int tv = misc[8 + w]; if (w < wid) base += tv; }
    const int ex = base + incl - pk; int sg = ex & 0xffff, se = ex >> 16; const int ngt = k - krem;
    for (int q = 0; q < per; ++q) { const int i = i0 + q; if (i < n) { const unsigned key = keys[i]; int slot = -1;
        if (key > T) slot = sg++; else if (key == T) { if (se < krem) slot = ngt + se; ++se; }
        if (slot >= 0) { idx_out[slot] = i; gate_out[slot] = __uint_as_float(key); inv_base[(size_t)i * NE] = slot; } } }
    __syncthreads();
}
__device__ __forceinline__ void phase_topk(const Frame& F, int l, bool has_ctx) {
    const int nunits = has_ctx ? 128 : 64;
    for (int u = F.bx; u < nunits; u += F.G) {
        if (u < 64) { const int b = u >> 4, e = u & 15;
            topk_unit(F, F.aff() + (size_t)u * KVROWS, SEQ, CAP, F.idx() + u * CAP, F.gatev() + u * CAP, F.inv() + (size_t)(b * SEQ) * NE + e); }
        else { const int g = u - 64, b = g >> 4, e = g & 15;
            topk_unit(F, F.aff() + (size_t)g * KVROWS + SEQ, CTX, CAPC, F.idx() + MOE_ROWS_LAT + g * CAPC, F.gatev() + MOE_ROWS_LAT + g * CAPC, F.inv() + (size_t)(ML + b * CTX) * NE + e); }
    }
    __syncthreads();
    const int nfree = F.G - nunits, fr = F.bx - nunits;
    if (nfree <= 0) { convert_expert_weights(F, l, 0, EXPERT_ITEMS, F.gw, F.NGW); if (l + 1 < DEPTH) convert_mixer_weights(F, l + 1, 0, MIXER_ITEMS, F.gw, F.NGW); return; }
    if (l + 1 < DEPTH) {
        convert_expert_weights(F, l, 0, EXPERT_ITEMS, F.gw, F.NGW);
        if (fr >= 0) convert_mixer_weights(F, l + 1, 0, MIXER_ITEMS, fr * NWAVES + F.wave, nfree * NWAVES);
    } else {
        const int cut = (EXPERT_ITEMS / 4) * 3;
        convert_expert_weights(F, l, 0, cut, F.gw, F.NGW);
        if (fr >= 0) convert_expert_weights(F, l, cut, EXPERT_ITEMS, fr * NWAVES + F.wave, nfree * NWAVES);
    }
}

#define COL8(lane, j) (512 * ((j) >> 1) + 8 * (lane) + 4 * ((j) & 1))
__device__ __forceinline__ void norm_mod_lds8(f32x4 (&v)[4], const LAS float* g, const LAS float* sh, const LAS float* sc, int lane) {
    float ss = 0.f;
#pragma unroll
    for (int j = 0; j < 4; ++j) ss += (v[j].x * v[j].x + v[j].y * v[j].y) + (v[j].z * v[j].z + v[j].w * v[j].w);
    ss = wave_sum(ss);
    const float rinv = 1.0f / sqrtf(ss * (1.0f / D) + EPS);
#pragma unroll
    for (int j = 0; j < 4; ++j) { const f32x4 gg = *(const LAS f32x4*)(g + COL8(lane, j)), s1 = *(const LAS f32x4*)(sc + COL8(lane, j)), s0 = *(const LAS f32x4*)(sh + COL8(lane, j));
        v[j] = (v[j] * rinv * gg) * (1.0f + s1) + s0; }
}
__device__ __forceinline__ void store_row_bf16_8(bf16_t* orow, const f32x4 (&v)[4], int lane) {
#pragma unroll
    for (int jj = 0; jj < 2; ++jj) { u32x4 w; w.x = cvt_pk_bf16(v[2 * jj].x, v[2 * jj].y); w.y = cvt_pk_bf16(v[2 * jj].z, v[2 * jj].w); w.z = cvt_pk_bf16(v[2 * jj + 1].x, v[2 * jj + 1].y); w.w = cvt_pk_bf16(v[2 * jj + 1].z, v[2 * jj + 1].w);
        *(u32x4*)(orow + 512 * jj + 8 * lane) = w; }
}
__device__ __forceinline__ void store_row_fp8_8(unsigned char* orow, const f32x4 (&v)[4], int lane) {
#pragma unroll
    for (int jj = 0; jj < 2; ++jj) { u32x2 w; w.x = pg8::pack4_fp8(v[2 * jj].x, v[2 * jj].y, v[2 * jj].z, v[2 * jj].w); w.y = pg8::pack4_fp8(v[2 * jj + 1].x, v[2 * jj + 1].y, v[2 * jj + 1].z, v[2 * jj + 1].w);
        *(u32x2*)(orow + 512 * jj + 8 * lane) = w; }
}
__device__ __forceinline__ void phase_combine(const Frame& F, int l, bool has_ctx, bool next_norm, bool dummy = false) {
    const float* modl = F.mod() + (size_t)l * 5 * PW; const int nrows = has_ctx ? MT : ML; const int lane = F.lane;
    const bf16_t* const Y = F.XS(); const int* const invp = F.inv(); const float* const gvp = F.gatev(); float* const outp = F.out(); float* const xcp = F.xc();
    const float* const xlat = (l == 0) ? F.x() : (const float*)F.out(); const float* const xctx = (l == 0) ? F.ctx() : (const float*)F.xc(); const bf16_t* const dlt = F.DELTA();
    LAS float* const cvl = (LAS float*)F.lds;
    { const float* gmn = F.g_mix() + (next_norm ? (l + 1) : l) * D; const float* modn_ = F.mod() + (size_t)(next_norm ? (l + 1) : l) * 5 * PW; float nv[32];
#pragma unroll
      for (int j = 0; j < 32; ++j) { const int i = F.tid + NTHR * j, r = i >> 10, k = i & 1023;
          nv[j] = (r < 5) ? modl[(size_t)r * PW + 5 * D + k] : (r == 5 ? gmn[k] : (r <= 10 ? modn_[(size_t)(r - 6) * PW + k] : modn_[(size_t)(r - 11) * PW + D + k])); }
#pragma unroll
      for (int j = 0; j < 32; ++j) cvl[F.tid + NTHR * j] = nv[j]; }
    __syncthreads();
    for (int r0 = F.gw; r0 < nrows; r0 += 2 * F.NGW) {
        const int rA = r0; const bool hasB = (r0 + F.NGW) < nrows; const int rB = hasB ? r0 + F.NGW : r0;
        const bool latA = rA < ML, latB = rB < ML;
        const int bA = latA ? rA / SEQ : (rA - ML) / CTX, bB = latB ? rB / SEQ : (rB - ML) / CTX;
        float* xrA = latA ? outp + (size_t)rA * D : xcp + (size_t)(rA - ML) * D; float* xrB = latB ? outp + (size_t)rB * D : xcp + (size_t)(rB - ML) * D;
        const float* xoA = latA ? xlat + (size_t)rA * D : xctx + (size_t)(rA - ML) * D; const float* xoB = latB ? xlat + (size_t)rB * D : xctx + (size_t)(rB - ML) * D;
        int myinv = invp[(size_t)((lane & 16) ? rB : rA) * NE + (lane & 15)];
        if ((lane & 16) && !hasB) myinv = -1;
        f32x4 xa[4], xb[4];
#pragma unroll
        for (int jj = 0; jj < 2; ++jj) {
            const u32x4 da = *(const u32x4*)(dlt + (size_t)rA * D + 512 * jj + 8 * lane), db = *(const u32x4*)(dlt + (size_t)rB * D + 512 * jj + 8 * lane);
            xa[2 * jj] = (f32x4){bf_lo(da.x), bf_hi(da.x), bf_lo(da.y), bf_hi(da.y)}; xa[2 * jj + 1] = (f32x4){bf_lo(da.z), bf_hi(da.z), bf_lo(da.w), bf_hi(da.w)};
            xb[2 * jj] = (f32x4){bf_lo(db.x), bf_hi(db.x), bf_lo(db.y), bf_hi(db.y)}; xb[2 * jj + 1] = (f32x4){bf_lo(db.z), bf_hi(db.z), bf_lo(db.w), bf_hi(db.w)}; }
        (void)xoA; (void)xoB;
        const unsigned long long bal = __ballot(myinv >= 0);
        unsigned mA = (unsigned)(bal & 0xffffull), mB = (unsigned)((bal >> 16) & 0xffffull);
        f32x4 aa[4], ab2[4];
#pragma unroll
        for (int j = 0; j < 4; ++j) { aa[j] = (f32x4){0.f, 0.f, 0.f, 0.f}; ab2[j] = (f32x4){0.f, 0.f, 0.f, 0.f}; }
        while (mA | mB) {
            size_t yo[4]; float gv[4];
#pragma unroll
            for (int c = 0; c < 4; ++c) {
                const bool isB = c >= 2; unsigned& m = isB ? mB : mA; yo[c] = 0; gv[c] = 0.f;
                if (m) { const int e = __builtin_ctz(m); m &= m - 1u;
                    const int slot = __builtin_amdgcn_readlane(myinv, (isB ? 16 : 0) + e);
                    const bool lat = isB ? latB : latA; const int bb = isB ? bB : bA;
                    const int yrow = lat ? (bb * NE + e) * CAP + slot : MOE_ROWS_LAT + e * 256 + bb * 32 + slot;
                    gv[c] = lat ? gvp[(bb * NE + e) * CAP + slot] : gvp[MOE_ROWS_LAT + (bb * NE + e) * CAPC + slot];
                    yo[c] = (size_t)yrow * D; }
            }
            u32x4 yw[4][2];
#pragma unroll
            for (int c = 0; c < 4; ++c)
#pragma unroll
                for (int jj = 0; jj < 2; ++jj) yw[c][jj] = __builtin_nontemporal_load((const u32x4*)(Y + yo[c] + 512 * jj + 8 * lane));
#pragma unroll
            for (int c = 0; c < 2; ++c)
#pragma unroll
                for (int jj = 0; jj < 2; ++jj) { const u32x4 w = yw[c][jj]; aa[2 * jj].x += gv[c] * bf_lo(w.x); aa[2 * jj].y += gv[c] * bf_hi(w.x); aa[2 * jj].z += gv[c] * bf_lo(w.y); aa[2 * jj].w += gv[c] * bf_hi(w.y);
                    aa[2 * jj + 1].x += gv[c] * bf_lo(w.z); aa[2 * jj + 1].y += gv[c] * bf_hi(w.z); aa[2 * jj + 1].z += gv[c] * bf_lo(w.w); aa[2 * jj + 1].w += gv[c] * bf_hi(w.w); }
#pragma unroll
            for (int c = 2; c < 4; ++c)
#pragma unroll
                for (int jj = 0; jj < 2; ++jj) { const u32x4 w = yw[c][jj]; ab2[2 * jj].x += gv[c] * bf_lo(w.x); ab2[2 * jj].y += gv[c] * bf_hi(w.x); ab2[2 * jj].z += gv[c] * bf_lo(w.y); ab2[2 * jj].w += gv[c] * bf_hi(w.y);
                    ab2[2 * jj + 1].x += gv[c] * bf_lo(w.z); ab2[2 * jj + 1].y += gv[c] * bf_hi(w.z); ab2[2 * jj + 1].z += gv[c] * bf_lo(w.w); ab2[2 * jj + 1].w += gv[c] * bf_hi(w.w); }
        }
        {
            const int mr = latA ? bA : 4; const LAS float* gt2 = cvl + mr * D;
            float* dst = dummy ? (float*)F.HID() + (size_t)(latA ? rA : 0) * D : xrA;
#pragma unroll
            for (int j = 0; j < 4; ++j) { const f32x4 gg = *(const LAS f32x4*)(gt2 + COL8(lane, j)); xa[j] = xa[j] + gg * aa[j]; if (!(next_norm && latA)) __builtin_nontemporal_store(xa[j], (f32x4*)(dst + COL8(lane, j))); }
            if (next_norm && latA && !dummy) store_row_bf16_8((bf16_t*)F.wsp(WS_XB16) + (size_t)rA * D, xa, lane);
            if (next_norm && !dummy) {
                norm_mod_lds8(xa, cvl + 5 * D, cvl + (6 + mr) * D, cvl + (11 + mr) * D, lane); store_row_bf16_8(F.H() + (size_t)rA * D, xa, lane); store_row_fp8_8(F.H8() + (size_t)rA * D, xa, lane); }
        }
        if (hasB) {
            const int mr = latB ? bB : 4; const LAS float* gt2 = cvl + mr * D;
            float* dst = dummy ? (float*)F.HID() + (size_t)(latB ? rB : 0) * D : xrB;
#pragma unroll
            for (int j = 0; j < 4; ++j) { const f32x4 gg = *(const LAS f32x4*)(gt2 + COL8(lane, j)); xb[j] = xb[j] + gg * ab2[j]; if (!(next_norm && latB)) __builtin_nontemporal_store(xb[j], (f32x4*)(dst + COL8(lane, j))); }
            if (next_norm && latB && !dummy) store_row_bf16_8((bf16_t*)F.wsp(WS_XB16) + (size_t)rB * D, xb, lane);
            if (next_norm && !dummy) {
                norm_mod_lds8(xb, cvl + 5 * D, cvl + (6 + mr) * D, cvl + (11 + mr) * D, lane); store_row_bf16_8(F.H() + (size_t)rB * D, xb, lane); store_row_fp8_8(F.H8() + (size_t)rB * D, xb, lane); }
        }
    }
}

__device__ __forceinline__ Frame mkframe(LAS unsigned char* lds) {
    Frame F; F.lds = lds;
    int t = threadIdx.x; asm volatile("" : "+v"(t)); int bx = blockIdx.x; asm volatile("" : "+s"(bx)); int G = gridDim.x; asm volatile("" : "+s"(G));
    F.tid = t; F.lane = t & 63; F.wave = __builtin_amdgcn_readfirstlane(t >> 6); F.G = G; F.bx = bx;
    F.vcu = (G % 8 == 0) ? (bx % 8) * (G / 8) + bx / 8 : bx; F.gw = F.vcu * NWAVES + F.wave; F.NGW = G * NWAVES;
    return F;
}
constexpr int PH_PER_LAYER = 9, NPHASES = 2 + DEPTH * PH_PER_LAYER;

__global__ void __launch_bounds__(NTHR, 2) fwd_kernel(Args args) {
    extern __shared__ __attribute__((aligned(16))) unsigned char lds_raw[];
    LAS unsigned char* const lds = (LAS unsigned char*)lds_raw;
    const int tid0 = threadIdx.x;
    volatile LAS unsigned* MISC = (volatile LAS unsigned*)(lds + MISC_OFF);
    if (tid0 < 32) MISC[tid0] = 0u;
    if (tid0 < 23) { const unsigned long long pv = (tid0 < 21) ? (unsigned long long)args.in[tid0 < 21 ? tid0 : 0] : (tid0 == 21 ? (unsigned long long)args.out : (unsigned long long)args.ws);
        ((LAS unsigned long long*)(lds + TAB_OFF))[tid0] = pv; }
    unsigned char* ws = args.ws;
    __syncthreads();
    XcdBarrier bar; bar.bar = (unsigned*)(ws + WS_CTL) + 1024; bar.x = 0; bar.st = nullptr;
#if MK_ONE_LAUNCH
    bar = xcd_barrier_post((unsigned*)(ws + WS_CTL) + 1024, MISC + 8);
#endif
    const int lo = args.ph_lo, hi = args.ph_hi;
#ifndef PHMASK
#define PHMASK 0xFFFFFFFFu
#endif
#define IN(k) (lo <= (k) && (k) < hi)
#define PM(j) ((PHMASK >> (j)) & 1u)
#ifndef DUPMASK
#define DUPMASK 0u
#endif
#define REPS(j) (((DUPMASK >> (j)) & 1u) ? 2 : 1)
#if MK_ONE_LAUNCH
#ifndef SEAMREP
#define SEAMREP 1
#endif
#define SEAM(k) do { if (IN(k) && IN((k) + 1)) { for (int sr_ = 0; sr_ < SEAMREP; ++sr_) xcd_barrier(bar); } } while (0)
#else
#define SEAM(k) do { } while (0)
#endif

#ifdef PTMASK
#define PT_BEGIN(k) do { if (((PTMASK) >> (k)) & 1u) { if (tid0 == 0) { const unsigned long long t_ = wall_clock64(); MISC[20] = (unsigned)t_; MISC[21] = (unsigned)(t_ >> 32); } } } while (0)
#define PT_END(k) do { if (((PTMASK) >> (k)) & 1u) { if (tid0 == 0) { const unsigned long long t_ = wall_clock64() - (((unsigned long long)MISC[21] << 32) | MISC[20]); const unsigned long long a_ = (((unsigned long long)MISC[23] << 32) | MISC[22]) + t_; MISC[22] = (unsigned)a_; MISC[23] = (unsigned)(a_ >> 32); } } } while (0)
#else
#define PT_BEGIN(k) do { } while (0)
#define PT_END(k) do { } while (0)
#endif
    PT_BEGIN(0);
    for (int rp = 0; rp < REPS(11); ++rp) if (PM(11) && IN(0)) { const Frame F = mkframe(lds); phase_prologue(F); }
    SEAM(0); PT_END(0); PT_BEGIN(1);
    for (int rp = 0; rp < REPS(12); ++rp) if (PM(12) && IN(1)) { const Frame F = mkframe(lds); phase_norm1(F, 0, F.x(), F.ctx()); }
    SEAM(1); PT_END(1);

    for (int l = 0; l < DEPTH; ++l) {
        const int pb = 2 + l * PH_PER_LAYER; const bool has_ctx = (l + 1 < DEPTH);
        PT_BEGIN(pb + 0);
        for (int rp = 0; rp < REPS(0); ++rp) if (PM(0) && IN(pb + 0)) { const Frame F = mkframe(lds);
            { pg8::SchedPlain S; S.T.init(MT / 256, 12, F.G, F.bx); S.A = (const char*)F.H(); S.B = (const char*)F.WinT(); S.atile = (size_t)256 * D * 2; S.btile = (size_t)256 * D * 2; S.pn0 = 0;
              pg8::EpiInProj E{(bf16_t*)F.wsp(0), F.gains() + l * 256, F.gains() + 512};
              pg8::gemm_phase(F.lds, D, D, D, S, E); }
            { pg8::SchedPlain S; S.T.init((has_ctx ? MT : ML) / 256, 12, F.G, F.G - 1 - F.bx); S.A = (const char*)F.H8();     S.B = (const char*)F.WinT() + 6 * MiB; S.atile = (size_t)256 * D; S.btile = (size_t)256 * D; S.pn0 = 12; if (F.G == 256) { S.deal = 1; S.bx = F.bx; }
              pg8::EpiInProjGate E{(bf16_t*)F.wsp(0)};
              pg8::gemm_phase(F.lds, D / 2, D / 2, D / 2, S, E); }
        }
        SEAM(pb + 0); PT_END(pb + 0); PT_BEGIN(pb + 1);
        for (int rp = 0; rp < REPS(1); ++rp) if (PM(1) && IN(pb + 1)) { const Frame F = mkframe(lds); phase_attention(F, l, has_ctx, rp == 0, rp > 0); }
        SEAM(pb + 1); PT_END(pb + 1); PT_BEGIN(pb + 2);
        for (int rp = 0; rp < REPS(2); ++rp) if (PM(2) && IN(pb + 2)) { const Frame F = mkframe(lds);
            pg8::SchedMerge S; S.T.init((has_ctx && !ctx_fused(F, has_ctx) ? MT : ML) / 256, D / 256, F.G, F.bx);     S.Q = (const char*)F.QKV(); S.C = (const char*)F.CONV(); S.W = (const char*)F.WbrT();
            pg8::EpiMerge E{(const unsigned char*)F.GATE(), F.H()};
            pg8::gemm_phase(F.lds, 512, QW, 512, S, E);
        }
        SEAM(pb + 2); PT_END(pb + 2); PT_BEGIN(pb + 3);
        for (int rp = 0; rp < REPS(3); ++rp) if (PM(3) && IN(pb + 3)) { const Frame F = mkframe(lds);
            pg8::SchedPlain S; S.T.init((has_ctx && !ctx_fused(F, has_ctx) ? MT : ML) / 256, D / 256, F.G, F.bx); S.A = (const char*)F.H(); S.B = (const char*)F.WoutT(); S.atile = (size_t)256 * D * 2; S.btile = (size_t)256 * D * 2; S.pn0 = 0;
            pg8::EpiOut E{F.DELTA(), F.mod() + (size_t)l * 5 * PW, F.x(), F.ctx(), (l == 0) ? (const bf16_t*)nullptr : (const bf16_t*)F.wsp(WS_XB16)};
            pg8::gemm_phase(F.lds, D, D, D, S, E);
        }
        SEAM(pb + 3); PT_END(pb + 3); PT_BEGIN(pb + 4);
        for (int rp = 0; rp < REPS(4); ++rp) if (PM(4) && IN(pb + 4)) { const Frame F = mkframe(lds); phase_norm2_mfma(F, l, has_ctx); }
        SEAM(pb + 4); PT_END(pb + 4); PT_BEGIN(pb + 5);
        for (int rp = 0; rp < REPS(5); ++rp) if (PM(5) && IN(pb + 5)) { const Frame F = mkframe(lds); phase_topk(F, l, has_ctx); }
        SEAM(pb + 5); PT_END(pb + 5); PT_BEGIN(pb + 6);
        for (int rp = 0; rp < REPS(6); ++rp) if (PM(6) && IN(pb + 6)) { const Frame F = mkframe(lds);
            pg8::SchedMoE<true> S; S.G = F.G; S.v = F.vcu; S.nN = 8; S.has_ctx = has_ctx; S.A = (const char*)F.H8(); S.W = (const char*)F.WGU(); S.wexp = (size_t)2048 * D; S.idx = F.idx(); S.rb = D;
            pg8::EpiGU E{(unsigned char*)F.HID()};
            pg8::gemm_phase(F.lds, D / 2, D / 2, D / 2, S, E);
        }
        SEAM(pb + 6); PT_END(pb + 6); PT_BEGIN(pb + 7);
        for (int rp = 0; rp < REPS(7); ++rp) if (PM(7) && IN(pb + 7)) { const Frame F = mkframe(lds);
            pg8::SchedMoE<false> S; S.G = F.G; S.v = F.vcu; S.nN = 4; S.has_ctx = has_ctx; S.A = (const char*)F.HID(); S.W = (const char*)F.WD(); S.wexp = (size_t)D * EH; S.idx = nullptr; S.rb = EH;
            pg8::EpiDown E{F.XS()};
            pg8::gemm_phase(F.lds, EH / 2, EH / 2, EH / 2, S, E);
        }
        SEAM(pb + 7); PT_END(pb + 7); PT_BEGIN(pb + 8);
        for (int rp = 0; rp < REPS(8); ++rp) if (PM(8) && IN(pb + 8)) { const Frame F = mkframe(lds); phase_combine(F, l, has_ctx, l + 1 < DEPTH, rp > 0); }
        SEAM(pb + 8); PT_END(pb + 8);
    }
#ifdef PTMASK
    if (blockIdx.x == 0 && tid0 == 0) { const unsigned long long a_ = (((unsigned long long)MISC[23] << 32) | MISC[22]) * (unsigned long long)(PAMP); const unsigned long long t0_ = wall_clock64(); while (wall_clock64() - t0_ < a_) __builtin_amdgcn_s_sleep(32); }
#endif
}

extern "C" void kernel_launch(void* const* d_in, const int* in_sizes, int n_in, void* d_out, int out_size, void* d_ws, size_t ws_size, hipStream_t stream) {
    static int grid = 0;
    if (grid == 0) {
        if (n_in != 21 || out_size != ML * D || ws_size < WS_END) { fprintf(stderr, "kernel_launch: unexpected shapes (n_in %d, out %d, ws %zu)\n", n_in, out_size, ws_size); grid = -1; return; }
        int dev = 0, cus = 0, per_cu = 0;
        if (hipGetDevice(&dev) != hipSuccess || hipDeviceGetAttribute(&cus, hipDeviceAttributeMultiprocessorCount, dev) != hipSuccess) { grid = -1; return; }
        if (hipFuncSetAttribute((const void*)fwd_kernel, hipFuncAttributeMaxDynamicSharedMemorySize, LDS_BYTES) != hipSuccess) { fprintf(stderr, "kernel_launch: hipFuncSetAttribute failed\n"); grid = -1; return; }
        if (hipOccupancyMaxActiveBlocksPerMultiprocessor(&per_cu, (const void*)fwd_kernel, NTHR, LDS_BYTES) != hipSuccess || per_cu < 1) { fprintf(stderr, "kernel_launch: occupancy query reports %d\n", per_cu); }
        (void)hipGetLastError();
        grid = cus;
    }
    if (grid < 0) return;
    (void)hipMemsetAsync((char*)d_ws + WS_CTL, 0, CTL_ZERO_BYTES, stream);
    Args a{};
    for (int i = 0; i < 21; ++i) a.in[i] = (const float*)d_in[i];
    a.out = (float*)d_out; a.ws = (unsigned char*)d_ws;
#if MK_ONE_LAUNCH
    a.ph_lo = 0; a.ph_hi = NPHASES;
    hipLaunchKernelGGL(fwd_kernel, dim3(grid), dim3(NTHR), LDS_BYTES, stream, a);
#else
    for (int p = 0; p < NPHASES; ++p) { a.ph_lo = p; a.ph_hi = p + 1; hipLaunchKernelGGL(fwd_kernel, dim3(grid), dim3(NTHR), LDS_BYTES, stream, a); }
#endif
}
```

```cpp
#include <hip/hip_runtime.h>
#include <hip/hip_bf16.h>
#include <cmath>
#include <cstdio>
#include <cstdint>

#define GAS __attribute__((address_space(1)))
#define LAS __attribute__((address_space(3)))
typedef unsigned short bf16_t;
typedef short bf16x8 __attribute__((ext_vector_type(8)));
typedef short s16x4 __attribute__((ext_vector_type(4)));
typedef float f32x4 __attribute__((ext_vector_type(4)));
typedef float f32x16 __attribute__((ext_vector_type(16)));
typedef unsigned u32x4 __attribute__((ext_vector_type(4)));
typedef unsigned u32x2 __attribute__((ext_vector_type(2)));
typedef int v4i32 __attribute__((ext_vector_type(4)));
typedef int v8i32 __attribute__((ext_vector_type(8)));

#ifndef MK_ONE_LAUNCH
#define MK_ONE_LAUNCH 1
#endif

constexpr int D = 1024, NB = 4, SEQ = 8192, CTX = 256, DEPTH = 2;
constexpr int ML = NB * SEQ, MC = NB * CTX, MT = ML + MC;
constexpr int PW = 6144;
constexpr int QW = 1024, GW = 3072;
constexpr int OFF_QA = 0, OFF_QB = 512;
constexpr int KVROWS = SEQ + CTX;
constexpr int NE = 16, CAP = 1024, CAPC = 32, EH = 1024;
constexpr float EPS = 1e-6f;
constexpr float LOG2E = 1.4426950408889634f;
constexpr float QSCALE = 0.125f * LOG2E;
constexpr int NWAVES = 8, NTHR = 512;

constexpr size_t MiB = 1u << 20;
constexpr size_t WS_CTL = 0, CTL_ZERO_BYTES = 64 * 1024;
constexpr size_t WS_MOD = 1 * MiB;
constexpr size_t WS_GAINS = 1 * MiB + 768 * 1024;
constexpr size_t WS_XC = 2 * MiB;
constexpr size_t WS_AFF = 6 * MiB;
constexpr size_t WS_IDX = 9 * MiB;
constexpr size_t WS_GATEV = 11 * MiB;
constexpr size_t WS_INV = 13 * MiB;
constexpr size_t WS_WIN = 16 * MiB;
constexpr size_t WS_WBR = 28 * MiB;
constexpr size_t WS_WOUT = 31 * MiB;
constexpr size_t WS_H = 33 * MiB;
constexpr size_t WS_KA = 99 * MiB, WS_KB = 108 * MiB, WS_VTA = 117 * MiB, WS_VTB = 126 * MiB;
constexpr size_t WS_QKV = 135 * MiB;
constexpr size_t WS_CONV = 234 * MiB;
constexpr size_t WS_GATE = 333 * MiB;
constexpr size_t WS_XS = 135 * MiB;
constexpr size_t WS_HID = 271 * MiB;
constexpr size_t WS_WGU = 407 * MiB;
constexpr size_t WS_WD = 471 * MiB;
constexpr size_t WS_DELTA = 531 * MiB;
constexpr size_t WS_H8 = 597 * MiB;
constexpr size_t WS_XB16 = 432 * MiB;
constexpr size_t WS_END = 630 * MiB;
constexpr int MOE_ROWS_LAT = NB * NE * CAP;
constexpr int MOE_ROWS = MOE_ROWS_LAT + NE * 256;

constexpr int RING_BYTES = 131072, MISC_OFF = RING_BYTES, LDS_BYTES = 147456;

__device__ __forceinline__ unsigned cvt_pk_bf16(float lo, float hi) { unsigned r; asm("v_cvt_pk_bf16_f32 %0, %1, %2" : "=v"(r) : "v"(lo), "v"(hi)); return r; }
__device__ __forceinline__ float bf_lo(unsigned w) { return __uint_as_float(w << 16); }
__device__ __forceinline__ float bf_hi(unsigned w) { return __uint_as_float(w & 0xffff0000u); }
__device__ __forceinline__ float wave_sum(float v) {
#pragma unroll
    for (int o = 1; o < 64; o <<= 1) v += __shfl_xor(v, o);
    return v;
}
__device__ __forceinline__ float fast_sigmoid(float v) { return __builtin_amdgcn_rcpf(1.0f + __builtin_amdgcn_exp2f(-v * LOG2E)); }
#define LDS_WAIT() asm volatile("s_waitcnt lgkmcnt(0)" ::: "memory")

#define XB_TMO      128
#define XB_XCNT(j)  (256  + 64 * (j))
#define XB_XSUB(j)  (1280 + 64 * (j))
#define XB_XGEN(j)  (2304 + 64 * (j))
#define XB_TOP      3328
#define XB_TOPGEN   3392
#define XCD_BAR_WORDS 3456
#define XB_SPIN_CAP (1u << 18)

__device__ __forceinline__ unsigned xb_ld(unsigned* p)              { return __hip_atomic_load(p, __ATOMIC_RELAXED, __HIP_MEMORY_SCOPE_AGENT); }
__device__ __forceinline__ unsigned xb_add(unsigned* p, unsigned v) { return __hip_atomic_fetch_add(p, v, __ATOMIC_RELAXED, __HIP_MEMORY_SCOPE_AGENT); }
__device__ __forceinline__ unsigned xb_xcc_id() { return (unsigned)__builtin_amdgcn_s_getreg((3 << 11) | 20) & 0xFu; }
#define XB_SPIN(cond, bar) do { unsigned _sp = 0; while (cond) { __builtin_amdgcn_s_sleep(1); \
    if ((++_sp & 255u) == 0u) { if (xb_ld(&(bar)[XB_TMO])) break; if (_sp > XB_SPIN_CAP) { atomicAdd(&(bar)[XB_TMO], 1u); break; } } } } while (0)

struct XcdBarrier { unsigned* bar; unsigned x; volatile LAS unsigned* st; };

__device__ __forceinline__ XcdBarrier xcd_barrier_post(unsigned* bar, volatile LAS unsigned* st) {
    XcdBarrier b; b.bar = bar; b.x = xb_xcc_id(); b.st = st;
    if (threadIdx.x == 0) (void)xb_add(&bar[XB_XCNT(b.x)], 1u);
    return b;
}
__device__ __forceinline__ void xcd_barrier_complete(unsigned* bar, unsigned x, unsigned& nloc, unsigned& nx) {
    const unsigned G = gridDim.x * gridDim.y * gridDim.z;
    unsigned sum, cnt, mine, sp = 0u;
    for (;;) {
        sum = 0u; cnt = 0u; mine = 0u;
#pragma unroll
        for (unsigned j = 0; j < 16; ++j) { const unsigned c = xb_ld(&bar[XB_XCNT(j)]); sum += c; cnt += (c > 0u) ? 1u : 0u; mine = (j == x) ? c : mine; }
        if (sum == G) break;
        __builtin_amdgcn_s_sleep(1);
        if ((++sp & 255u) == 0u) { if (xb_ld(&bar[XB_TMO])) break; if (sp > XB_SPIN_CAP) { atomicAdd(&bar[XB_TMO], 1u); break; } }
    }
    nloc = mine > 0u ? mine : 1u; nx = cnt > 0u ? cnt : 1u;
}
__device__ __forceinline__ void xcd_barrier(const XcdBarrier& b) {
    asm volatile("s_waitcnt vmcnt(0)" ::: "memory");
    __syncthreads();
    if (threadIdx.x == 0) {
        unsigned* bar = b.bar;
        __builtin_amdgcn_s_waitcnt(0);
        unsigned nloc = b.st[0], nx = b.st[1];
        if (nloc == 0u) { xcd_barrier_complete(bar, b.x, nloc, nx); b.st[0] = nloc; b.st[1] = nx; }
        const unsigned old = xb_add(&bar[XB_XSUB(b.x)], 1u);
        const unsigned gen = old / nloc;
        if (old + 1u == (gen + 1u) * nloc) {
            __builtin_amdgcn_fence(__ATOMIC_RELEASE, "agent");
            asm volatile("s_waitcnt vmcnt(0)" ::: "memory");
            const unsigned og = xb_add(&bar[XB_TOP], 1u);
            const unsigned tg = og / nx;
            if (og + 1u == (tg + 1u) * nx) xb_add(&bar[XB_TOPGEN], 1u);
            else XB_SPIN(xb_ld(&bar[XB_TOPGEN]) == tg, bar);
            __builtin_amdgcn_fence(__ATOMIC_ACQUIRE, "agent");
            xb_add(&bar[XB_XGEN(b.x)], 1u);
            asm volatile("s_waitcnt vmcnt(0)" ::: "memory");
        } else {
            XB_SPIN(xb_ld(&bar[XB_XGEN(b.x)]) == gen, bar);
            __builtin_amdgcn_fence(__ATOMIC_ACQUIRE, "agent");
            asm volatile("s_waitcnt vmcnt(0)" ::: "memory");
        }
    }
    __syncthreads();
}

#ifndef PG8_ALIGN_EPI
#define PG8_ALIGN_EPI 1
#endif
#ifndef PG8_SP2
#define PG8_SP2 1
#endif
namespace pg8 {
constexpr int BM = 256, BK = 64, HALF = 128, HTB = HALF * BK * 2, STAGE_BYTES = 8 * HTB, NXCD = 8, WGM = 8;
__host__ __device__ __forceinline__ int lds_byte(int r, int c) { const int st = (r >> 4) * 2 + (c >> 5), rr = r & 15, cc = c & 31, ob = rr * 64 + cc * 2; return st * 1024 + (ob ^ (((ob >> 9) & 1) << 5)); }
__host__ __device__ __forceinline__ void stage_rc(int b, int& R, int& C) { const int st = b / 1024, sb = b % 1024, swz = sb ^ (((sb >> 9) & 1) << 5); R = (st >> 1) * 16 + swz / 64; C = (st & 1) * 32 + (swz % 64) / 2; }
__host__ __device__ __forceinline__ int perm32(int rho) { const int n = rho >> 4, i = rho & 15; return 8 * (i >> 2) + 4 * n + (i & 3); }

__device__ __forceinline__ void glds16_saddr(unsigned voff, const void* sbase, unsigned lds_dst) { unsigned keep;
    asm volatile("s_mov_b32 %0, m0\n\ts_mov_b32 m0, %3\n\ts_nop 0\n\tglobal_load_lds_dwordx4 %1, %2\n\ts_mov_b32 m0, %0" : "=&s"(keep) : "v"(voff), "s"(sbase), "s"(lds_dst) : "memory"); }
struct Unit { const char* a; const char* b; int pm, pn, aux; };

struct TileOrder {
    int nM, nN, nwg, G, c;
    __device__ __forceinline__ void init(int nM_, int nN_, int G_, int c_) { nM = nM_; nN = nN_; nwg = nM * nN; G = G_; c = c_; }
    __device__ __forceinline__ bool tile(int i, int& pm, int& pn) const { return tileL((long)i * G + c, pm, pn); }
    __device__ __forceinline__ bool tileL(const long L, int& pm, int& pn) const {
        if (L >= nwg) return false;
        int wgid = (int)L; { const int q = nwg / NXCD, r = nwg % NXCD, xcd = wgid % NXCD, off = wgid / NXCD; wgid = (xcd < r ? xcd * (q + 1) : r * (q + 1) + (xcd - r) * q) + off; }
        const int nig = WGM * nN, gid = wgid / nig, fm = gid * WGM, gsz = (nM - fm) < WGM ? (nM - fm) : WGM;
        pm = fm + ((wgid % nig) % gsz); pn = (wgid % nig) / gsz; return true;
    }
};

template <class Epi, class Sched>
__device__ __forceinline__ void gemm_phase(LAS unsigned char* lds, const int K, const int lda, const int ldb, const Sched& S, const Epi& E) {
    int tid_ = threadIdx.x; asm volatile("" : "+v"(tid_));
    const int tid = tid_, wid = __builtin_amdgcn_readfirstlane(tid >> 6), lane = tid & 63, wr = wid >> 2, wc = wid & 3, fr = lane & 15, fq = lane >> 4;
    const int nt = K / BK;
    unsigned voffA[2], voffB[2]; int Rr[2];
#pragma unroll
    for (int i = 0; i < 2; ++i) { int R, C; stage_rc(tid * 16 + i * 8192, R, C); const int Rb = Epi::PERM ? ((R & ~31) + perm32(R & 31)) : R;
        voffA[i] = Sched::GATHER ? (unsigned)C * 2u : (unsigned)(R * lda + C) * 2u; voffB[i] = (unsigned)(Rb * ldb + C) * 2u; Rr[i] = R; }
    unsigned gA0 = 0u, gA1 = 0u, nG0 = 0u, nG1 = 0u;
    const size_t kstep = (size_t)(BK * 2);
    const size_t hstepA = (size_t)HALF * lda * 2, hstepB = (size_t)HALF * ldb * 2;
    const unsigned ldsw = (unsigned)wid * 1024u;
    const unsigned ldsbase = (unsigned)__builtin_amdgcn_readfirstlane((int)((unsigned)(uintptr_t)lds + ldsw));
    const int aoff = lds_byte(wr * 64 + fr, fq * 8), boff = lds_byte(wc * 32 + fr, fq * 8);
#define PG8_SA(b, h) (((b) * 2 + (h)) * HTB)
#define PG8_SB(b, h) ((4 + (b) * 2 + (h)) * HTB)
#define PG8_STAGE(bufoff, gbase, voff) do { _Pragma("unroll") for (int _i = 0; _i < 2; ++_i) \
        glds16_saddr((voff)[_i], (const void*)(gbase), ldsbase + (unsigned)((bufoff) + _i * 8192)); } while (0)
#define PG8_STAGE_A(b, h, ptr_plain, ptr_gather, GO) do { if constexpr (Sched::GATHER) { const unsigned go_[2] = { ((GO) & 0xffffu) * S.rowbytes() + voffA[0], ((GO) >> 16) * S.rowbytes() + voffA[1] }; PG8_STAGE(PG8_SA(b, h), ptr_gather, go_); } \
        else PG8_STAGE(PG8_SA(b, h), ptr_plain, voffA); } while (0)
#define PG8_LDA(dst, b, h) do { _Pragma("unroll") for (int m = 0; m < 4; ++m) { \
        if constexpr (Epi::FP8) dst##8[m] = __builtin_shufflevector(*(const LAS v4i32*)(lds + PG8_SA(b, h) + aoff + m * 2048), *(const LAS v4i32*)(lds + PG8_SA(b, h) + aoff + m * 2048 + 1024), 0, 1, 2, 3, 4, 5, 6, 7); \
        else { _Pragma("unroll") for (int k = 0; k < 2; ++k) dst[m][k] = *(const LAS bf16x8*)(lds + PG8_SA(b, h) + aoff + m * 2048 + k * 1024); } } } while (0)
#define PG8_LDB(dst, b, h) do { _Pragma("unroll") for (int n = 0; n < 2; ++n) { \
        if constexpr (Epi::FP8) dst##8[n] = __builtin_shufflevector(*(const LAS v4i32*)(lds + PG8_SB(b, h) + boff + n * 2048), *(const LAS v4i32*)(lds + PG8_SB(b, h) + boff + n * 2048 + 1024), 0, 1, 2, 3, 4, 5, 6, 7); \
        else { _Pragma("unroll") for (int k = 0; k < 2; ++k) dst[n][k] = *(const LAS bf16x8*)(lds + PG8_SB(b, h) + boff + n * 2048 + k * 1024); } } } while (0)
#define PG8_MMA(ai, bj, At, Bt) do { __builtin_amdgcn_s_setprio(1); \
        if constexpr (Epi::FP8) {     \
            _Pragma("unroll") for (int m = 0; m < 4; ++m) _Pragma("unroll") for (int n = 0; n < 2; ++n) { \
                asm volatile("v_mfma_scale_f32_16x16x128_f8f6f4 %0, %1, %2, %0, %3, %3 op_sel_hi:[0,0,0]" : "+v"(acc[ai][bj][m][n]) : "v"(Bt##8[n]), "v"(At##8[m]), "v"(sc8)); }   \
        } else { \
            _Pragma("unroll") for (int m = 0; m < 4; ++m) _Pragma("unroll") for (int n = 0; n < 2; ++n) _Pragma("unroll") for (int k = 0; k < 2; ++k) \
                acc[ai][bj][m][n] = __builtin_amdgcn_mfma_f32_16x16x32_bf16(Bt[n][k], At[m][k], acc[ai][bj][m][n], 0, 0, 0); } \
        __builtin_amdgcn_s_setprio(0); } while (0)
#define PG8_WAIT_V(n) asm volatile("s_waitcnt vmcnt(" #n ")" ::: "memory")
#define PG8_WAIT_L(n) asm volatile("s_waitcnt lgkmcnt(" #n ")" ::: "memory")
#define PG8_BAR __builtin_amdgcn_s_barrier()
#define PG8_SCHED __builtin_amdgcn_sched_barrier(0)
    Unit cur, nxt; int ui = 0;
    if (!S.next(0, cur)) return;
    f32x4 acc[2][2][4][2];
#pragma unroll
    for (int a = 0; a < 2; ++a)
#pragma unroll
        for (int b = 0; b < 2; ++b)
#pragma unroll
            for (int m = 0; m < 4; ++m)
#pragma unroll
                for (int n = 0; n < 2; ++n) acc[a][b][m][n] = (f32x4){0.f, 0.f, 0.f, 0.f};
    const int sc8 = 0x7F7F7F7F;
    bf16x8 At[4][2], B0[2][2], B1[2][2]; v8i32 At8[4], B08[2], B18[2];
    const char* cA = cur.a; const char* cB = cur.b;
    if constexpr (Sched::GATHER) { S.rows(cur, tid, gA0, gA1); }
#if PG8_SP2
    PG8_STAGE(PG8_SB(0, 0), cB, voffB); PG8_STAGE(PG8_SB(0, 1), cB + hstepB, voffB); PG8_STAGE_A(0, 0, cA, cA, gA0); PG8_STAGE_A(0, 1, cA + hstepA, cA, gA1);
    if (wr == 1) PG8_BAR;
    PG8_WAIT_V(2); PG8_BAR;
    PG8_STAGE(PG8_SB(1, 0), cB + kstep, voffB); PG8_STAGE_A(1, 0, cA + kstep, cA + kstep, gA0); PG8_STAGE(PG8_SB(1, 1), cB + hstepB + kstep, voffB);
    PG8_WAIT_V(6); PG8_BAR;
#else
    PG8_STAGE(PG8_SB(0, 0), cB, voffB); PG8_STAGE_A(0, 0, cA, cA, gA0); PG8_STAGE(PG8_SB(0, 1), cB + hstepB, voffB); PG8_STAGE_A(0, 1, cA + hstepA, cA, gA1);
    if (wr == 1) PG8_BAR;
    PG8_WAIT_V(4); PG8_BAR;
    PG8_STAGE(PG8_SB(1, 0), cB + kstep, voffB); PG8_STAGE_A(1, 0, cA + kstep, cA + kstep, gA0); PG8_STAGE(PG8_SB(1, 1), cB + hstepB + kstep, voffB);
    PG8_WAIT_V(6); PG8_BAR;
#endif
    for (;;) {
        const bool has_next = S.next(ui + 1, nxt);
        const char* nA = has_next ? nxt.a : cA; const char* nB = has_next ? nxt.b : cB;
        if constexpr (Sched::GATHER) { if (has_next) S.rows(nxt, tid, nG0, nG1); else { nG0 = gA0; nG1 = gA1; } }
#pragma unroll 1
        for (int t = 0; t < nt; t += 2) {
            const bool last = (t == nt - 2);
            const char* a1 = cA + (size_t)(t + 1) * kstep;
            const char* a2 = last ? nA : cA + (size_t)(t + 2) * kstep; const char* b2 = last ? nB : cB + (size_t)(t + 2) * kstep;
            const char* a3 = a2 + kstep; const char* b3 = b2 + kstep;
            const unsigned s0 = last ? nG0 : gA0, s1 = last ? nG1 : gA1;
#if PG8_SP2
            PG8_LDB(B0, 0, 0); PG8_LDB(B1, 0, 1); PG8_SCHED; PG8_LDA(At, 0, 0); PG8_STAGE_A(1, 1, a1 + hstepA, a1, gA1);
            PG8_WAIT_V(8); PG8_WAIT_L(0); PG8_BAR; PG8_MMA(0, 0, At, B0); PG8_MMA(0, 1, At, B1); PG8_BAR; PG8_SCHED;
            PG8_LDA(At, 0, 1); PG8_STAGE(PG8_SB(0, 0), b2, voffB); PG8_STAGE(PG8_SB(0, 1), b2 + hstepB, voffB); PG8_STAGE_A(0, 0, a2, a2, s0);
            PG8_WAIT_V(8); PG8_WAIT_L(0); PG8_BAR; PG8_MMA(1, 0, At, B0); PG8_MMA(1, 1, At, B1); PG8_BAR; PG8_SCHED;
            PG8_LDB(B0, 1, 0); PG8_LDB(B1, 1, 1); PG8_SCHED; PG8_LDA(At, 1, 0); PG8_STAGE_A(0, 1, a2 + hstepA, a2, s1);
            PG8_WAIT_V(8); PG8_WAIT_L(0); PG8_BAR; PG8_MMA(0, 0, At, B0); PG8_MMA(0, 1, At, B1); PG8_BAR; PG8_SCHED;
            PG8_LDA(At, 1, 1); PG8_STAGE(PG8_SB(1, 0), b3, voffB); PG8_STAGE(PG8_SB(1, 1), b3 + hstepB, voffB); PG8_STAGE_A(1, 0, a3, a3, s0);
            PG8_WAIT_V(8); PG8_WAIT_L(0); PG8_BAR; PG8_MMA(1, 0, At, B0); PG8_MMA(1, 1, At, B1); PG8_BAR; PG8_SCHED;
#else
            PG8_LDB(B0, 0, 0); PG8_SCHED; PG8_LDA(At, 0, 0); PG8_STAGE_A(1, 1, a1 + hstepA, a1, gA1);
            PG8_WAIT_L(8); PG8_BAR; PG8_WAIT_L(0); PG8_MMA(0, 0, At, B0); PG8_BAR; PG8_SCHED;
            PG8_LDB(B1, 0, 1); PG8_STAGE(PG8_SB(0, 0), b2, voffB);
            PG8_BAR; PG8_WAIT_L(0); PG8_MMA(0, 1, At, B1); PG8_BAR;
            PG8_LDA(At, 0, 1); PG8_STAGE_A(0, 0, a2, a2, s0);
            PG8_BAR; PG8_WAIT_L(0); PG8_MMA(1, 0, At, B0); PG8_BAR; PG8_SCHED;
            PG8_STAGE(PG8_SB(0, 1), b2 + hstepB, voffB);
            PG8_WAIT_V(6); PG8_BAR; PG8_MMA(1, 1, At, B1); PG8_BAR;
            PG8_LDB(B0, 1, 0); PG8_SCHED; PG8_LDA(At, 1, 0); PG8_STAGE_A(0, 1, a2 + hstepA, a2, s1);
            PG8_WAIT_L(8); PG8_BAR; PG8_WAIT_L(0); PG8_MMA(0, 0, At, B0); PG8_BAR; PG8_SCHED;
            PG8_LDB(B1, 1, 1); PG8_STAGE(PG8_SB(1, 0), b3, voffB);
            PG8_BAR; PG8_WAIT_L(0); PG8_MMA(0, 1, At, B1); PG8_BAR;
            PG8_LDA(At, 1, 1); PG8_STAGE_A(1, 0, a3, a3, s0);
            PG8_BAR; PG8_WAIT_L(0); PG8_MMA(1, 0, At, B0); PG8_BAR; PG8_SCHED;
            PG8_STAGE(PG8_SB(1, 1), b3 + hstepB, voffB);
            PG8_WAIT_V(6); PG8_BAR; PG8_MMA(1, 1, At, B1); PG8_BAR;
#endif
        }
#if PG8_ALIGN_EPI
        if (wr == 0) PG8_BAR;
#endif
        if constexpr (Epi::FP8) asm volatile("s_nop 15\n\ts_nop 15" ::: "memory");
        { int t_ = tid; asm volatile("" : "+v"(t_)); const int fr_ = t_ & 15, fq_ = (t_ >> 4) & 3;
          E(acc, cur, wr, wc, fr_, fq_); }
        if (!has_next) break;
        bool keep_acc = false; if constexpr (Epi::CHAIN) keep_acc = E.keep(cur);
        if (!keep_acc) {
#pragma unroll
        for (int a = 0; a < 2; ++a)
#pragma unroll
            for (int b = 0; b < 2; ++b)
#pragma unroll
                for (int m = 0; m < 4; ++m)
#pragma unroll
                    for (int n = 0; n < 2; ++n) acc[a][b][m][n] = (f32x4){0.f, 0.f, 0.f, 0.f};
        }
        cur = nxt; cA = nA; cB = nB; ++ui;
        if constexpr (Sched::GATHER) { gA0 = nG0; gA1 = nG1; }
#if PG8_ALIGN_EPI
        if (wr == 1) PG8_BAR;
#endif
    }
    PG8_WAIT_V(0);
#if !PG8_ALIGN_EPI
    if (wr == 0) PG8_BAR;
#endif
    PG8_BAR;
#undef PG8_SA
#undef PG8_SB
#undef PG8_STAGE
#undef PG8_STAGE_A
#undef PG8_LDA
#undef PG8_LDB
#undef PG8_MMA
#undef PG8_WAIT_V
#undef PG8_WAIT_L
#undef PG8_BAR
#undef PG8_SCHED
}

struct SchedPlain {
    static constexpr bool GATHER = false;
    TileOrder T; const char* A; const char* B; size_t atile, btile; int pn0;
    int deal = 0, bx = 0;
    __device__ __forceinline__ bool next(int i, Unit& u) const {
        if (deal) { long L;
            if (i < 5) L = (long)i * 256 + bx;
            else if (i == 5) { if (bx < 48) return false; L = 1280 + (bx - 48); }
            else if (i == 6) { if (bx >= 48 && bx < 96) L = 1488 + (bx - 48); else if (bx >= 208) L = 1536 + (bx - 208); else return false; }
            else return false;
            if (!T.tileL(L, u.pm, u.pn)) return false; }
        else if (!T.tile(i, u.pm, u.pn)) return false;
        u.a = A + (size_t)u.pm * atile; u.b = B + (size_t)u.pn * btile; u.pn += pn0; u.aux = 0; return true; }
};
struct SchedMerge {
    static constexpr bool GATHER = false;
    TileOrder T; const char* Q; const char* C; const char* W;
    __device__ __forceinline__ bool next(int i, Unit& u) const { const int k = i % 3; if (!T.tile(i / 3, u.pm, u.pn)) return false;
        u.a = (k < 2 ? Q + (size_t)(512 * k) * 2 : C) + (size_t)u.pm * 256 * QW * 2; u.b = W + ((size_t)(k * 1024 + u.pn * 256) * 512) * 2; u.aux = k; return true; }
};
struct SchedMergeOne {
    static constexpr bool GATHER = false;
    int pm, pn; const char* Q; const char* C; const char* W;
    __device__ __forceinline__ bool next(int i, Unit& u) const { if (i >= 3) return false; const int k = i; u.pm = pm; u.pn = pn;
        u.a = (k < 2 ? Q + (size_t)(512 * k) * 2 : C) + (size_t)u.pm * 256 * QW * 2; u.b = W + ((size_t)(k * 1024 + u.pn * 256) * 512) * 2; u.aux = k; return true; }
};
struct SchedPlainOne {
    static constexpr bool GATHER = false;
    int pm, pn; const char* A; const char* B; size_t atile, btile;
    __device__ __forceinline__ bool next(int i, Unit& u) const { if (i >= 1) return false; u.pm = pm; u.pn = pn; u.a = A + (size_t)pm * atile; u.b = B + (size_t)pn * btile; u.aux = 0; return true; }
};
template <bool GATHER_> struct SchedMoE {
    static constexpr bool GATHER = GATHER_;
    int G, v, nN, has_ctx; const char* A; const char* W; size_t wexp; const int* idx; int rb;
    __device__ __forceinline__ bool next(int i, Unit& u) const {
        const int L = i * G + v, per = 4 * nN, nlat = 64 * per; int tm, e, pn;
        if (L < nlat) { const int g = L / per, r = L % per; tm = g * 4 + r / nN; pn = r % nN; e = g & 15; }
        else { const int L2 = L - nlat; if (!has_ctx || L2 >= 16 * nN) return false; e = L2 / nN; pn = L2 % nN; tm = 256 + e; }
        u.a = GATHER_ ? A : A + (size_t)tm * 256 * rb; u.b = W + (size_t)e * wexp + (size_t)pn * 256 * rb; u.pm = tm; u.pn = pn; u.aux = e; return true;
    }
    __device__ __forceinline__ unsigned srcrow(int tm, int j) const {
        const bool latent = tm < 256; const int e = tm - 256, b = (j >> 5) & 3, sl = j & 31;
        const int ix = latent ? tm * 256 + j : MOE_ROWS_LAT + (b * NE + e) * CAPC + sl;
        const int base = latent ? (tm >> 6) * SEQ : ML + b * CTX;
        const int v = idx[ix];
        return (latent || j < 128) ? (unsigned)(base + v) : 0u;
    }
    __device__ __forceinline__ unsigned rowbytes() const { return (unsigned)rb; }
    __device__ __forceinline__ void rows(const Unit& u, const int tid, unsigned& p0, unsigned& p1) const {
        int t_ = tid; asm volatile("" : "+v"(t_)); int r0, r1, c_; stage_rc(t_ * 16, r0, c_); stage_rc(t_ * 16 + 8192, r1, c_);
        p0 = srcrow(u.pm, r0) | (srcrow(u.pm, r1) << 16); p1 = srcrow(u.pm, 128 + r0) | (srcrow(u.pm, 128 + r1) << 16);
    }
};

__device__ __forceinline__ unsigned pack4_fp8(float a, float b, float c, float d) {
    unsigned w; asm("v_cvt_pk_fp8_f32 %0, %1, %2" : "=v"(w) : "v"(a), "v"(b)); asm("v_cvt_pk_fp8_f32 %0, %1, %2 op_sel:[0,0,1]" : "+v"(w) : "v"(c), "v"(d)); return w; }
constexpr float WSCALE = 32.0f, WDESCALE = 1.0f / 32.0f;
#ifndef EPI_NT
#define EPI_NT 1
#endif
#if EPI_NT
#define EPI_ST16(p, v) __builtin_nontemporal_store((v), (u32x4*)(p))
#else
#define EPI_ST16(p, v) (*(u32x4*)(p) = (v))
#endif
struct EpiInProj {
    static constexpr bool PERM = true, CHAIN = false, FP8 = false;
    bf16_t* W0;
    const float* gains;
    const float* rope;
    __device__ __forceinline__ void operator()(f32x4 (&acc)[2][2][4][2], const Unit& u, int wr, int wc, int fr, int fq) const {
        if (u.pn < 6) {
            const int hg = u.pn * 4 + wc;
            const bool isv = (hg < 8) && ((hg & 2) != 0), isq = hg >= 8, lat = u.pm < 128;
            const int b = lat ? (u.pm >> 5) : (u.pm - 128);
            const int gsel = (hg < 8) ? ((hg & 4) ? 1 : 0) : (hg < 16 ? 2 : 3);
            const float* gp = gains + gsel * 64 + 8 * fq;
            const f32x4 g1a = *(const f32x4*)gp, g1b = *(const f32x4*)(gp + 4), g2a = *(const f32x4*)(gp + 32), g2b = *(const f32x4*)(gp + 36);
            float frq[8];
            { const f32x4 fa = *(const f32x4*)(rope + 8 * (fq & 1)), fb = *(const f32x4*)(rope + 8 * (fq & 1) + 4); frq[0] = fa[0]; frq[1] = fa[1]; frq[2] = fa[2]; frq[3] = fa[3]; frq[4] = fb[0]; frq[5] = fb[1]; frq[6] = fb[2]; frq[7] = fb[3]; }
            bf16_t* dbase; size_t dpitch; int prow0;
            if (isq) { dbase = W0 + WS_QKV / 2 + OFF_QA + (hg - 8) * 64 + 8 * fq; dpitch = QW; prow0 = u.pm * BM; }
            else { const size_t off = (hg & 4) ? (isv ? WS_VTB : WS_KB) : (isv ? WS_VTA : WS_KA);
                dbase = W0 + off / 2 + (size_t)(b * 2 + (hg & 1)) * KVROWS * 64 + 8 * fq; dpitch = 64; prow0 = lat ? (u.pm & 31) * BM : SEQ; }
#pragma unroll
            for (int ai = 0; ai < 2; ++ai)
#pragma unroll
                for (int m = 0; m < 4; ++m) {
                    const int rt = ai * HALF + wr * 64 + m * 16 + fr;
                    float x1[8], x2[8];
#pragma unroll
                    for (int e = 0; e < 4; ++e) { x1[e] = acc[ai][0][m][0][e]; x1[4 + e] = acc[ai][0][m][1][e]; x2[e] = acc[ai][1][m][0][e]; x2[4 + e] = acc[ai][1][m][1][e]; }
                    if (!isv) {
                        float ss = 0.f;
#pragma unroll
                        for (int e = 0; e < 8; ++e) ss += x1[e] * x1[e] + x2[e] * x2[e];
                        ss += __shfl_xor(ss, 16); ss += __shfl_xor(ss, 32);
                        const float rinv = 1.0f / sqrtf(ss * (1.0f / 64.0f) + EPS);
#pragma unroll
                        for (int e = 0; e < 4; ++e) { x1[e] *= rinv * g1a[e]; x1[4 + e] *= rinv * g1b[e]; x2[e] *= rinv * g2a[e]; x2[4 + e] *= rinv * g2b[e]; }
                        if (lat) {
                            const int rowpos = 4 * (u.pm & 31) + 2 * ai + wr, colpos = 16 * m + fr;
                            const float posf = (float)((fq < 2) ? rowpos : colpos);
#pragma unroll
                            for (int e = 0; e < 8; ++e) { const float ang = posf * frq[e];
                                const float rev = ang * 0.15915494309189535f, cse = __builtin_amdgcn_cosf(rev), sne = __builtin_amdgcn_sinf(rev);
                                const float a1 = x1[e], a2 = x2[e]; x1[e] = a1 * cse - a2 * sne; x2[e] = a2 * cse + a1 * sne; }
                        }
                        if (isq) {
#pragma unroll
                            for (int e = 0; e < 8; ++e) { x1[e] *= QSCALE; x2[e] *= QSCALE; }
                        }
                    }
                    u32x4 w1, w2; w1.x = cvt_pk_bf16(x1[0], x1[1]); w1.y = cvt_pk_bf16(x1[2], x1[3]); w1.z = cvt_pk_bf16(x1[4], x1[5]); w1.w = cvt_pk_bf16(x1[6], x1[7]);
                    w2.x = cvt_pk_bf16(x2[0], x2[1]); w2.y = cvt_pk_bf16(x2[2], x2[3]); w2.z = cvt_pk_bf16(x2[4], x2[5]); w2.w = cvt_pk_bf16(x2[6], x2[7]);
                    bf16_t* dp = dbase + (size_t)(prow0 + rt) * dpitch;
                    *(u32x4*)dp = w1; *(u32x4*)(dp + 32) = w2;
                }
            return;
        }
        if (u.pn >= 8 && u.pn < 12) {
            const int row0 = u.pm * BM + wr * 64 + fr, col0 = 512 + (u.pn - 8) * HALF + wc * 32 + 8 * fq;
#pragma unroll
            for (int ai = 0; ai < 2; ++ai)
#pragma unroll
                for (int m = 0; m < 4; ++m) { const f32x4 c0 = acc[ai][0][m][0], c1 = acc[ai][0][m][1], x0 = acc[ai][1][m][0], x1v = acc[ai][1][m][1];
                    u32x4 w; w.x = cvt_pk_bf16(c0[0] * x0[0], c0[1] * x0[1]); w.y = cvt_pk_bf16(c0[2] * x0[2], c0[3] * x0[3]); w.z = cvt_pk_bf16(c1[0] * x1v[0], c1[1] * x1v[1]); w.w = cvt_pk_bf16(c1[2] * x1v[2], c1[3] * x1v[3]);
                    EPI_ST16(W0 + WS_CONV / 2 + (size_t)(row0 + ai * HALF + m * 16) * QW + col0, w); }
            return;
        }
        const int pnl = u.pn - 6;
        const int row0 = u.pm * BM + wr * 64 + fr, col0 = pnl * BM + wc * 32 + 8 * fq;
        bf16_t* const cbase = W0 + WS_CONV / 2;
#pragma unroll
        for (int ai = 0; ai < 2; ++ai)
#pragma unroll
            for (int m = 0; m < 4; ++m) { bf16_t* rowp = cbase + (size_t)(row0 + ai * HALF + m * 16) * QW + col0;
#pragma unroll
                for (int bj = 0; bj < 2; ++bj) { const f32x4 v0 = acc[ai][bj][m][0], v1 = acc[ai][bj][m][1];
                    u32x4 w; w.x = cvt_pk_bf16(v0[0], v0[1]); w.y = cvt_pk_bf16(v0[2], v0[3]); w.z = cvt_pk_bf16(v1[0], v1[1]); w.w = cvt_pk_bf16(v1[2], v1[3]);
                    EPI_ST16(rowp + bj * HALF, w); } }
    }
};
struct EpiInProjGate {
    static constexpr bool PERM = true, CHAIN = false, FP8 = true;
    bf16_t* W0;
    __device__ __forceinline__ void operator()(f32x4 (&acc)[2][2][4][2], const Unit& u, int wr, int wc, int fr, int fq) const {
        unsigned char* const gt8 = (unsigned char*)W0 + WS_GATE + ((size_t)(u.pm * 12 + (u.pn - 12)) << 16) + (size_t)(((wr * 4 + wc) * 64) + fq * 16 + fr) * 16;
#pragma unroll
        for (int ai = 0; ai < 2; ++ai)
#pragma unroll
            for (int m = 0; m < 4; ++m) { unsigned qb[4];
#pragma unroll
                for (int bj = 0; bj < 2; ++bj)
#pragma unroll
                    for (int n = 0; n < 2; ++n) { unsigned wv = 0u;
#pragma unroll
                        for (int j = 0; j < 4; ++j) { const float ex = __builtin_amdgcn_exp2f(acc[ai][bj][m][n][j] * (-WDESCALE * LOG2E));
                            const float r256 = __builtin_amdgcn_rcpf(__builtin_fmaf(ex, 1.0f / 256.0f, 1.0f / 256.0f)); const unsigned q = (unsigned)fminf(r256, 255.0f); wv |= q << (8 * j); }
                        qb[bj * 2 + n] = wv; }
                EPI_ST16(gt8 + (size_t)((ai * 4 + m) * 512) * 16, ((u32x4){qb[0], qb[1], qb[2], qb[3]})); }
    }
};
struct EpiMerge {
    static constexpr bool PERM = true, CHAIN = true, FP8 = false;
    const unsigned char* Gt; bf16_t* Mg;
    __device__ __forceinline__ bool keep(const Unit& u) const { return u.aux < 2; }
    __device__ __forceinline__ void operator()(f32x4 (&acc)[2][2][4][2], const Unit& u, int wr, int wc, int fr, int fq) const {
        const int row0 = u.pm * BM + wr * 64 + fr, col0 = u.pn * BM + wc * 32 + 8 * fq; const int k = u.aux;
        const unsigned char* const gt8 = Gt + ((size_t)(u.pm * 12 + 4 * k + u.pn) << 16) + (size_t)(((wr * 4 + wc) * 64) + fq * 16 + fr) * 16;
        u32x4 g[2][4], q[2][4];
#pragma unroll
        for (int ai = 0; ai < 2; ++ai)
#pragma unroll
            for (int m = 0; m < 4; ++m) { const unsigned char* gp = gt8 + (size_t)((ai * 4 + m) * 512) * 16;
                g[ai][m] = *(const u32x4*)gp; if (k < 2) q[ai][m] = *(const u32x4*)(gp + ((size_t)4 << 16)); }
        asm volatile("" ::: "memory");
#pragma unroll
        for (int ai = 0; ai < 2; ++ai)
#pragma unroll
            for (int m = 0; m < 4; ++m)
#pragma unroll
                for (int bj = 0; bj < 2; ++bj) {
                    const unsigned g0w = bj ? g[ai][m].z : g[ai][m].x, g1w = bj ? g[ai][m].w : g[ai][m].y;
                    float gk[8];
#pragma unroll
                    for (int j = 0; j < 4; ++j) { gk[j] = ((float)((g0w >> (8 * j)) & 255u) + 0.5f) * (1.0f / 256.0f); gk[4 + j] = ((float)((g1w >> (8 * j)) & 255u) + 0.5f) * (1.0f / 256.0f); }
                    if (k < 2) {
                        const unsigned q0w = bj ? q[ai][m].z : q[ai][m].x, q1w = bj ? q[ai][m].w : q[ai][m].y;
#pragma unroll
                        for (int j = 0; j < 4; ++j) { const float d0 = (float)((q0w >> (8 * j)) & 255u) + 0.5f, d1 = (float)((q1w >> (8 * j)) & 255u) + 0.5f;
                            acc[ai][bj][m][0][j] *= (gk[j] * 256.0f) * __builtin_amdgcn_rcpf(d0); acc[ai][bj][m][1][j] *= (gk[4 + j] * 256.0f) * __builtin_amdgcn_rcpf(d1); }
                    } else {
                        const f32x4 v0 = acc[ai][bj][m][0], v1 = acc[ai][bj][m][1];
                        u32x4 w; w.x = cvt_pk_bf16(v0[0] * gk[0], v0[1] * gk[1]); w.y = cvt_pk_bf16(v0[2] * gk[2], v0[3] * gk[3]); w.z = cvt_pk_bf16(v1[0] * gk[4], v1[1] * gk[5]); w.w = cvt_pk_bf16(v1[2] * gk[6], v1[3] * gk[7]);
                        *(u32x4*)(Mg + (size_t)(row0 + ai * HALF + m * 16) * D + col0 + bj * HALF) = w;
                    }
                }
    }
};
struct EpiOut {
    static constexpr bool PERM = true, CHAIN = false, FP8 = false;
    bf16_t* Dl; const float* modl;
    const float* xf; const float* xcf; const bf16_t* xb16;
    __device__ __forceinline__ void operator()(f32x4 (&acc)[2][2][4][2], const Unit& u, int wr, int wc, int fr, int fq) const {
        const int mr = (u.pm < 128) ? (u.pm >> 5) : 4;
        const float* gt = modl + mr * PW + 2 * D;
        const int row0 = u.pm * BM + wr * 64 + fr, col0 = u.pn * BM + wc * 32 + 8 * fq;
        f32x4 gv[2][2];
#pragma unroll
        for (int bj = 0; bj < 2; ++bj)
#pragma unroll
            for (int n = 0; n < 2; ++n) gv[bj][n] = *(const f32x4*)(gt + col0 + bj * HALF + 4 * n);
#pragma unroll
        for (int ai = 0; ai < 2; ++ai)
#pragma unroll
            for (int m = 0; m < 4; ++m) { const int row = row0 + ai * HALF + m * 16; bf16_t* rowp = Dl + (size_t)row * D + col0;
                f32x4 xa[2], xb[2];
                if (xb16) {
#pragma unroll
                    for (int bj = 0; bj < 2; ++bj) { const u32x4 t = *(const u32x4*)(xb16 + (size_t)row * D + col0 + bj * HALF); xa[bj] = (f32x4){bf_lo(t.x), bf_hi(t.x), bf_lo(t.y), bf_hi(t.y)}; xb[bj] = (f32x4){bf_lo(t.z), bf_hi(t.z), bf_lo(t.w), bf_hi(t.w)}; }
                } else { const float* xr = (u.pm < 128 ? xf + (size_t)row * D : xcf + (size_t)(row - ML) * D) + col0;
#pragma unroll
                    for (int bj = 0; bj < 2; ++bj) { xa[bj] = *(const f32x4*)(xr + bj * HALF); xb[bj] = *(const f32x4*)(xr + bj * HALF + 4); } }
#pragma unroll
                for (int bj = 0; bj < 2; ++bj) { const f32x4 v0 = xa[bj] + acc[ai][bj][m][0] * gv[bj][0], v1 = xb[bj] + acc[ai][bj][m][1] * gv[bj][1];
                    u32x4 w; w.x = cvt_pk_bf16(v0[0], v0[1]); w.y = cvt_pk_bf16(v0[2], v0[3]); w.z = cvt_pk_bf16(v1[0], v1[1]); w.w = cvt_pk_bf16(v1[2], v1[3]);
                    *(u32x4*)(rowp + bj * HALF) = w; } }
    }
};
struct EpiGU {
    static constexpr bool PERM = true, CHAIN = false, FP8 = true;
    unsigned char* Hd;
    __device__ __forceinline__ void operator()(f32x4 (&acc)[2][2][4][2], const Unit& u, int wr, int wc, int fr, int fq) const {
        const int row0 = u.pm * BM + wr * 64 + fr, col0 = u.pn * HALF + wc * 32 + 8 * fq;
#pragma unroll
        for (int ai = 0; ai < 2; ++ai)
#pragma unroll
            for (int m = 0; m < 4; ++m) { unsigned char* rowp = Hd + (size_t)(row0 + ai * HALF + m * 16) * EH + col0;
                float o[8];
#pragma unroll
                for (int n = 0; n < 2; ++n)
#pragma unroll
                    for (int j = 0; j < 4; ++j) { const float a = acc[ai][0][m][n][j] * WDESCALE, uu = acc[ai][1][m][n][j] * WDESCALE; o[4 * n + j] = a * fast_sigmoid(a) * uu; }
                u32x2 w; w.x = pack4_fp8(o[0], o[1], o[2], o[3]); w.y = pack4_fp8(o[4], o[5], o[6], o[7]);
                __builtin_nontemporal_store(w, (u32x2*)rowp); }
    }
};
struct EpiDown {
    static constexpr bool PERM = true, CHAIN = false, FP8 = true;
    bf16_t* Y;
    __device__ __forceinline__ void operator()(f32x4 (&acc)[2][2][4][2], const Unit& u, int wr, int wc, int fr, int fq) const {
        const int row0 = u.pm * BM + wr * 64 + fr, col0 = u.pn * BM + wc * 32 + 8 * fq;
#pragma unroll
        for (int ai = 0; ai < 2; ++ai)
#pragma unroll
            for (int m = 0; m < 4; ++m) { bf16_t* rowp = Y + (size_t)(row0 + ai * HALF + m * 16) * D + col0;
#pragma unroll
                for (int bj = 0; bj < 2; ++bj) { const f32x4 v0 = acc[ai][bj][m][0] * WDESCALE, v1 = acc[ai][bj][m][1] * WDESCALE;
                    u32x4 w; w.x = cvt_pk_bf16(v0[0], v0[1]); w.y = cvt_pk_bf16(v0[2], v0[3]); w.z = cvt_pk_bf16(v1[0], v1[1]); w.w = cvt_pk_bf16(v1[2], v1[3]);
                    EPI_ST16(rowp + bj * HALF, w); } }
    }
};
}

namespace ab {
using bf16=__hip_bfloat16;
using bf16x8=__attribute__((ext_vector_type(8)))short;
using s16x4=__attribute__((ext_vector_type(4)))short;
using f32x16=__attribute__((ext_vector_type(16)))float;
using u32x4=__attribute__((ext_vector_type(4)))unsigned;
constexpr int D=64, QP=1024, KP=64;
constexpr int NW=8,QBLK=32,QB=QBLK*NW,KVBLK=64;
__device__ __forceinline__ int crow(int r,int hi){return (r&3)+8*(r>>2)+4*hi;}
#define SBAR() __builtin_amdgcn_sched_barrier(0)
constexpr int NSLOT=3, SLOTB=8192;
constexpr int LDS_K=0, LDS_V=NSLOT*SLOTB, LDS_WS=2*NSLOT*SLOTB, LDS_OST=LDS_WS+NW*64*4, LDS_BYTES=LDS_OST+NW*4096;
constexpr float C2=0.125f*1.4426950408889634f;
__device__ __forceinline__ void glds16(const void*gsrc,unsigned lds_dst){unsigned keep;
  asm volatile("s_mov_b32 %0, m0\n\ts_mov_b32 m0, %2\n\ts_nop 0\n\tglobal_load_lds_dwordx4 %1, off\n\ts_mov_b32 m0, %0":"=&s"(keep):"v"(gsrc),"s"(lds_dst):"memory");}
__device__ __forceinline__ float max3f(float a,float b,float c){float r;asm("v_max3_f32 %0, %1, %2, %3":"=v"(r):"v"(a),"v"(b),"v"(c));return r;}
__device__ __forceinline__ float max2f(float a,float b){float r;asm("v_max_f32_e32 %0, %1, %2":"=v"(r):"v"(a),"v"(b));return r;}
__device__ __forceinline__ float fadd_s(float a,float b){float r;asm("v_add_f32_e32 %0, %1, %2":"=v"(r):"v"(a),"v"(b));return r;}
__device__ __forceinline__ float fsub_s(float a,float b){float r;asm("v_sub_f32_e32 %0, %1, %2":"=v"(r):"v"(a),"v"(b));return r;}
typedef float f32x2_t __attribute__((ext_vector_type(2))); typedef __bf16 bf16x2_t __attribute__((ext_vector_type(2)));
__device__ __forceinline__ unsigned cvtpk_s(float lo,float hi){f32x2_t v={lo,hi};bf16x2_t b=__builtin_convertvector(v,bf16x2_t);return __builtin_bit_cast(unsigned,b);}
#define WAIT_BAR(N) asm volatile("s_waitcnt vmcnt(" #N ") lgkmcnt(0)\n\ts_barrier":::"memory")

__device__ __forceinline__ void qkt(f32x16&p0,f32x16&p1,const char*Kslot,const bf16x8*qr,const f32x16&negm,int r32,int hi){
  const char*kb=Kslot+hi*1024+r32*16;
  #pragma unroll
  for(int d0=0;d0<4;++d0){
    const bf16x8 b0=*reinterpret_cast<const bf16x8*>(kb+d0*2048);
    const bf16x8 b1=*reinterpret_cast<const bf16x8*>(kb+d0*2048+512);
    if(d0==0){p0=__builtin_amdgcn_mfma_f32_32x32x16_bf16(b0,qr[0],negm,0,0,0);p1=__builtin_amdgcn_mfma_f32_32x32x16_bf16(b1,qr[0],negm,0,0,0);}
    else{p0=__builtin_amdgcn_mfma_f32_32x32x16_bf16(b0,qr[d0],p0,0,0,0);p1=__builtin_amdgcn_mfma_f32_32x32x16_bf16(b1,qr[d0],p1,0,0,0);}}
}
typedef __attribute__((address_space(3))) const char* lds_cptr;
typedef short v4i16_t __attribute__((ext_vector_type(4)));
__device__ __forceinline__ void kload8(bf16x8*kf,lds_cptr kp){
  kf[0]=*(const __attribute__((address_space(3))) bf16x8*)(kp);      kf[1]=*(const __attribute__((address_space(3))) bf16x8*)(kp+512);
  kf[2]=*(const __attribute__((address_space(3))) bf16x8*)(kp+2048); kf[3]=*(const __attribute__((address_space(3))) bf16x8*)(kp+2560);
  kf[4]=*(const __attribute__((address_space(3))) bf16x8*)(kp+4096); kf[5]=*(const __attribute__((address_space(3))) bf16x8*)(kp+4608);
  kf[6]=*(const __attribute__((address_space(3))) bf16x8*)(kp+6144); kf[7]=*(const __attribute__((address_space(3))) bf16x8*)(kp+6656);
}
__device__ __forceinline__ void kload2(bf16x8*kf,lds_cptr kp,int j){ kf[2*j]=*(const __attribute__((address_space(3))) bf16x8*)(kp+j*2048); kf[2*j+1]=*(const __attribute__((address_space(3))) bf16x8*)(kp+j*2048+512); }
__device__ __forceinline__ s16x4 vtr(lds_cptr p){ return __builtin_bit_cast(s16x4,__builtin_amdgcn_ds_read_tr16_b64_v4i16((__attribute__((address_space(3))) v4i16_t*)p)); }
__device__ __forceinline__ float rowmax(const f32x16&p0,const f32x16&p1){
  float a=max3f(p0[0],p0[1],p1[0]),b=max3f(p0[2],p0[3],p1[1]);a=max3f(a,p1[2],p1[3]);
  #pragma unroll
  for(int r=4;r<16;r+=4){a=max3f(a,p0[r],p0[r+1]);b=max3f(b,p0[r+2],p0[r+3]);a=max3f(a,p1[r],p1[r+1]);b=max3f(b,p1[r+2],p1[r+3]);}
  const float m=max2f(a,b);
  auto rr=__builtin_amdgcn_permlane32_swap(__float_as_uint(m),__float_as_uint(m),false,false);
  return max2f(__uint_as_float(rr[0]),__uint_as_float(rr[1]));
}
__device__ __forceinline__ void pv(f32x16*o,int vb,bf16x8 pa0,bf16x8 pa1,bf16x8 pa2,bf16x8 pa3){
  #pragma unroll
  for(int d0=0;d0<2;++d0){s16x4 lo[4],hi[4];
    #pragma unroll
    for(int ks=0;ks<4;++ks){
      asm volatile("ds_read_b64_tr_b16 %0,%1 offset:%c2":"=&v"(lo[ks]):"v"(vb),"i"(d0*4096+ks*1024):"memory");
      asm volatile("ds_read_b64_tr_b16 %0,%1 offset:%c2":"=&v"(hi[ks]):"v"(vb),"i"(d0*4096+ks*1024+512):"memory");}
    asm volatile("s_waitcnt lgkmcnt(0)":::"memory");SBAR();
    #define PK(k) (bf16x8){lo[k][0],lo[k][1],lo[k][2],lo[k][3],hi[k][0],hi[k][1],hi[k][2],hi[k][3]}
    o[d0]=__builtin_amdgcn_mfma_f32_32x32x16_bf16(pa0,PK(0),o[d0],0,0,0);
    o[d0]=__builtin_amdgcn_mfma_f32_32x32x16_bf16(pa1,PK(1),o[d0],0,0,0);
    o[d0]=__builtin_amdgcn_mfma_f32_32x32x16_bf16(pa2,PK(2),o[d0],0,0,0);
    o[d0]=__builtin_amdgcn_mfma_f32_32x32x16_bf16(pa3,PK(3),o[d0],0,0,0);
    #undef PK
  }
}

#ifndef ATTN_STORE16
#define ATTN_STORE16(p,v) (*(u32x4*)(p)=(v))
#endif
template<int THRL,bool WIN,bool HAS_SINK,bool NOMAX> __device__ __forceinline__ void attn_unit(const bf16*Qu,const bf16*__restrict__ Kh,const bf16*__restrict__ Vh,bf16*Ou,const int NT,char*shm,const int tid_in,const int lo,const int q0,const float sink2,const float mfix){
  int tid_o=tid_in; asm volatile("":"+v"(tid_o)); const int tid=tid_o;
  const int lane=tid&63,r32=lane&31,hi=lane>>5; const int wid=__builtin_amdgcn_readfirstlane(tid>>6);
  const bf16*Qw=Qu+(long)(wid*QBLK)*QP;
  const unsigned lds0=(unsigned)(uintptr_t)shm;
  float*wsf=(float*)(shm+LDS_WS)+wid*64;
  const bf16*ksrc=Kh+(long)lane*KP+wid*8;
  const bf16*vsrc=Vh+(long)(16*(wid&3)+(lane>>2))*KP+(wid>>2)*32+(lane&3)*8;
  const unsigned kdst=lds0+LDS_K+wid*1024, vdst=lds0+LDS_V+wid*1024;
  #define KVROW(t) (WIN ? (((t)<4) ? (long)(::SEQ+64*(t)) : (long)(64*(lo-4+(t)))) : (long)(t)*KVBLK)
  #define DMA_K(t,slot) glds16(ksrc+KVROW(t)*KP,(unsigned)__builtin_amdgcn_readfirstlane(kdst+(slot)))
  #define DMA_V(t,slot) glds16(vsrc+KVROW(t)*KP,(unsigned)__builtin_amdgcn_readfirstlane(vdst+(slot)))
  const int vb0=(int)(lds0+LDS_V)+((lane>>4)&1)*32+(lane&3)*8+(4*hi+((lane&15)>>2))*64;
  const char*Kbase=shm+LDS_K; bf16x8 kf[8];
  const lds_cptr shm3=(lds_cptr)shm; const lds_cptr kp0=shm3+LDS_K+hi*1024+r32*16; const lds_cptr vp0=shm3+LDS_V+((lane>>4)&1)*32+(lane&3)*8+(4*hi+((lane&15)>>2))*64;
  DMA_K(0,0);DMA_V(0,0);DMA_K(1,SLOTB);
  bf16x8 qr[4];
  #pragma unroll
  for(int d0=0;d0<4;++d0)qr[d0]=*reinterpret_cast<const bf16x8*>(&Qw[(long)r32*QP+d0*16+hi*8]);
  float mhat=NOMAX?mfix:0.f,l_reg=0.f;f32x16 o[2];o[0]=f32x16{};o[1]=f32x16{};f32x16 negm=f32x16{};
  if constexpr(NOMAX){ _Pragma("unroll") for(int r=0;r<16;++r)negm[r]=-mfix; }
  asm volatile("":"+v"(negm));
  const int qpos_=q0+wid*QBLK+r32;
  #define CMASK(P0,P1,t) do{ if(WIN && (t)>=4){ const int d0_=64*(lo-4+(t))+4*hi-qpos_; \
      _Pragma("unroll") for(int r=0;r<16;++r){ const int d_=d0_+(r&3)+8*(r>>2); if(d_>128||d_<-128)P0[r]=-INFINITY; if(d_+32>128||d_+32<-128)P1[r]=-INFINITY; } } }while(0)
  bool resc=false;
  #define START(P0,P1) do{ resc=false; if constexpr(!NOMAX) { const float rm=rowmax(P0,P1); \
      const float dl=rm; mhat=fadd_s(mhat,dl); \
      _Pragma("unroll") for(int r=0;r<16;++r){P0[r]=fsub_s(P0[r],dl);P1[r]=fsub_s(P1[r],dl);} \
      _Pragma("unroll") for(int r=0;r<16;++r)negm[r]=-mhat; asm volatile("":"+v"(negm)); } \
    _Pragma("unroll") for(int r=0;r<16;++r)P0[r]=__builtin_amdgcn_exp2f(P0[r]); }while(0)
  #define RESC() do{ if(resc){ asm volatile("s_waitcnt lgkmcnt(0)":::"memory"); \
      _Pragma("unroll") for(int d_=0;d_<2;++d_) _Pragma("unroll") for(int r=0;r<16;++r)o[d_][r]*=wsf[crow(r,hi)]; } }while(0)
  f32x16 pA0,pA1,pB0,pB1;
  int sl_prev=0,sl_cur=0,sl_next=SLOTB;
  #define ROT() do{sl_prev=sl_cur;sl_cur=sl_next;sl_next=(sl_next==(NSLOT-1)*SLOTB)?0:sl_next+SLOTB;}while(0)
  DMA_K(2,2*SLOTB);
  WAIT_BAR(3);
  qkt(pA0,pA1,Kbase,qr,negm,r32,hi);asm volatile("s_nop 15\n\ts_nop 7":"+v"(pA0),"+v"(pA1));CMASK(pA0,pA1,0);
  START(pA0,pA1);
  _Pragma("unroll") for(int r=0;r<16;++r)pA1[r]=__builtin_amdgcn_exp2f(pA1[r]);
  WAIT_BAR(0);
  DMA_K(3,0);DMA_V(1,SLOTB);
  ROT();
  kload8(kf,kp0+sl_cur);
  WAIT_BAR(2);
  s16x4 vlo[8],vhi[8]; u32x4 pw0,pw1,pw2,pw3;
  #define PKW(P,B) cvtpk_s(P[B],P[B+1])
  #define PAF(k) __builtin_bit_cast(bf16x8,pw##k)
  #define VFR(i) (bf16x8){vlo[i][0],vlo[i][1],vlo[i][2],vlo[i][3],vhi[i][0],vhi[i][1],vhi[i][2],vhi[i][3]}
  #define PIN(x) asm volatile("":"+v"(x))
  #define MX3(a,b,c) __builtin_fmaxf(__builtin_fmaxf((a),(b)),(c))
  #define GAPA(MF,A0,A1,A2,A3,W0,W1,PW) do{ MF; sacc+=A0; sacc+=A1; sacc+=A2; sacc+=A3; PIN(sacc); W0; W1; PIN(PW); SBAR(); }while(0)
  #define EX(v) __builtin_amdgcn_exp2f(v)
  #define GAPB(MF,X,B) do{ MF; X[B]=EX(X[B]); X[B+1]=EX(X[B+1]); X[B+2]=EX(X[B+2]); X[B+3]=EX(X[B+3]); PIN(X); SBAR(); }while(0)
  #define VRD(i) do{ vlo[i]=vtr(vp_+(((i)>>2)*4096+((i)&3)*1024)); vhi[i]=vtr(vp_+(((i)>>2)*4096+((i)&3)*1024+512)); }while(0)
  #define KRD(G,j) do{ if(G){ kload2(kf,kp0+sl_next,j); SBAR(); } }while(0)
  #define STEP(C0,C1,P0,P1,t,GK,GV,GL) do{ SBAR(); \
    const lds_cptr vp_=vp0+sl_prev; \
    VRD(0); SBAR(); float sacc=(P0[0]+P0[1]); \
    GAPA(C0=__builtin_amdgcn_mfma_f32_32x32x16_bf16(kf[0],qr[0],negm,0,0,0), P0[2],P0[3],P0[4],P0[5],     pw0[0]=PKW(P0,0), pw0[1]=PKW(P0,2), pw0); \
    VRD(4); SBAR(); GAPA(C1=__builtin_amdgcn_mfma_f32_32x32x16_bf16(kf[1],qr[0],negm,0,0,0), P0[6],P0[7],P0[8],P0[9],     pw0[2]=PKW(P0,4), pw0[3]=PKW(P0,6), pw0); \
    VRD(1); SBAR(); GAPA(C0=__builtin_amdgcn_mfma_f32_32x32x16_bf16(kf[2],qr[1],C0,0,0,0),   P0[10],P0[11],P0[12],P0[13], pw1[0]=PKW(P0,8), pw1[1]=PKW(P0,10), pw1); \
    VRD(5); SBAR(); GAPA(C1=__builtin_amdgcn_mfma_f32_32x32x16_bf16(kf[3],qr[1],C1,0,0,0),   P0[14],P0[15],P1[0],P1[1],   pw1[2]=PKW(P0,12),pw1[3]=PKW(P0,14), pw1); \
    VRD(2); SBAR(); GAPA(C0=__builtin_amdgcn_mfma_f32_32x32x16_bf16(kf[4],qr[2],C0,0,0,0),   P1[2],P1[3],P1[4],P1[5],     pw2[0]=PKW(P1,0), pw2[1]=PKW(P1,2), pw2); \
    VRD(6); SBAR(); GAPA(C1=__builtin_amdgcn_mfma_f32_32x32x16_bf16(kf[5],qr[2],C1,0,0,0),   P1[6],P1[7],P1[8],P1[9],     pw2[2]=PKW(P1,4), pw2[3]=PKW(P1,6), pw2); \
    VRD(3); SBAR(); GAPA(C0=__builtin_amdgcn_mfma_f32_32x32x16_bf16(kf[6],qr[3],C0,0,0,0),   P1[10],P1[11],P1[12],P1[13], pw3[0]=PKW(P1,8), pw3[1]=PKW(P1,10), pw3); \
    VRD(7); SBAR(); GAPA(C1=__builtin_amdgcn_mfma_f32_32x32x16_bf16(kf[7],qr[3],C1,0,0,0),   P1[14],P1[15],0.f,0.f,       pw3[2]=PKW(P1,12),pw3[3]=PKW(P1,14), pw3); \
    l_reg+=sacc; \
    if(GK){DMA_K((t)+3,sl_cur);} if(GV){DMA_V((t)+1,sl_next);} \
    CMASK(C0,C1,t); \
    if constexpr(NOMAX) { resc=false; if(__builtin_expect(NT<0,0)){ const float dl=1.f; mhat+=dl;   \
        _Pragma("unroll") for(int r=0;r<16;++r){C0[r]-=dl;C1[r]-=dl;} \
        _Pragma("unroll") for(int r=0;r<16;++r)negm[r]=-mhat; asm volatile("":"+v"(negm)); \
        const float f=__builtin_amdgcn_exp2f(-dl); l_reg*=f; if(hi==0)wsf[r32]=f; resc=true; } } \
    if constexpr(!NOMAX) { float a=MX3(C0[0],C0[1],C1[0]),b=MX3(C0[2],C0[3],C1[1]); a=MX3(a,C1[2],C1[3]); \
      _Pragma("unroll") for(int r=4;r<16;r+=4){a=MX3(a,C0[r],C0[r+1]);b=MX3(b,C0[r+2],C0[r+3]);a=MX3(a,C1[r],C1[r+1]);b=MX3(b,C1[r+2],C1[r+3]);} \
      float rm=__builtin_fmaxf(a,b); { auto rr=__builtin_amdgcn_permlane32_swap(__float_as_uint(rm),__float_as_uint(rm),false,false); rm=__builtin_fmaxf(__uint_as_float(rr[0]),__uint_as_float(rr[1])); } \
      resc=false; \
      if(__builtin_expect(__any(rm>(float)THRL),0)){ const float dl=__builtin_fmaxf(rm,0.f); mhat+=dl; \
        _Pragma("unroll") for(int r=0;r<16;++r){C0[r]-=dl;C1[r]-=dl;} \
        _Pragma("unroll") for(int r=0;r<16;++r)negm[r]=-mhat; asm volatile("":"+v"(negm)); \
        const float f=__builtin_amdgcn_exp2f(-dl); l_reg*=f; if(hi==0)wsf[r32]=f; resc=true; } } \
    SBAR(); \
    GAPB(o[0]=__builtin_amdgcn_mfma_f32_32x32x16_bf16(PAF(0),VFR(0),o[0],0,0,0), C0,0); \
    GAPB(o[1]=__builtin_amdgcn_mfma_f32_32x32x16_bf16(PAF(0),VFR(4),o[1],0,0,0), C0,4); \
    KRD(GL,0); GAPB(o[0]=__builtin_amdgcn_mfma_f32_32x32x16_bf16(PAF(1),VFR(1),o[0],0,0,0), C0,8); \
    KRD(GL,1); GAPB(o[1]=__builtin_amdgcn_mfma_f32_32x32x16_bf16(PAF(1),VFR(5),o[1],0,0,0), C0,12); \
    KRD(GL,2); GAPB(o[0]=__builtin_amdgcn_mfma_f32_32x32x16_bf16(PAF(2),VFR(2),o[0],0,0,0), C1,0); \
    KRD(GL,3); GAPB(o[1]=__builtin_amdgcn_mfma_f32_32x32x16_bf16(PAF(2),VFR(6),o[1],0,0,0), C1,4); \
    GAPB(o[0]=__builtin_amdgcn_mfma_f32_32x32x16_bf16(PAF(3),VFR(3),o[0],0,0,0), C1,8); \
    GAPB(o[1]=__builtin_amdgcn_mfma_f32_32x32x16_bf16(PAF(3),VFR(7),o[1],0,0,0), C1,12); \
    }while(0)
  int t=1;
  for(;t+5<NT;t+=2){
    STEP(pB0,pB1,pA0,pA1,t,true,true,true);     WAIT_BAR(2); RESC(); ROT();
    STEP(pA0,pA1,pB0,pB1,t+1,true,true,true);   WAIT_BAR(2); RESC(); ROT();
  }
  #define ENDW(tt) do{ if((tt)+3<NT){WAIT_BAR(2);} else if((tt)+2<NT){WAIT_BAR(1);} else {WAIT_BAR(0);} }while(0)
  for(;t+1<NT;t+=2){
    STEP(pB0,pB1,pA0,pA1,t,(t+3<NT),(t+1<NT),(t+1<NT));       ENDW(t);   RESC(); ROT();
    STEP(pA0,pA1,pB0,pB1,t+1,(t+4<NT),(t+2<NT),(t+2<NT));     ENDW(t+1); RESC(); ROT();
  }
  STEP(pB0,pB1,pA0,pA1,NT-1,false,false,false); RESC();
  { float sacc=pB0[0]+pB0[1]; _Pragma("unroll") for(int r=2;r<16;++r)sacc+=pB0[r]; _Pragma("unroll") for(int r=0;r<16;++r)sacc+=pB1[r]; l_reg+=sacc;
    pw0=(u32x4){PKW(pB0,0),PKW(pB0,2),PKW(pB0,4),PKW(pB0,6)};pw1=(u32x4){PKW(pB0,8),PKW(pB0,10),PKW(pB0,12),PKW(pB0,14)};pw2=(u32x4){PKW(pB1,0),PKW(pB1,2),PKW(pB1,4),PKW(pB1,6)};pw3=(u32x4){PKW(pB1,8),PKW(pB1,10),PKW(pB1,12),PKW(pB1,14)};
    SBAR(); pv(o,vb0+sl_cur,PAF(0),PAF(1),PAF(2),PAF(3)); }
  #undef PKW
  #undef PAF
  #undef VFR
  #undef PIN
  #undef MX3
  #undef GAPA
  #undef GAPB
  #undef EX
  #undef VRD
  #undef KRD
  #undef STEP
  #undef ENDW
  {auto rr=__builtin_amdgcn_permlane32_swap(__float_as_uint(l_reg),__float_as_uint(l_reg),false,false);l_reg=__uint_as_float(rr[0])+__uint_as_float(rr[1]);}
  if(HAS_SINK) l_reg+=__builtin_amdgcn_exp2f(sink2-mhat);
  if(hi==0)wsf[32+r32]=l_reg;asm volatile("s_waitcnt lgkmcnt(0)":::"memory");
  float rli[16];
  #pragma unroll
  for(int r=0;r<16;++r)rli[r]=__builtin_amdgcn_rcpf(wsf[32+crow(r,hi)]);
  bf16*Ow=Ou+(long)(wid*QBLK)*QP;
  { bf16*stg=(bf16*)(shm+LDS_OST)+wid*2048;
    #pragma unroll
    for(int r=0;r<16;++r){const int orow=crow(r,hi);
      #pragma unroll
      for(int d0=0;d0<2;++d0)stg[orow*64+d0*32+r32]=__float2bfloat16(o[d0][r]*rli[r]);}
    asm volatile("s_waitcnt lgkmcnt(0)":::"memory");
    #pragma unroll
    for(int i=0;i<4;++i){const int row=i*8+(lane>>3),ch=lane&7; const u32x4 v=*(const u32x4*)(stg+row*64+ch*8); ATTN_STORE16(Ow+(long)row*QP+ch*8,v);} }
  asm volatile("s_waitcnt lgkmcnt(0)\n\ts_barrier":::"memory");
  #undef DMA_K
  #undef DMA_V
  #undef KVROW
  #undef CMASK
  #undef START
  #undef RESC
  #undef ROT
}
constexpr int ATTN_LDS_BYTES=LDS_BYTES;
#undef SBAR
#undef WAIT_BAR
}

struct Args { const float* in[21]; float* out; unsigned char* ws; int ph_lo, ph_hi; };

constexpr int TAB_OFF = MISC_OFF + 256;
struct Frame {
    LAS unsigned char* lds; int tid, lane, wave, G, bx, vcu, gw, NGW;
    __device__ __forceinline__ unsigned long long tab(int i) const { const u32x2 v = ((const LAS u32x2*)(lds + TAB_OFF))[i];
        const unsigned lo = __builtin_amdgcn_readfirstlane(v.x), hi = __builtin_amdgcn_readfirstlane(v.y); return ((unsigned long long)hi << 32) | lo; }
    __device__ __forceinline__ const float* in(int i) const { return (const float*)(const GAS float*)tab(i); }
    __device__ __forceinline__ unsigned char* wsp(size_t off) const { return (unsigned char*)(GAS unsigned char*)(tab(22) + off); }
#define FIN(name, i) __device__ __forceinline__ const float* name() const { return in(i); }
    FIN(x, 0) FIN(c, 1) FIN(ctx, 2) FIN(c_ctx, 3) FIN(w_ada, 4) FIN(b_ada, 5) FIN(g_mix, 6) FIN(g_ffn, 7) FIN(w_in, 8) FIN(qg_a, 9) FIN(kg_a, 10) FIN(qg_b, 11) FIN(kg_b, 12)
    FIN(sink_b, 13) FIN(conv_w, 14) FIN(w_branch, 15) FIN(w_out, 16) FIN(w_router, 17) FIN(w_eg, 18) FIN(w_eu, 19) FIN(w_ed, 20)
#undef FIN
    __device__ __forceinline__ float* out() const { return (float*)(GAS float*)tab(21); }
#define FWS(type, name, off) __device__ __forceinline__ type* name() const { return (type*)wsp(off); }
    FWS(float, mod, WS_MOD) FWS(float, gains, WS_GAINS) FWS(float, xc, WS_XC) FWS(float, aff, WS_AFF) FWS(float, gatev, WS_GATEV) FWS(int, idx, WS_IDX) FWS(int, inv, WS_INV)
    FWS(bf16_t, WinT, WS_WIN) FWS(bf16_t, WbrT, WS_WBR) FWS(bf16_t, WoutT, WS_WOUT) FWS(bf16_t, H, WS_H) FWS(bf16_t, KA, WS_KA) FWS(bf16_t, KB, WS_KB) FWS(bf16_t, VA, WS_VTA) FWS(bf16_t, VB, WS_VTB)
    FWS(bf16_t, QKV, WS_QKV) FWS(bf16_t, CONV, WS_CONV) FWS(bf16_t, GATE, WS_GATE) FWS(bf16_t, XS, WS_XS) FWS(bf16_t, HID, WS_HID) FWS(bf16_t, WGU, WS_WGU) FWS(bf16_t, WD, WS_WD) FWS(bf16_t, DELTA, WS_DELTA) FWS(unsigned char, H8, WS_H8)
#undef FWS
};

__device__ __forceinline__ void transpose_item(const float* W, int K, int N, bf16_t* WT, int k0, int n0, int drow0, LAS float* scr, int lane) {
    float tv[32];
#pragma unroll
    for (int i = 0; i < 32; ++i) tv[i] = W[(size_t)(k0 + 2 * i + (lane >> 5)) * N + n0 + (lane & 31)];
#pragma unroll
    for (int i = 0; i < 32; ++i) scr[(2 * i + (lane >> 5)) * 33 + (lane & 31)] = tv[i];
    LDS_WAIT(); asm volatile("" ::: "memory");
    const int c = lane & 7;
#pragma unroll
    for (int j = 0; j < 4; ++j) { const int n = (lane >> 3) + 8 * j; const LAS float* s = scr + (8 * c) * 33 + n;
        u32x4 o; o.x = cvt_pk_bf16(s[0 * 33], s[1 * 33]); o.y = cvt_pk_bf16(s[2 * 33], s[3 * 33]); o.z = cvt_pk_bf16(s[4 * 33], s[5 * 33]); o.w = cvt_pk_bf16(s[6 * 33], s[7 * 33]);
        *(u32x4*)(WT + (size_t)(drow0 + n) * K + k0 + 8 * c) = o; }
    LDS_WAIT(); asm volatile("" ::: "memory");
}
__device__ __forceinline__ void transpose_item_fp8(const float* W, int K, int N, unsigned char* WT, int k0, int n0, int drow0, float scale, LAS float* scr, int lane) {
    float tv[32];
#pragma unroll
    for (int i = 0; i < 32; ++i) tv[i] = W[(size_t)(k0 + 2 * i + (lane >> 5)) * N + n0 + (lane & 31)];
#pragma unroll
    for (int i = 0; i < 32; ++i) scr[(2 * i + (lane >> 5)) * 33 + (lane & 31)] = tv[i] * scale;
    LDS_WAIT(); asm volatile("" ::: "memory");
    const int n = lane >> 1, kh = lane & 1; const LAS float* sp = scr + (32 * kh) * 33 + n;
    unsigned w[8];
#pragma unroll
    for (int q = 0; q < 8; ++q) w[q] = pg8::pack4_fp8(sp[(4 * q) * 33], sp[(4 * q + 1) * 33], sp[(4 * q + 2) * 33], sp[(4 * q + 3) * 33]);
    unsigned char* dp = WT + (size_t)(drow0 + n) * K + k0 + 32 * kh;
    *(u32x4*)dp = (u32x4){w[0], w[1], w[2], w[3]}; *(u32x4*)(dp + 16) = (u32x4){w[4], w[5], w[6], w[7]};
    LDS_WAIT(); asm volatile("" ::: "memory");
}
constexpr int MIXER_ITEMS = 16 * 192 + 3 * 8 * 32 + 16 * 32, EXPERT_ITEMS = NE * 3 * 16 * 32;
__device__ __forceinline__ void convert_mixer_weights(const Frame& F, int l, int begin, int end, int first, int stride) {
    LAS float* scr = (LAS float*)(F.lds + F.wave * 8448);
    constexpr int I_IN = 16 * 192, I_BR = 8 * 32, I_OUT = 16 * 32;
    for (int it = begin + first; it < end; it += stride) {
        int r = it;
        if (r < I_IN) { const int kb = r / 192, nb = r % 192, n0 = 32 * nb;
            int drow = n0;
            if (n0 < 1536) drow = (n0 & ~255) + 128 * ((n0 & 63) >> 5) + 32 * ((n0 & 255) >> 6);
            else if (n0 >= 2048 && n0 < 3072) { const int isx = n0 >= 2560, ch = n0 - (isx ? 2560 : 2048); drow = (8 + (ch >> 7)) * 256 + 128 * isx + (ch & 127); }
            if (n0 >= 3072) transpose_item_fp8(F.w_in() + (size_t)l * D * PW, D, PW, (unsigned char*)F.WinT() + 6 * MiB, 64 * kb, n0, n0 - 3072, pg8::WSCALE, scr, F.lane);
            else transpose_item(F.w_in() + (size_t)l * D * PW, D, PW, F.WinT(), 64 * kb, n0, drow, scr, F.lane);
            continue; } r -= I_IN;
        if (r < 3 * I_BR) { const int k3 = r / I_BR, q = r % I_BR, kb = q / 32, nb = q % 32;
            transpose_item(F.w_branch() + ((size_t)l * 3 + k3) * 512 * D, 512, D, F.WbrT() + (size_t)k3 * D * 512, 64 * kb, 32 * nb, 32 * nb, scr, F.lane); continue; } r -= 3 * I_BR;
        { const int kb = r / 32, nb = r % 32; transpose_item(F.w_out() + (size_t)l * D * D, D, D, F.WoutT(), 64 * kb, 32 * nb, 32 * nb, scr, F.lane); }
    }
}
__device__ __forceinline__ void convert_expert_weights(const Frame& F, int l, int begin, int end, int first, int stride) {
    LAS float* scr = (LAS float*)(F.lds + F.wave * 8448);
    constexpr int PER = 16 * 32;
    for (int it = begin + first; it < end; it += stride) {
        const int e = it / (3 * PER), r = it % (3 * PER), which = r / PER, q = r % PER, kb = q / 32, nb = q % 32, n0 = 32 * nb;
        const size_t eo = ((size_t)l * NE + e) * (size_t)D * EH;
        unsigned char* const wgu = (unsigned char*)F.WGU(); unsigned char* const wd = (unsigned char*)F.WD();
        if (which == 0) transpose_item_fp8(F.w_eg() + eo, D, EH, wgu + (size_t)e * 2048 * D, 64 * kb, n0, (n0 >> 7) * 256 + (n0 & 127), pg8::WSCALE, scr, F.lane);
        else if (which == 1) transpose_item_fp8(F.w_eu() + eo, D, EH, wgu + (size_t)e * 2048 * D, 64 * kb, n0, (n0 >> 7) * 256 + 128 + (n0 & 127), pg8::WSCALE, scr, F.lane);
        else transpose_item_fp8(F.w_ed() + eo, EH, D, wd + (size_t)e * D * EH, 64 * kb, n0, n0, pg8::WSCALE, scr, F.lane);
    }
}

__device__ __forceinline__ void norm_mod(f32x4 (&v)[4], const float* g, const float* sh, const float* sc, int lane) {
    f32x4 gg[4], s1[4], s0[4];
#pragma unroll
    for (int j = 0; j < 4; ++j) { gg[j] = *(const f32x4*)(g + 4 * lane + 256 * j); s1[j] = *(const f32x4*)(sc + 4 * lane + 256 * j); s0[j] = *(const f32x4*)(sh + 4 * lane + 256 * j); }
    float ss = 0.f;
#pragma unroll
    for (int j = 0; j < 4; ++j) ss += (v[j].x * v[j].x + v[j].y * v[j].y) + (v[j].z * v[j].z + v[j].w * v[j].w);
    ss = wave_sum(ss);
    const float rinv = 1.0f / sqrtf(ss * (1.0f / D) + EPS);
#pragma unroll
    for (int j = 0; j < 4; ++j) v[j] = (v[j] * rinv * gg[j]) * (1.0f + s1[j]) + s0[j];
}
__device__ __forceinline__ void norm_mod_lds(f32x4 (&v)[4], const LAS float* g, const LAS float* sh, const LAS float* sc, int lane) {
    float ss = 0.f;
#pragma unroll
    for (int j = 0; j < 4; ++j) ss += (v[j].x * v[j].x + v[j].y * v[j].y) + (v[j].z * v[j].z + v[j].w * v[j].w);
    ss = wave_sum(ss);
    const float rinv = 1.0f / sqrtf(ss * (1.0f / D) + EPS);
#pragma unroll
    for (int j = 0; j < 4; ++j) { const f32x4 gg = *(const LAS f32x4*)(g + 4 * lane + 256 * j), s1 = *(const LAS f32x4*)(sc + 4 * lane + 256 * j), s0 = *(const LAS f32x4*)(sh + 4 * lane + 256 * j);
        v[j] = (v[j] * rinv * gg) * (1.0f + s1) + s0; }
}
__device__ __forceinline__ void norm_mod_reg(f32x4 (&v)[4], const f32x4 (&gg)[4], const f32x4 (&s0)[4], const f32x4 (&s1)[4]) {
    float ss = 0.f;
#pragma unroll
    for (int j = 0; j < 4; ++j) ss += (v[j].x * v[j].x + v[j].y * v[j].y) + (v[j].z * v[j].z + v[j].w * v[j].w);
    ss = wave_sum(ss);
    const float rinv = 1.0f / sqrtf(ss * (1.0f / D) + EPS);
#pragma unroll
    for (int j = 0; j < 4; ++j) v[j] = (v[j] * rinv * gg[j]) * (1.0f + s1[j]) + s0[j];
}
__device__ __forceinline__ void store_row_fp8(unsigned char* orow, const f32x4 (&v)[4], int lane) {
#pragma unroll
    for (int j = 0; j < 4; ++j) *(unsigned*)(orow + 4 * lane + 256 * j) = pg8::pack4_fp8(v[j].x, v[j].y, v[j].z, v[j].w);
}
__device__ __forceinline__ void store_row_bf16(bf16_t* orow, const f32x4 (&v)[4], int lane) {
#pragma unroll
    for (int j = 0; j < 4; ++j) { u32x2 w; w.x = cvt_pk_bf16(v[j].x, v[j].y); w.y = cvt_pk_bf16(v[j].z, v[j].w); *(u32x2*)(orow + 4 * lane + 256 * j) = w; }
}

__device__ const float kInvFreq[16] = { 1.0f, 0.5623413251903491f, 0.31622776601683794f, 0.17782794100389228f, 0.1f, 0.05623413251903491f, 0.031622776601683794f, 0.017782794100389228f,
                                        0.01f, 0.005623413251903491f, 0.0031622776601683794f, 0.0017782794100389228f, 0.001f, 0.0005623413251903491f, 0.00031622776601683794f, 0.00017782794100389228f };
__device__ __forceinline__ void phase_prologue(const Frame& F) {
    LAS float* sv = (LAS float*)F.lds;
    LAS float* red = (LAS float*)(F.lds + 20480);
    { const float* cp = F.c(); const float* cc = F.c_ctx(); float cv[10];
#pragma unroll
      for (int j = 0; j < 8; ++j) cv[j] = cp[F.tid + NTHR * j];
      cv[8] = cc[F.tid]; cv[9] = cc[F.tid + NTHR];
#pragma unroll
      for (int j = 0; j < 10; ++j) sv[F.tid + NTHR * j] = cv[j] / (1.0f + __expf(-cv[j])); }
    __syncthreads();
    for (int item = F.bx; item < 2 * 96; item += F.G) {
        const int l = item / 96, col = (item % 96) * 64 + F.lane;
        const float* W = F.w_ada() + (size_t)l * D * PW + col;
        float a0 = 0.f, a1 = 0.f, a2 = 0.f, a3 = 0.f, a4 = 0.f;
#pragma unroll 16
        for (int kk = 0; kk < 128; ++kk) { const int k = F.wave * 128 + kk; const float w = W[(size_t)k * PW];
            a0 += sv[k] * w; a1 += sv[D + k] * w; a2 += sv[2 * D + k] * w; a3 += sv[3 * D + k] * w; a4 += sv[4 * D + k] * w; }
        red[(F.wave * 5 + 0) * 64 + F.lane] = a0; red[(F.wave * 5 + 1) * 64 + F.lane] = a1; red[(F.wave * 5 + 2) * 64 + F.lane] = a2; red[(F.wave * 5 + 3) * 64 + F.lane] = a3; red[(F.wave * 5 + 4) * 64 + F.lane] = a4;
        __syncthreads();
        if (F.wave < 5) { float s = 0.f;
#pragma unroll
            for (int w = 0; w < 8; ++w) s += red[(w * 5 + F.wave) * 64 + F.lane];
            F.mod()[(size_t)(l * 5 + F.wave) * PW + col] = s + F.b_ada()[l * PW + col]; }
        __syncthreads();
    }
    if (F.bx == 0) { float* gt = F.gains(); if (F.tid < 16) gt[512 + F.tid] = kInvFreq[F.tid];
        if (F.tid >= 64 && F.tid < 68) {
            const int l = (F.tid - 64) >> 1, br = (F.tid - 64) & 1; const float* gq = (br ? F.qg_b() : F.qg_a()) + l * 64; const float* gk = (br ? F.kg_b() : F.kg_a()) + l * 64; float mq = 0.f, mk = 0.f;
            for (int d = 0; d < 64; ++d) { mq = fmaxf(mq, fabsf(gq[d])); mk = fmaxf(mk, fabsf(gk[d])); }
            gt[528 + l * 2 + br] = QSCALE * 64.0f * mq * mk * 1.02f; } for (int i = F.tid; i < 2 * 4 * 64; i += NTHR) { const int l = i >> 8, w = (i >> 6) & 3, d = i & 63;
            const float* src = (w == 0) ? F.kg_a() : (w == 1) ? F.kg_b() : (w == 2) ? F.qg_a() : F.qg_b(); gt[i] = src[l * 64 + d]; } }
    __syncthreads();
    convert_mixer_weights(F, 0, 0, MIXER_ITEMS, F.gw, F.NGW);
}

__device__ __forceinline__ void phase_norm1(const Frame& F, int l, const float* xl, const float* xcsrc) {
    const int lane = F.lane;
#define N1_LOAD(V, RB) do { _Pragma("unroll") for (int q = 0; q < 4; ++q) { const int row = (RB) + q * F.NGW; const int rc = row < MT ? row : (RB); \
            const float* xr = rc < ML ? xl + (size_t)rc * D : xcsrc + (size_t)(rc - ML) * D; \
            _Pragma("unroll") for (int j = 0; j < 4; ++j) V[q][j] = *(const f32x4*)(xr + 4 * lane + 256 * j); } } while (0)
    int r0 = F.gw < MT ? F.gw : 0;
    f32x4 v[4][4], vn[4][4];
    N1_LOAD(v, r0);
    LAS float* const nvl = (LAS float*)F.lds;
    { const float* modv = F.mod() + (size_t)l * 5 * PW; const float* gm = F.g_mix() + l * D; float nv[22];
#pragma unroll
      for (int j = 0; j < 22; ++j) { const int i = F.tid + NTHR * j, r = i >> 10, k = i & 1023; nv[j] = (r == 0) ? gm[k] : (r <= 5 ? modv[(size_t)(r - 1) * PW + k] : modv[(size_t)(r - 6) * PW + D + k]); }
#pragma unroll
      for (int j = 0; j < 22; ++j) nvl[F.tid + NTHR * j] = nv[j]; }
    __syncthreads();
    for (;;) {
        const int rn = r0 + 4 * F.NGW; const bool more = rn < MT;
        { const int rl = more ? rn : r0; N1_LOAD(vn, rl); }
        __builtin_amdgcn_sched_barrier(0);
#pragma unroll
        for (int q = 0; q < 4; ++q) { const int row = r0 + q * F.NGW;
            if (row < MT) { const int mr = row < ML ? row / SEQ : 4;
                norm_mod_lds(v[q], nvl, nvl + (1 + mr) * D, nvl + (6 + mr) * D, lane);
                store_row_bf16(F.H() + (size_t)row * D, v[q], lane); store_row_fp8(F.H8() + (size_t)row * D, v[q], lane); } }
        if (!more) break;
#pragma unroll
        for (int q = 0; q < 4; ++q)
#pragma unroll
            for (int j = 0; j < 4; ++j) v[q][j] = vn[q][j];
        r0 = rn;
    }
#undef N1_LOAD
}

__device__ __forceinline__ void phase_elementwise(const Frame& F, int l, int g_begin, int g_end, int gw, int ngw, bool dummy = false) {
    const int lane = F.lane;
    f32x4 cw[3][2];
    { const float* cwp = F.conv_w() + (size_t)l * 3 * 512 + 8 * lane;
#pragma unroll
      for (int q = 0; q < 3; ++q) { cw[q][0] = *(const f32x4*)(cwp + q * 512); cw[q][1] = *(const f32x4*)(cwp + q * 512 + 4); } }
    bf16_t* const Cb = F.CONV();
    for (int g4 = g_begin + gw; g4 < g_end; g4 += ngw) {
        const int g0 = g4 * 4; const bool lat = g0 < ML;
        const int tw = lat ? g0 % SEQ : (g0 - ML) % CTX, nseq = lat ? SEQ : CTX;
        bf16_t* const crow0 = Cb + (size_t)g0 * QW;
        u32x4 uu[6], bg[4];
#pragma unroll
        for (int q = 0; q < 6; ++q) { const int tt = tw + q - 1; const bool ok = (tt >= 0) && (tt < nseq);
            uu[q] = ok ? *(const u32x4*)(crow0 + (ptrdiff_t)(q - 1) * QW + 512 + 8 * lane) : (u32x4){0u, 0u, 0u, 0u}; }
#pragma unroll
        for (int i = 0; i < 4; ++i) bg[i] = *(const u32x4*)(crow0 + (size_t)i * QW + 8 * lane);
        float u[6][8];
#pragma unroll
        for (int q = 0; q < 6; ++q) { u[q][0] = bf_lo(uu[q].x); u[q][1] = bf_hi(uu[q].x); u[q][2] = bf_lo(uu[q].y); u[q][3] = bf_hi(uu[q].y); u[q][4] = bf_lo(uu[q].z); u[q][5] = bf_hi(uu[q].z); u[q][6] = bf_lo(uu[q].w); u[q][7] = bf_hi(uu[q].w); }
#pragma unroll
        for (int i = 0; i < 4; ++i) {
            float o8[8];
#pragma unroll
            for (int e = 0; e < 8; ++e) { const float w0 = (e < 4) ? cw[0][0][e & 3] : cw[0][1][e & 3], w1 = (e < 4) ? cw[1][0][e & 3] : cw[1][1][e & 3], w2 = (e < 4) ? cw[2][0][e & 3] : cw[2][1][e & 3];
                o8[e] = w0 * u[i][e] + w1 * u[i + 1][e] + w2 * u[i + 2][e]; }
            const u32x4 bb = bg[i];
            u32x4 w; w.x = cvt_pk_bf16(o8[0] * bf_lo(bb.x), o8[1] * bf_hi(bb.x)); w.y = cvt_pk_bf16(o8[2] * bf_lo(bb.y), o8[3] * bf_hi(bb.y));
            w.z = cvt_pk_bf16(o8[4] * bf_lo(bb.z), o8[5] * bf_hi(bb.z)); w.w = cvt_pk_bf16(o8[6] * bf_lo(bb.w), o8[7] * bf_hi(bb.w));
            if (!dummy) *(u32x4*)(crow0 + (size_t)i * QW + 8 * lane) = w;
        }
    }
}

__device__ __forceinline__ void ctr_signal(unsigned* ctr) {
    asm volatile("s_waitcnt vmcnt(0)" ::: "memory"); __syncthreads();
    if (threadIdx.x == 0) { __builtin_amdgcn_fence(__ATOMIC_RELEASE, "agent"); asm volatile("s_waitcnt vmcnt(0)" ::: "memory"); (void)xb_add(ctr, 1u); }
}
__device__ __forceinline__ void ctr_wait(unsigned* ctr, unsigned n) {
    if (threadIdx.x == 0) { unsigned sp = 0u; while (xb_ld(ctr) < n) { __builtin_amdgcn_s_sleep(2); if (++sp > (1u << 22)) break; }
        __builtin_amdgcn_fence(__ATOMIC_ACQUIRE, "agent"); asm volatile("s_waitcnt vmcnt(0)" ::: "memory"); }
    __syncthreads();
}
#if defined(DUPMASK)
#define ATT_DUMMY(x) (x)
#else
#define ATT_DUMMY(x) false
#endif
constexpr int CTX_FUSED_G = 256;
__device__ __forceinline__ bool ctx_fused(const Frame& F, bool has_ctx) { return has_ctx && F.G == CTX_FUSED_G; }
__device__ __forceinline__ void phase_attention(const Frame& F, int l, bool has_ctx, bool first, bool dummy_out = false) {
    const float mA = F.gains()[528 + l * 2], mB = F.gains()[528 + l * 2 + 1];
    const bool fastA = mA < 80.0f; (void)mB;
    const bool fused = ctx_fused(F, has_ctx);
    const int v = F.vcu;
    const bool isM = fused && v >= 64 && v < 80, isO = fused && v >= 80 && v < 96;
    const int nwin = v < 64 ? 4 : v < 80 ? 0 : v < 96 ? 2 : v < 192 ? 5 : 4;
    const int wstart = v < 64 ? 4 * v : v < 80 ? 256 : v < 96 ? 256 + 2 * (v - 80) : v < 192 ? 288 + 5 * (v - 96) : 768 + 4 * (v - 192);
    unsigned* const ctrA = (unsigned*)F.wsp(WS_CTL) + 8192 + 64 * (2 * l), * const ctrM = ctrA + 64;
    enum { K_SKIP = 0, K_CONVCTX, K_CONV, K_GLOBAL, K_WINDOW, K_CTXATT, K_MERGE, K_OUT };
    for (int n = 0;; ++n) {
        int kind = K_SKIP, arg = 0;
        if (fused) {
            if (n == 0) kind = v < 32 ? K_CONVCTX : K_SKIP;
            else if (n == 1) { kind = v < 64 ? K_CTXATT : K_SKIP; arg = v; }
            else if (n == 2) kind = isM ? K_SKIP : K_CONV;
            else if (n == 3 || n == 4) { kind = K_GLOBAL; arg = (n - 3) * 256 + v; }
            else if (n == 5) kind = isM ? K_MERGE : K_SKIP;
            else if (n == 6 || n == 7) { kind = K_GLOBAL; arg = (n - 4) * 256 + v; }
            else if (n == 8) kind = isO ? K_OUT : K_SKIP;
            else { const int j = n - 9; if (j >= nwin) break; kind = K_WINDOW; arg = wstart + j; }
        } else {
            if (n == 0) kind = K_CONV;
            else { const int uid = (n - 1) * F.G + v; if (uid >= 2048 + (has_ctx ? 64 : 0)) break;
                if (uid < 1024) { kind = K_GLOBAL; arg = uid; } else if (uid < 2048) { kind = K_WINDOW; arg = uid - 1024; } else { kind = K_CTXATT; arg = uid - 2048; } }
        }
        if (kind == K_CONVCTX) { if (first) phase_elementwise(F, l, ML / 4, MT / 4, v * NWAVES + F.wave, 32 * NWAVES); }
        else if (kind == K_CONV) {
            if (first) { if (fused) { const int vv = v < 64 ? v : v - 16; phase_elementwise(F, l, 0, ML / 4, vv * NWAVES + F.wave, (CTX_FUSED_G - 16) * NWAVES); }
                         else phase_elementwise(F, l, 0, MT / 4, F.gw, F.NGW); }
        } else if (kind == K_GLOBAL) {
            const int uid = arg; const int b = uid >> 8, h = (uid >> 5) & 7, qb = uid & 31, kvh = h >> 2;
            ab::bf16* qo = (ab::bf16*)(F.QKV() + (size_t)(b * SEQ + qb * 256) * QW + OFF_QA + h * 64); ab::bf16* oo = ATT_DUMMY(dummy_out) ? (ab::bf16*)F.H() : qo;
            const ab::bf16* kp = (const ab::bf16*)(F.KA() + (size_t)(b * 2 + kvh) * KVROWS * 64); const ab::bf16* vp = (const ab::bf16*)(F.VA() + (size_t)(b * 2 + kvh) * KVROWS * 64);
            if (fastA) ab::attn_unit<8, false, false, true>(qo, kp, vp, oo, KVROWS / 64, (char*)F.lds, F.tid, 0, 0, 0.f, mA);
            else ab::attn_unit<8, false, false, false>(qo, kp, vp, oo, KVROWS / 64, (char*)F.lds, F.tid, 0, 0, 0.f, 0.f);
        } else if (kind == K_WINDOW) {
            const int w = arg; const int b = w >> 8, h = (w >> 5) & 7, qb = w & 31, kvh = h >> 2;
            ab::bf16* qo = (ab::bf16*)(F.QKV() + (size_t)(b * SEQ + qb * 256) * QW + OFF_QB + h * 64); ab::bf16* oo = ATT_DUMMY(dummy_out) ? (ab::bf16*)F.H() : qo;
            int lo = qb * 4 - 2, hi2 = qb * 4 + 6; if (lo < 0) lo = 0; if (hi2 > SEQ / 64) hi2 = SEQ / 64;
            const size_t ko = (size_t)(b * 2 + kvh) * KVROWS * 64; const float sk = F.sink_b()[l * 8 + h] * LOG2E;
            ab::attn_unit<8, true, true, false>(qo, (const ab::bf16*)(F.KB() + ko), (const ab::bf16*)(F.VB() + ko), oo, 4 + (hi2 - lo), (char*)F.lds, F.tid, lo, qb * 256, sk, 0.f);
        } else if (kind == K_CTXATT) {
            const int w = arg, isb = w >> 5, b = (w >> 3) & 3, h = w & 7, kvh = h >> 2;
            ab::bf16* qo = (ab::bf16*)(F.QKV() + (size_t)(ML + b * CTX) * QW + (isb ? OFF_QB : OFF_QA) + h * 64); ab::bf16* oo = ATT_DUMMY(dummy_out) ? (ab::bf16*)F.H() : qo;
            const size_t ko = ((size_t)(b * 2 + kvh) * KVROWS + SEQ) * 64;
            if (isb) ab::attn_unit<8, false, true, false>(qo, (const ab::bf16*)(F.KB() + ko), (const ab::bf16*)(F.VB() + ko), oo, CTX / 64, (char*)F.lds, F.tid, 0, 0, F.sink_b()[l * 8 + h] * LOG2E, 0.f);
            else ab::attn_unit<8, false, false, false>(qo, (const ab::bf16*)(F.KA() + ko), (const ab::bf16*)(F.VA() + ko), oo, CTX / 64, (char*)F.lds, F.tid, 0, 0, 0.f, 0.f);
            if (fused) ctr_signal(ctrA);
        } else if (kind == K_MERGE) {
            ctr_wait(ctrA, 64u);
            const int t = v - 64;
            pg8::SchedMergeOne S; S.pm = ML / 256 + (t >> 2); S.pn = t & 3; S.Q = (const char*)F.QKV(); S.C = (const char*)F.CONV(); S.W = (const char*)F.WbrT();
            pg8::EpiMerge E{(const unsigned char*)F.GATE(), F.H()};
            pg8::gemm_phase(F.lds, 512, QW, 512, S, E);
            ctr_signal(ctrM);
        } else if (kind == K_OUT) {
            ctr_wait(ctrM, 16u);
            const int t = v - 80;
            pg8::SchedPlainOne S; S.pm = ML / 256 + (t >> 2); S.pn = t & 3; S.A = (const char*)F.H(); S.B = (const char*)F.WoutT(); S.atile = (size_t)256 * D * 2; S.btile = (size_t)256 * D * 2;
            pg8::EpiOut E{F.DELTA(), F.mod() + (size_t)l * 5 * PW, F.x(), F.ctx(), (l == 0) ? (const bf16_t*)nullptr : (const bf16_t*)F.wsp(WS_XB16)};
            pg8::gemm_phase(F.lds, D, D, D, S, E);
        }
    }
}

__device__ __forceinline__ void router_row(const Frame& F, f32x4 (&v)[4], int l, int row, int b, int pos, int mr, const float* modl, const LAS float* wrt, int lane) {
        norm_mod(v, F.g_ffn() + l * D, modl + mr * PW + 3 * D, modl + mr * PW + 4 * D, lane);
        store_row_fp8(F.H8() + (size_t)row * D, v, lane);
        float lg[16];
#pragma unroll
        for (int e = 0; e < 16; ++e) { float s = 0.f;
#pragma unroll
            for (int j = 0; j < 4; ++j) { const f32x4 w = *(const LAS f32x4*)(wrt + e * D + 4 * lane + 256 * j); s += (v[j].x * w.x + v[j].y * w.y) + (v[j].z * w.z + v[j].w * w.w); }
            lg[e] = s; }
        float w8[8], w4[4], w2[2], lgt;
        { const bool up = (lane & 32) != 0;
#pragma unroll
          for (int i = 0; i < 8; ++i) { const float mine = up ? lg[8 + i] : lg[i], oth = up ? lg[i] : lg[8 + i]; w8[i] = mine + __shfl_xor(oth, 32); } }
        { const bool up = (lane & 16) != 0;
#pragma unroll
          for (int i = 0; i < 4; ++i) { const float mine = up ? w8[4 + i] : w8[i], oth = up ? w8[i] : w8[4 + i]; w4[i] = mine + __shfl_xor(oth, 16); } }
        { const bool up = (lane & 8) != 0;
#pragma unroll
          for (int i = 0; i < 2; ++i) { const float mine = up ? w4[2 + i] : w4[i], oth = up ? w4[i] : w4[2 + i]; w2[i] = mine + __shfl_xor(oth, 8); } }
        { const bool up = (lane & 4) != 0; const float mine = up ? w2[1] : w2[0], oth = up ? w2[0] : w2[1]; lgt = mine + __shfl_xor(oth, 4); }
        lgt += __shfl_xor(lgt, 2); lgt += __shfl_xor(lgt, 1);
        float mx = lgt;
        mx = fmaxf(mx, __shfl_xor(mx, 4)); mx = fmaxf(mx, __shfl_xor(mx, 8)); mx = fmaxf(mx, __shfl_xor(mx, 16)); mx = fmaxf(mx, __shfl_xor(mx, 32));
        const float ex = __expf(lgt - mx); float sum = ex;
        sum += __shfl_xor(sum, 4); sum += __shfl_xor(sum, 8); sum += __shfl_xor(sum, 16); sum += __shfl_xor(sum, 32);
        if ((lane & 3) == 0) { const int e = ((lane >> 5) & 1) * 8 + ((lane >> 4) & 1) * 4 + ((lane >> 3) & 1) * 2 + ((lane >> 2) & 1);
            F.aff()[(size_t)(b * NE + e) * KVROWS + pos] = ex / sum; F.inv()[(size_t)row * NE + e] = -1; }
}
__device__ __forceinline__ void router_finish(const Frame& F, const float (&lg)[16], int row, int b, int pos, int lane) {
    float w8[8], w4[4], w2[2], lgt;
    { const bool up = (lane & 32) != 0;
#pragma unroll
      for (int i = 0; i < 8; ++i) { const float mine = up ? lg[8 + i] : lg[i], oth = up ? lg[i] : lg[8 + i]; w8[i] = mine + __shfl_xor(oth, 32); } }
    { const bool up = (lane & 16) != 0;
#pragma unroll
      for (int i = 0; i < 4; ++i) { const float mine = up ? w8[4 + i] : w8[i], oth = up ? w8[i] : w8[4 + i]; w4[i] = mine + __shfl_xor(oth, 16); } }
    { const bool up = (lane & 8) != 0;
#pragma unroll
      for (int i = 0; i < 2; ++i) { const float mine = up ? w4[2 + i] : w4[i], oth = up ? w4[i] : w4[2 + i]; w2[i] = mine + __shfl_xor(oth, 8); } }
    { const bool up = (lane & 4) != 0; const float mine = up ? w2[1] : w2[0], oth = up ? w2[0] : w2[1]; lgt = mine + __shfl_xor(oth, 4); }
    lgt += __shfl_xor(lgt, 2); lgt += __shfl_xor(lgt, 1);
    float mx = lgt;
    mx = fmaxf(mx, __shfl_xor(mx, 4)); mx = fmaxf(mx, __shfl_xor(mx, 8)); mx = fmaxf(mx, __shfl_xor(mx, 16)); mx = fmaxf(mx, __shfl_xor(mx, 32));
    const float ex = __expf(lgt - mx); float sum = ex;
    sum += __shfl_xor(sum, 4); sum += __shfl_xor(sum, 8); sum += __shfl_xor(sum, 16); sum += __shfl_xor(sum, 32);
    if ((lane & 3) == 0) { const int e = ((lane >> 5) & 1) * 8 + ((lane >> 4) & 1) * 4 + ((lane >> 3) & 1) * 2 + ((lane >> 2) & 1);
        F.aff()[(size_t)(b * NE + e) * KVROWS + pos] = ex / sum; F.inv()[(size_t)row * NE + e] = -1; }
}
constexpr int WRP = 1028;
__device__ __forceinline__ void phase_norm2_mfma(const Frame& F, int l, bool has_ctx) {
    LAS float* wrt = (LAS float*)F.lds;
    const int nrows = has_ctx ? MT : ML, ngroups = nrows / 16, lane = F.lane, r = lane & 15, g = lane >> 4;
    const bf16_t* const xm = F.DELTA();
    u32x4 xw[32];
    { const int gi0 = F.gw < ngroups ? F.gw : 0; const bf16_t* xr = xm + (size_t)(gi0 * 16 + r) * D + 8 * g;
#pragma unroll
      for (int t = 0; t < 32; ++t) xw[t] = *(const u32x4*)(xr + 32 * t); }
    { const f32x4* wsrc = (const f32x4*)(F.w_router() + (size_t)l * D * NE) + F.tid * 8;
      f32x4 wv[8];
#pragma unroll
      for (int i = 0; i < 8; ++i) wv[i] = wsrc[i];
#pragma unroll
      for (int i = 0; i < 8; ++i) { const int k = 2 * F.tid + (i >> 2), e0 = (i & 3) * 4; wrt[(e0 + 0) * WRP + k] = wv[i].x; wrt[(e0 + 1) * WRP + k] = wv[i].y; wrt[(e0 + 2) * WRP + k] = wv[i].z; wrt[(e0 + 3) * WRP + k] = wv[i].w; } }
    LAS float* const nvl = wrt + NE * WRP;
    { const float* modv = F.mod() + (size_t)l * 5 * PW; const float* gf = F.g_ffn() + l * D; float nv[22];
#pragma unroll
      for (int j = 0; j < 22; ++j) { const int i = F.tid + NTHR * j, r = i >> 10, k = i & 1023; nv[j] = (r == 0) ? gf[k] : (r <= 5 ? modv[(size_t)(r - 1) * PW + 3 * D + k] : modv[(size_t)(r - 6) * PW + 4 * D + k]); }
#pragma unroll
      for (int j = 0; j < 22; ++j) nvl[F.tid + NTHR * j] = nv[j]; }
    __syncthreads();
    for (int it = 0;; ++it) {
        int gi;
        if (it == 0) gi = F.gw; else { if (F.wave != 0) break; gi = F.NGW + F.vcu + (it - 1) * F.G; }
        if (gi >= ngroups) break;
        const int row = gi * 16 + r; const bool lat = row < ML;
        const int b = lat ? row / SEQ : (row - ML) / CTX, pos = lat ? row % SEQ : SEQ + (row - ML) % CTX, mr = lat ? b : 4;
        if (it > 0) { const bf16_t* xr = xm + (size_t)row * D + 8 * g;
#pragma unroll
          for (int t = 0; t < 32; ++t) xw[t] = *(const u32x4*)(xr + 32 * t); }
        float ss = 0.f;
#pragma unroll
        for (int t = 0; t < 32; ++t) { const u32x4 w = xw[t];
            const float a0 = bf_lo(w.x), a1 = bf_hi(w.x), a2 = bf_lo(w.y), a3 = bf_hi(w.y), a4 = bf_lo(w.z), a5 = bf_hi(w.z), a6 = bf_lo(w.w), a7 = bf_hi(w.w);
            ss += (a0 * a0 + a1 * a1) + (a2 * a2 + a3 * a3) + (a4 * a4 + a5 * a5) + (a6 * a6 + a7 * a7); }
        ss += __shfl_xor(ss, 16); ss += __shfl_xor(ss, 32);
        const float rinv = 1.0f / sqrtf(ss * (1.0f / D) + EPS);
#pragma unroll
        for (int t = 0; t < 32; ++t) asm volatile("" : "+v"(xw[t]));
        const LAS float* const gl = nvl + 8 * g; const LAS float* const shl = nvl + (1 + mr) * D + 8 * g; const LAS float* const scl = nvl + (6 + mr) * D + 8 * g;
        const LAS float* const wl = wrt + r * WRP + 8 * g;
        unsigned char* const h8 = F.H8() + (size_t)row * D + 8 * g;
        f32x4 acc = (f32x4){0.f, 0.f, 0.f, 0.f};
#pragma unroll
        for (int t = 0; t < 32; ++t) { const u32x4 w = xw[t];
            const f32x4 g0 = *(const LAS f32x4*)(gl + 32 * t), g1 = *(const LAS f32x4*)(gl + 32 * t + 4), s00 = *(const LAS f32x4*)(shl + 32 * t), s01 = *(const LAS f32x4*)(shl + 32 * t + 4),
                        s10 = *(const LAS f32x4*)(scl + 32 * t), s11 = *(const LAS f32x4*)(scl + 32 * t + 4), w0 = *(const LAS f32x4*)(wl + 32 * t), w1 = *(const LAS f32x4*)(wl + 32 * t + 4);
            float h[8];
            h[0] = (bf_lo(w.x) * rinv * g0.x) * (1.0f + s10.x) + s00.x; h[1] = (bf_hi(w.x) * rinv * g0.y) * (1.0f + s10.y) + s00.y; h[2] = (bf_lo(w.y) * rinv * g0.z) * (1.0f + s10.z) + s00.z; h[3] = (bf_hi(w.y) * rinv * g0.w) * (1.0f + s10.w) + s00.w;
            h[4] = (bf_lo(w.z) * rinv * g1.x) * (1.0f + s11.x) + s01.x; h[5] = (bf_hi(w.z) * rinv * g1.y) * (1.0f + s11.y) + s01.y; h[6] = (bf_lo(w.w) * rinv * g1.z) * (1.0f + s11.z) + s01.z; h[7] = (bf_hi(w.w) * rinv * g1.w) * (1.0f + s11.w) + s01.w;
            u32x2 pk; pk.x = pg8::pack4_fp8(h[0], h[1], h[2], h[3]); pk.y = pg8::pack4_fp8(h[4], h[5], h[6], h[7]);
            *(u32x2*)(h8 + 32 * t) = pk;
            acc = __builtin_amdgcn_mfma_f32_16x16x4f32(w0.x, h[0], acc, 0, 0, 0); acc = __builtin_amdgcn_mfma_f32_16x16x4f32(w0.y, h[1], acc, 0, 0, 0);
            acc = __builtin_amdgcn_mfma_f32_16x16x4f32(w0.z, h[2], acc, 0, 0, 0); acc = __builtin_amdgcn_mfma_f32_16x16x4f32(w0.w, h[3], acc, 0, 0, 0);
            acc = __builtin_amdgcn_mfma_f32_16x16x4f32(w1.x, h[4], acc, 0, 0, 0); acc = __builtin_amdgcn_mfma_f32_16x16x4f32(w1.y, h[5], acc, 0, 0, 0);
            acc = __builtin_amdgcn_mfma_f32_16x16x4f32(w1.z, h[6], acc, 0, 0, 0); acc = __builtin_amdgcn_mfma_f32_16x16x4f32(w1.w, h[7], acc, 0, 0, 0);
            __builtin_amdgcn_sched_barrier(0); }
        float mx = fmaxf(fmaxf(acc.x, acc.y), fmaxf(acc.z, acc.w));
        mx = fmaxf(mx, __shfl_xor(mx, 16)); mx = fmaxf(mx, __shfl_xor(mx, 32));
        const float e0 = __expf(acc.x - mx), e1 = __expf(acc.y - mx), e2 = __expf(acc.z - mx), e3 = __expf(acc.w - mx);
        float sum = (e0 + e1) + (e2 + e3);
        sum += __shfl_xor(sum, 16); sum += __shfl_xor(sum, 32);
        const float rs = 1.0f / sum;
        float* const ap = F.aff() + (size_t)(b * NE + 4 * g) * KVROWS + pos;
        ap[0] = e0 * rs; ap[KVROWS] = e1 * rs; ap[2 * KVROWS] = e2 * rs; ap[3 * KVROWS] = e3 * rs;
        { int m1 = -1; asm volatile("" : "+v"(m1));
          *(v4i32*)(F.inv() + (size_t)row * NE + 4 * g) = (v4i32){m1, m1, m1, m1}; }
    }
}

template <bool XBF>
__device__ __forceinline__ void phase_norm2_router(const Frame& F, int l, bool has_ctx) {
    LAS float* wrt = (LAS float*)F.lds;
    { const f32x4* wsrc = (const f32x4*)(F.w_router() + (size_t)l * D * NE) + F.tid * 8;
      f32x4 wv[8];
#pragma unroll
      for (int i = 0; i < 8; ++i) wv[i] = wsrc[i];
#pragma unroll
      for (int i = 0; i < 8; ++i) { const int k = 2 * F.tid + (i >> 2), e0 = (i & 3) * 4; wrt[(e0 + 0) * D + k] = wv[i].x; wrt[(e0 + 1) * D + k] = wv[i].y; wrt[(e0 + 2) * D + k] = wv[i].z; wrt[(e0 + 3) * D + k] = wv[i].w; } }
    LAS float* const nvl = wrt + NE * D;
    { const float* modv = F.mod() + (size_t)l * 5 * PW; const float* gf = F.g_ffn() + l * D; float nv[22];
#pragma unroll
      for (int j = 0; j < 22; ++j) { const int i = F.tid + NTHR * j, r = i >> 10, k = i & 1023; nv[j] = (r == 0) ? gf[k] : (r <= 5 ? modv[(size_t)(r - 1) * PW + 3 * D + k] : modv[(size_t)(r - 6) * PW + 4 * D + k]); }
#pragma unroll
      for (int j = 0; j < 22; ++j) nvl[F.tid + NTHR * j] = nv[j]; }
    __syncthreads();
    const float* modl = F.mod() + (size_t)l * 5 * PW; const int nrows = has_ctx ? MT : ML; const int lane = F.lane;
    const bf16_t* const xb16 = (const bf16_t*)F.wsp(WS_XB16);
    const float* const xlat = (l == 0) ? F.x() : (const float*)F.out(); const float* const xctx = (l == 0) ? F.ctx() : (const float*)F.xc(); const bf16_t* const dlt = F.DELTA();
    constexpr int R = 2;
#define N2_LOAD(V, DW, RB) do { _Pragma("unroll") for (int q = 0; q < R; ++q) { const int row = (RB) + q * F.NGW; const int rc = row < nrows ? row : (RB); \
            const bf16_t* dr = dlt + (size_t)rc * D + 4 * lane; \
            _Pragma("unroll") for (int j = 0; j < 4; ++j) DW[q][j] = *(const u32x2*)(dr + 256 * j); } } while (0)
    int r0 = F.gw; if (r0 >= nrows) return;
    f32x4 gR[4], shR[4], scR[4]; int mrc = -1;
#pragma unroll
    for (int j = 0; j < 4; ++j) gR[j] = *(const LAS f32x4*)(nvl + 4 * lane + 256 * j);
    f32x4 v[R][4]; u32x2 dw[R][4], dn[R][4];
    N2_LOAD(v, dw, r0);
    for (;;) {
        const int rn = r0 + R * F.NGW; const bool more = rn < nrows;
        { const int rl = more ? rn : r0; N2_LOAD(v, dn, rl); }
        __builtin_amdgcn_sched_barrier(0);
#pragma unroll
        for (int q = 0; q < R; ++q) { const int row = r0 + q * F.NGW; const int rc = row < nrows ? row : r0; const int mr = rc < ML ? rc / SEQ : 4;
#pragma unroll
            for (int j = 0; j < 4; ++j) v[q][j] = (f32x4){bf_lo(dw[q][j].x), bf_hi(dw[q][j].x), bf_lo(dw[q][j].y), bf_hi(dw[q][j].y)};
            if (mr != mrc) { mrc = mr;
#pragma unroll
                for (int j = 0; j < 4; ++j) { shR[j] = *(const LAS f32x4*)(nvl + (1 + mr) * D + 4 * lane + 256 * j); scR[j] = *(const LAS f32x4*)(nvl + (6 + mr) * D + 4 * lane + 256 * j); } }
            norm_mod_reg(v[q], gR, shR, scR);
            if (row < nrows) store_row_fp8(F.H8() + (size_t)row * D, v[q], lane); }
        typedef float f32x2 __attribute__((ext_vector_type(2)));
        f32x2 vp[4][4];
#pragma unroll
        for (int j = 0; j < 4; ++j) { vp[j][0] = (f32x2){v[0][j].x, v[1][j].x}; vp[j][1] = (f32x2){v[0][j].y, v[1][j].y}; vp[j][2] = (f32x2){v[0][j].z, v[1][j].z}; vp[j][3] = (f32x2){v[0][j].w, v[1][j].w}; }
        float lg[R][16];
#pragma unroll
        for (int e = 0; e < 16; ++e) { f32x2 acc = (f32x2){0.f, 0.f};
#pragma unroll
            for (int j = 0; j < 4; ++j) { const f32x4 w = *(const LAS f32x4*)(wrt + e * D + 4 * lane + 256 * j); const f32x2 w01 = (f32x2){w.x, w.y}, w23 = (f32x2){w.z, w.w};
                asm("v_pk_fma_f32 %0, %1, %2, %0 op_sel_hi:[1,0,1]" : "+v"(acc) : "v"(vp[j][0]), "v"(w01));
                asm("v_pk_fma_f32 %0, %1, %2, %0 op_sel:[0,1,0] op_sel_hi:[1,1,1]" : "+v"(acc) : "v"(vp[j][1]), "v"(w01));
                asm("v_pk_fma_f32 %0, %1, %2, %0 op_sel_hi:[1,0,1]" : "+v"(acc) : "v"(vp[j][2]), "v"(w23));
                asm("v_pk_fma_f32 %0, %1, %2, %0 op_sel:[0,1,0] op_sel_hi:[1,1,1]" : "+v"(acc) : "v"(vp[j][3]), "v"(w23)); }
            lg[0][e] = acc.x; lg[1][e] = acc.y;
            if ((e & 3) == 3) __builtin_amdgcn_sched_barrier(0); }
#pragma unroll
        for (int q = 0; q < R; ++q) { const int row = r0 + q * F.NGW;
            if (row < nrows) { const bool lat = row < ML; const int b = lat ? row / SEQ : (row - ML) / CTX, pos = lat ? row % SEQ : SEQ + (row - ML) % CTX;
                router_finish(F, lg[q], row, b, pos, lane); } }
        if (!more) break;
#pragma unroll
        for (int q = 0; q < R; ++q)
#pragma unroll
            for (int j = 0; j < 4; ++j) dw[q][j] = dn[q][j];
        r0 = rn;
    }
#undef N2_LOAD
}

__device__ __forceinline__ void topk_unit(const Frame& F, const float* affrow, int n, int k, int* idx_out, float* gate_out, int* inv_base) {
    LAS unsigned* keys = (LAS unsigned*)F.lds; LAS int* hist = (LAS int*)(F.lds + 32768);
    LAS int* misc = (LAS int*)(F.lds + 32768 + 65536);
    const int tid = F.tid, lane = F.lane, wid = F.wave;
    for (int i0 = 0; i0 < n; i0 += 8 * NTHR) { float kv[8];
#pragma unroll
        for (int j = 0; j < 8; ++j) { const int i = i0 + tid + j * NTHR; kv[j] = affrow[i < n ? i : 0]; }
#pragma unroll
        for (int j = 0; j < 8; ++j) { const int i = i0 + tid + j * NTHR; if (i < n) keys[i] = __float_as_uint(kv[j]); } }
    for (int i = tid; i < 8 * 2048; i += NTHR) hist[i] = 0;
    __syncthreads();
    unsigned prefix = 0u; int krem = k;
    {
        for (int i = tid; i < n; i += NTHR) __hip_atomic_fetch_add(&hist[wid * 2048 + (keys[i] >> 20)], 1, __ATOMIC_RELAXED, __HIP_MEMORY_SCOPE_WORKGROUP);
        __syncthreads();
        int h[4], s4 = 0;
#pragma unroll
        for (int q = 0; q < 4; ++q) { int c = 0;
#pragma unroll
            for (int w = 0; w < 8; ++w) c += hist[w * 2048 + 2047 - 4 * tid - q];
            h[q] = c; s4 += c; }
        int incl = s4;
#pragma unroll
        for (int o = 1; o < 64; o <<= 1) { const int tv = __shfl_up(incl, o); if (lane >= o) incl += tv; }
        if (lane == 63) misc[8 + wid] = incl;
        __syncthreads();
        int base = 0;
#pragma unroll
        for (int w = 0; w < 8; ++w) { const int tv = misc[8 + w]; if (w < wid) base += tv; }
        incl += base; const int excl = incl - s4;
        if (excl < krem && incl >= krem) { int c = excl, sel, nk;
            if (c + h[0] >= krem) { sel = 2047 - 4 * tid; nk = krem - c; }
            else { c += h[0]; if (c + h[1] >= krem) { sel = 2046 - 4 * tid; nk = krem - c; }
                else { c += h[1]; if (c + h[2] >= krem) { sel = 2045 - 4 * tid; nk = krem - c; } else { c += h[2]; sel = 2044 - 4 * tid; nk = krem - c; } } }
            misc[0] = sel; misc[1] = nk; }
        __syncthreads();
        prefix = (unsigned)misc[0]; krem = misc[1];
        __syncthreads();
    }
    for (int pass = 1; pass < 4; ++pass) {
        const int shift = (pass == 1) ? 12 : (pass == 2 ? 4 : 0), width = (pass == 3) ? 4 : 8, hs = shift + width; const unsigned bm = (1u << width) - 1u;
        if (tid < 256) hist[tid] = 0;
        __syncthreads();
        for (int i = tid; i < n; i += NTHR) { const unsigned key = keys[i]; if ((key >> hs) == prefix) __hip_atomic_fetch_add(&hist[(key >> shift) & bm], 1, __ATOMIC_RELAXED, __HIP_MEMORY_SCOPE_WORKGROUP); }
        __syncthreads();
        if (wid == 0) {
            const int h0 = hist[255 - 4 * lane], h1 = hist[254 - 4 * lane], h2 = hist[253 - 4 * lane], h3 = hist[252 - 4 * lane];
            const int s = h0 + h1 + h2 + h3; int incl = s;
#pragma unroll
            for (int o = 1; o < 64; o <<= 1) { const int tv = __shfl_up(incl, o); if (lane >= o) incl += tv; }
            const int excl = incl - s;
            if (excl < krem && incl >= krem) { int c = excl, sel, nk;
                if (c + h0 >= krem) { sel = 255 - 4 * lane; nk = krem - c; }
                else { c += h0; if (c + h1 >= krem) { sel = 254 - 4 * lane; nk = krem - c; }
                    else { c += h1; if (c + h2 >= krem) { sel = 253 - 4 * lane; nk = krem - c; } else { c += h2; sel = 252 - 4 * lane; nk = krem - c; } } }
                misc[0] = sel; misc[1] = nk; }
        }
        __syncthreads();
        prefix = (prefix << width) | (unsigned)misc[0]; krem = misc[1];
        __syncthreads();
    }
    const unsigned T = prefix; const int per = (n + NTHR - 1) / NTHR, i0 = tid * per;
    int cg = 0, ce = 0;
    for (int q = 0; q < per; ++q) { const int i = i0 + q; if (i < n) { const unsigned key = keys[i]; cg += (key > T); ce += (key == T); } }
    int pk = cg | (ce << 16), incl = pk;
#pragma unroll
    for (int o = 1; o < 64; o <<= 1) { const int tv = __shfl_up(incl, o); if (lane >= o) incl += tv; }
    if (lane == 63) misc[8 + wid] = incl;
    __syncthreads();
    int base = 0;
#pragma unroll
    for (int w = 0; w < 8; ++w) { const int tv = misc[8 + w]; if (w < wid) base += tv; }
    const int ex = base + incl - pk; int sg = ex & 0xffff, se = ex >> 16; const int ngt = k - krem;
    for (int q = 0; q < per; ++q) { const int i = i0 + q; if (i < n) { const unsigned key = keys[i]; int slot = -1;
        if (key > T) slot = sg++; else if (key == T) { if (se < krem) slot = ngt + se; ++se; }
        if (slot >= 0) { idx_out[slot] = i; gate_out[slot] = __uint_as_float(key); inv_base[(size_t)i * NE] = slot; } } }
    __syncthreads();
}
__device__ __forceinline__ void phase_topk(const Frame& F, int l, bool has_ctx) {
    const int nunits = has_ctx ? 128 : 64;
    for (int u = F.bx; u < nunits; u += F.G) {
        if (u < 64) { const int b = u >> 4, e = u & 15;
            topk_unit(F, F.aff() + (size_t)u * KVROWS, SEQ, CAP, F.idx() + u * CAP, F.gatev() + u * CAP, F.inv() + (size_t)(b * SEQ) * NE + e); }
        else { const int g = u - 64, b = g >> 4, e = g & 15;
            topk_unit(F, F.aff() + (size_t)g * KVROWS + SEQ, CTX, CAPC, F.idx() + MOE_ROWS_LAT + g * CAPC, F.gatev() + MOE_ROWS_LAT + g * CAPC, F.inv() + (size_t)(ML + b * CTX) * NE + e); }
    }
    __syncthreads();
    const int nfree = F.G - nunits, fr = F.bx - nunits;
    if (nfree <= 0) { convert_expert_weights(F, l, 0, EXPERT_ITEMS, F.gw, F.NGW); if (l + 1 < DEPTH) convert_mixer_weights(F, l + 1, 0, MIXER_ITEMS, F.gw, F.NGW); return; }
    if (l + 1 < DEPTH) {
        convert_expert_weights(F, l, 0, EXPERT_ITEMS, F.gw, F.NGW);
        if (fr >= 0) convert_mixer_weights(F, l + 1, 0, MIXER_ITEMS, fr * NWAVES + F.wave, nfree * NWAVES);
    } else {
        const int cut = (EXPERT_ITEMS / 4) * 3;
        convert_expert_weights(F, l, 0, cut, F.gw, F.NGW);
        if (fr >= 0) convert_expert_weights(F, l, cut, EXPERT_ITEMS, fr * NWAVES + F.wave, nfree * NWAVES);
    }
}

__device__ __forceinline__ void phase_combine(const Frame& F, int l, bool has_ctx, bool next_norm, bool dummy = false) {
    const float* modl = F.mod() + (size_t)l * 5 * PW; const int nrows = has_ctx ? MT : ML; const int lane = F.lane;
    const bf16_t* const Y = F.XS(); const int* const invp = F.inv(); const float* const gvp = F.gatev(); float* const outp = F.out(); float* const xcp = F.xc();
    const float* const xlat = (l == 0) ? F.x() : (const float*)F.out(); const float* const xctx = (l == 0) ? F.ctx() : (const float*)F.xc(); const bf16_t* const dlt = F.DELTA();
    LAS float* const cvl = (LAS float*)F.lds;
    { const float* gmn = F.g_mix() + (next_norm ? (l + 1) : l) * D; const float* modn_ = F.mod() + (size_t)(next_norm ? (l + 1) : l) * 5 * PW; float nv[32];
#pragma unroll
      for (int j = 0; j < 32; ++j) { const int i = F.tid + NTHR * j, r = i >> 10, k = i & 1023;
          nv[j] = (r < 5) ? modl[(size_t)r * PW + 5 * D + k] : (r == 5 ? gmn[k] : (r <= 10 ? modn_[(size_t)(r - 6) * PW + k] : modn_[(size_t)(r - 11) * PW + D + k])); }
#pragma unroll
      for (int j = 0; j < 32; ++j) cvl[F.tid + NTHR * j] = nv[j]; }
    __syncthreads();
    for (int r0 = F.gw; r0 < nrows; r0 += 2 * F.NGW) {
        const int rA = r0; const bool hasB = (r0 + F.NGW) < nrows; const int rB = hasB ? r0 + F.NGW : r0;
        const bool latA = rA < ML, latB = rB < ML;
        const int bA = latA ? rA / SEQ : (rA - ML) / CTX, bB = latB ? rB / SEQ : (rB - ML) / CTX;
        float* xrA = latA ? outp + (size_t)rA * D : xcp + (size_t)(rA - ML) * D; float* xrB = latB ? outp + (size_t)rB * D : xcp + (size_t)(rB - ML) * D;
        const float* xoA = latA ? xlat + (size_t)rA * D : xctx + (size_t)(rA - ML) * D; const float* xoB = latB ? xlat + (size_t)rB * D : xctx + (size_t)(rB - ML) * D;
        int myinv = invp[(size_t)((lane & 16) ? rB : rA) * NE + (lane & 15)];
        if ((lane & 16) && !hasB) myinv = -1;
        f32x4 xa[4], xb[4];
#pragma unroll
        for (int j = 0; j < 4; ++j) {
            const u32x2 da = *(const u32x2*)(dlt + (size_t)rA * D + 4 * lane + 256 * j), db = *(const u32x2*)(dlt + (size_t)rB * D + 4 * lane + 256 * j);
            xa[j].x = bf_lo(da.x); xa[j].y = bf_hi(da.x); xa[j].z = bf_lo(da.y); xa[j].w = bf_hi(da.y); xb[j].x = bf_lo(db.x); xb[j].y = bf_hi(db.x); xb[j].z = bf_lo(db.y); xb[j].w = bf_hi(db.y); }
        (void)xoA; (void)xoB;
        const unsigned long long bal = __ballot(myinv >= 0);
        unsigned mA = (unsigned)(bal & 0xffffull), mB = (unsigned)((bal >> 16) & 0xffffull);
        f32x4 aa[4], ab2[4];
#pragma unroll
        for (int j = 0; j < 4; ++j) { aa[j] = (f32x4){0.f, 0.f, 0.f, 0.f}; ab2[j] = (f32x4){0.f, 0.f, 0.f, 0.f}; }
        while (mA | mB) {
            size_t yo[4]; float gv[4];
#pragma unroll
            for (int c = 0; c < 4; ++c) {
                const bool isB = c >= 2; unsigned& m = isB ? mB : mA; yo[c] = 0; gv[c] = 0.f;
                if (m) { const int e = __builtin_ctz(m); m &= m - 1u;
                    const int slot = __builtin_amdgcn_readlane(myinv, (isB ? 16 : 0) + e);
                    const bool lat = isB ? latB : latA; const int bb = isB ? bB : bA;
                    const int yrow = lat ? (bb * NE + e) * CAP + slot : MOE_ROWS_LAT + e * 256 + bb * 32 + slot;
                    gv[c] = lat ? gvp[(bb * NE + e) * CAP + slot] : gvp[MOE_ROWS_LAT + (bb * NE + e) * CAPC + slot];
                    yo[c] = (size_t)yrow * D; }
            }
            u32x2 yw[4][4];
#pragma unroll
            for (int c = 0; c < 4; ++c)
#pragma unroll
                for (int j = 0; j < 4; ++j) yw[c][j] = __builtin_nontemporal_load((const u32x2*)(Y + yo[c] + 4 * lane + 256 * j));
#pragma unroll
            for (int c = 0; c < 2; ++c)
#pragma unroll
                for (int j = 0; j < 4; ++j) { const u32x2 w = yw[c][j]; aa[j].x += gv[c] * bf_lo(w.x); aa[j].y += gv[c] * bf_hi(w.x); aa[j].z += gv[c] * bf_lo(w.y); aa[j].w += gv[c] * bf_hi(w.y); }
#pragma unroll
            for (int c = 2; c < 4; ++c)
#pragma unroll
                for (int j = 0; j < 4; ++j) { const u32x2 w = yw[c][j]; ab2[j].x += gv[c] * bf_lo(w.x); ab2[j].y += gv[c] * bf_hi(w.x); ab2[j].z += gv[c] * bf_lo(w.y); ab2[j].w += gv[c] * bf_hi(w.y); }
        }
        {
            const int mr = latA ? bA : 4; const LAS float* gt2 = cvl + mr * D;
            float* dst = dummy ? (float*)F.HID() + (size_t)(latA ? rA : 0) * D : xrA;
#pragma unroll
            for (int j = 0; j < 4; ++j) { const f32x4 gg = *(const LAS f32x4*)(gt2 + 4 * lane + 256 * j); xa[j] = xa[j] + gg * aa[j]; if (!(next_norm && latA)) __builtin_nontemporal_store(xa[j], (f32x4*)(dst + 4 * lane + 256 * j)); }
            if (next_norm && latA && !dummy) store_row_bf16((bf16_t*)F.wsp(WS_XB16) + (size_t)rA * D, xa, lane);
            if (next_norm && !dummy) {
                norm_mod_lds(xa, cvl + 5 * D, cvl + (6 + mr) * D, cvl + (11 + mr) * D, lane); store_row_bf16(F.H() + (size_t)rA * D, xa, lane); store_row_fp8(F.H8() + (size_t)rA * D, xa, lane); }
        }
        if (hasB) {
            const int mr = latB ? bB : 4; const LAS float* gt2 = cvl + mr * D;
            float* dst = dummy ? (float*)F.HID() + (size_t)(latB ? rB : 0) * D : xrB;
#pragma unroll
            for (int j = 0; j < 4; ++j) { const f32x4 gg = *(const LAS f32x4*)(gt2 + 4 * lane + 256 * j); xb[j] = xb[j] + gg * ab2[j]; if (!(next_norm && latB)) __builtin_nontemporal_store(xb[j], (f32x4*)(dst + 4 * lane + 256 * j)); }
            if (next_norm && latB && !dummy) store_row_bf16((bf16_t*)F.wsp(WS_XB16) + (size_t)rB * D, xb, lane);
            if (next_norm && !dummy) {
                norm_mod_lds(xb, cvl + 5 * D, cvl + (6 + mr) * D, cvl + (11 + mr) * D, lane); store_row_bf16(F.H() + (size_t)rB * D, xb, lane); store_row_fp8(F.H8() + (size_t)rB * D, xb, lane); }
        }
    }
}

__device__ __forceinline__ Frame mkframe(LAS unsigned char* lds) {
    Frame F; F.lds = lds;
    int t = threadIdx.x; asm volatile("" : "+v"(t)); int bx = blockIdx.x; asm volatile("" : "+s"(bx)); int G = gridDim.x; asm volatile("" : "+s"(G));
    F.tid = t; F.lane = t & 63; F.wave = __builtin_amdgcn_readfirstlane(t >> 6); F.G = G; F.bx = bx;
    F.vcu = (G % 8 == 0) ? (bx % 8) * (G / 8) + bx / 8 : bx; F.gw = F.vcu * NWAVES + F.wave; F.NGW = G * NWAVES;
    return F;
}
constexpr int PH_PER_LAYER = 9, NPHASES = 2 + DEPTH * PH_PER_LAYER;

__global__ void __launch_bounds__(NTHR, 2) fwd_kernel(Args args) {
    extern __shared__ __attribute__((aligned(16))) unsigned char lds_raw[];
    LAS unsigned char* const lds = (LAS unsigned char*)lds_raw;
    const int tid0 = threadIdx.x;
    volatile LAS unsigned* MISC = (volatile LAS unsigned*)(lds + MISC_OFF);
    if (tid0 < 32) MISC[tid0] = 0u;
    if (tid0 < 23) { const unsigned long long pv = (tid0 < 21) ? (unsigned long long)args.in[tid0 < 21 ? tid0 : 0] : (tid0 == 21 ? (unsigned long long)args.out : (unsigned long long)args.ws);
        ((LAS unsigned long long*)(lds + TAB_OFF))[tid0] = pv; }
    unsigned char* ws = args.ws;
    __syncthreads();
    XcdBarrier bar; bar.bar = (unsigned*)(ws + WS_CTL) + 1024; bar.x = 0; bar.st = nullptr;
#if MK_ONE_LAUNCH
    bar = xcd_barrier_post((unsigned*)(ws + WS_CTL) + 1024, MISC + 8);
#endif
    const int lo = args.ph_lo, hi = args.ph_hi;
#ifndef PHMASK
#define PHMASK 0xFFFFFFFFu
#endif
#define IN(k) (lo <= (k) && (k) < hi)
#define PM(j) ((PHMASK >> (j)) & 1u)
#ifndef DUPMASK
#define DUPMASK 0u
#endif
#define REPS(j) (((DUPMASK >> (j)) & 1u) ? 2 : 1)
#if MK_ONE_LAUNCH
#ifndef SEAMREP
#define SEAMREP 1
#endif
#define SEAM(k) do { if (IN(k) && IN((k) + 1)) { for (int sr_ = 0; sr_ < SEAMREP; ++sr_) xcd_barrier(bar); } } while (0)
#else
#define SEAM(k) do { } while (0)
#endif

#ifdef PTMASK
#define PT_BEGIN(k) do { if (((PTMASK) >> (k)) & 1u) { if (tid0 == 0) { const unsigned long long t_ = wall_clock64(); MISC[20] = (unsigned)t_; MISC[21] = (unsigned)(t_ >> 32); } } } while (0)
#define PT_END(k) do { if (((PTMASK) >> (k)) & 1u) { if (tid0 == 0) { const unsigned long long t_ = wall_clock64() - (((unsigned long long)MISC[21] << 32) | MISC[20]); const unsigned long long a_ = (((unsigned long long)MISC[23] << 32) | MISC[22]) + t_; MISC[22] = (unsigned)a_; MISC[23] = (unsigned)(a_ >> 32); } } } while (0)
#else
#define PT_BEGIN(k) do { } while (0)
#define PT_END(k) do { } while (0)
#endif
    PT_BEGIN(0);
    for (int rp = 0; rp < REPS(11); ++rp) if (PM(11) && IN(0)) { const Frame F = mkframe(lds); phase_prologue(F); }
    SEAM(0); PT_END(0); PT_BEGIN(1);
    for (int rp = 0; rp < REPS(12); ++rp) if (PM(12) && IN(1)) { const Frame F = mkframe(lds); phase_norm1(F, 0, F.x(), F.ctx()); }
    SEAM(1); PT_END(1);

    for (int l = 0; l < DEPTH; ++l) {
        const int pb = 2 + l * PH_PER_LAYER; const bool has_ctx = (l + 1 < DEPTH);
        PT_BEGIN(pb + 0);
        for (int rp = 0; rp < REPS(0); ++rp) if (PM(0) && IN(pb + 0)) { const Frame F = mkframe(lds);
            { pg8::SchedPlain S; S.T.init(MT / 256, 12, F.G, F.bx); S.A = (const char*)F.H(); S.B = (const char*)F.WinT(); S.atile = (size_t)256 * D * 2; S.btile = (size_t)256 * D * 2; S.pn0 = 0;
              pg8::EpiInProj E{(bf16_t*)F.wsp(0), F.gains() + l * 256, F.gains() + 512};
              pg8::gemm_phase(F.lds, D, D, D, S, E); }
            { pg8::SchedPlain S; S.T.init((has_ctx ? MT : ML) / 256, 12, F.G, F.G - 1 - F.bx); S.A = (const char*)F.H8();     S.B = (const char*)F.WinT() + 6 * MiB; S.atile = (size_t)256 * D; S.btile = (size_t)256 * D; S.pn0 = 12; if (F.G == 256) { S.deal = 1; S.bx = F.bx; }
              pg8::EpiInProjGate E{(bf16_t*)F.wsp(0)};
              pg8::gemm_phase(F.lds, D / 2, D / 2, D / 2, S, E); }
        }
        SEAM(pb + 0); PT_END(pb + 0); PT_BEGIN(pb + 1);
        for (int rp = 0; rp < REPS(1); ++rp) if (PM(1) && IN(pb + 1)) { const Frame F = mkframe(lds); phase_attention(F, l, has_ctx, rp == 0, rp > 0); }
        SEAM(pb + 1); PT_END(pb + 1); PT_BEGIN(pb + 2);
        for (int rp = 0; rp < REPS(2); ++rp) if (PM(2) && IN(pb + 2)) { const Frame F = mkframe(lds);
            pg8::SchedMerge S; S.T.init((has_ctx && !ctx_fused(F, has_ctx) ? MT : ML) / 256, D / 256, F.G, F.bx);     S.Q = (const char*)F.QKV(); S.C = (const char*)F.CONV(); S.W = (const char*)F.WbrT();
            pg8::EpiMerge E{(const unsigned char*)F.GATE(), F.H()};
            pg8::gemm_phase(F.lds, 512, QW, 512, S, E);
        }
        SEAM(pb + 2); PT_END(pb + 2); PT_BEGIN(pb + 3);
        for (int rp = 0; rp < REPS(3); ++rp) if (PM(3) && IN(pb + 3)) { const Frame F = mkframe(lds);
            pg8::SchedPlain S; S.T.init((has_ctx && !ctx_fused(F, has_ctx) ? MT : ML) / 256, D / 256, F.G, F.bx); S.A = (const char*)F.H(); S.B = (const char*)F.WoutT(); S.atile = (size_t)256 * D * 2; S.btile = (size_t)256 * D * 2; S.pn0 = 0;
            pg8::EpiOut E{F.DELTA(), F.mod() + (size_t)l * 5 * PW, F.x(), F.ctx(), (l == 0) ? (const bf16_t*)nullptr : (const bf16_t*)F.wsp(WS_XB16)};
            pg8::gemm_phase(F.lds, D, D, D, S, E);
        }
        SEAM(pb + 3); PT_END(pb + 3); PT_BEGIN(pb + 4);
        for (int rp = 0; rp < REPS(4); ++rp) if (PM(4) && IN(pb + 4)) { const Frame F = mkframe(lds); phase_norm2_mfma(F, l, has_ctx); }
        SEAM(pb + 4); PT_END(pb + 4); PT_BEGIN(pb + 5);
        for (int rp = 0; rp < REPS(5); ++rp) if (PM(5) && IN(pb + 5)) { const Frame F = mkframe(lds); phase_topk(F, l, has_ctx); }
        SEAM(pb + 5); PT_END(pb + 5); PT_BEGIN(pb + 6);
        for (int rp = 0; rp < REPS(6); ++rp) if (PM(6) && IN(pb + 6)) { const Frame F = mkframe(lds);
            pg8::SchedMoE<true> S; S.G = F.G; S.v = F.vcu; S.nN = 8; S.has_ctx = has_ctx; S.A = (const char*)F.H8(); S.W = (const char*)F.WGU(); S.wexp = (size_t)2048 * D; S.idx = F.idx(); S.rb = D;
            pg8::EpiGU E{(unsigned char*)F.HID()};
            pg8::gemm_phase(F.lds, D / 2, D / 2, D / 2, S, E);
        }
        SEAM(pb + 6); PT_END(pb + 6); PT_BEGIN(pb + 7);
        for (int rp = 0; rp < REPS(7); ++rp) if (PM(7) && IN(pb + 7)) { const Frame F = mkframe(lds);
            pg8::SchedMoE<false> S; S.G = F.G; S.v = F.vcu; S.nN = 4; S.has_ctx = has_ctx; S.A = (const char*)F.HID(); S.W = (const char*)F.WD(); S.wexp = (size_t)D * EH; S.idx = nullptr; S.rb = EH;
            pg8::EpiDown E{F.XS()};
            pg8::gemm_phase(F.lds, EH / 2, EH / 2, EH / 2, S, E);
        }
        SEAM(pb + 7); PT_END(pb + 7); PT_BEGIN(pb + 8);
        for (int rp = 0; rp < REPS(8); ++rp) if (PM(8) && IN(pb + 8)) { const Frame F = mkframe(lds); phase_combine(F, l, has_ctx, l + 1 < DEPTH, rp > 0); }
        SEAM(pb + 8); PT_END(pb + 8);
    }
#ifdef PTMASK
    if (blockIdx.x == 0 && tid0 == 0) { const unsigned long long a_ = (((unsigned long long)MISC[23] << 32) | MISC[22]) * (unsigned long long)(PAMP); const unsigned long long t0_ = wall_clock64(); while (wall_clock64() - t0_ < a_) __builtin_amdgcn_s_sleep(32); }
#endif
}

extern "C" void kernel_launch(void* const* d_in, const int* in_sizes, int n_in, void* d_out, int out_size, void* d_ws, size_t ws_size, hipStream_t stream) {
    static int grid = 0;
    if (grid == 0) {
        if (n_in != 21 || out_size != ML * D || ws_size < WS_END) { fprintf(stderr, "kernel_launch: unexpected shapes (n_in %d, out %d, ws %zu)\n", n_in, out_size, ws_size); grid = -1; return; }
        int dev = 0, cus = 0, per_cu = 0;
        if (hipGetDevice(&dev) != hipSuccess || hipDeviceGetAttribute(&cus, hipDeviceAttributeMultiprocessorCount, dev) != hipSuccess) { grid = -1; return; }
        if (hipFuncSetAttribute((const void*)fwd_kernel, hipFuncAttributeMaxDynamicSharedMemorySize, LDS_BYTES) != hipSuccess) { fprintf(stderr, "kernel_launch: hipFuncSetAttribute failed\n"); grid = -1; return; }
        if (hipOccupancyMaxActiveBlocksPerMultiprocessor(&per_cu, (const void*)fwd_kernel, NTHR, LDS_BYTES) != hipSuccess || per_cu < 1) { fprintf(stderr, "kernel_launch: occupancy query reports %d\n", per_cu); }
        (void)hipGetLastError();
        grid = cus;
    }
    if (grid < 0) return;
    (void)hipMemsetAsync((char*)d_ws + WS_CTL, 0, CTL_ZERO_BYTES, stream);
    Args a{};
    for (int i = 0; i < 21; ++i) a.in[i] = (const float*)d_in[i];
    a.out = (float*)d_out; a.ws = (unsigned char*)d_ws;
#if MK_ONE_LAUNCH
    a.ph_lo = 0; a.ph_hi = NPHASES;
    hipLaunchKernelGGL(fwd_kernel, dim3(grid), dim3(NTHR), LDS_BYTES, stream, a);
#else
    for (int p = 0; p < NPHASES; ++p) { a.ph_lo = p; a.ph_hi = p + 1; hipLaunchKernelGGL(fwd_kernel, dim3(grid), dim3(NTHR), LDS_BYTES, stream, a); }
#endif
}
```

```cpp
#include <hip/hip_runtime.h>
#include <hip/hip_bf16.h>
#include <cmath>
#include <cstdio>
#include <cstdint>

#define GAS __attribute__((address_space(1)))
#define LAS __attribute__((address_space(3)))
typedef unsigned short bf16_t;
typedef short bf16x8 __attribute__((ext_vector_type(8)));
typedef short s16x4 __attribute__((ext_vector_type(4)));
typedef float f32x4 __attribute__((ext_vector_type(4)));
typedef float f32x16 __attribute__((ext_vector_type(16)));
typedef unsigned u32x4 __attribute__((ext_vector_type(4)));
typedef unsigned u32x2 __attribute__((ext_vector_type(2)));
typedef int v4i32 __attribute__((ext_vector_type(4)));
typedef int v8i32 __attribute__((ext_vector_type(8)));

#ifndef MK_ONE_LAUNCH
#define MK_ONE_LAUNCH 1
#endif

constexpr int D = 1024, NB = 4, SEQ = 8192, CTX = 256, DEPTH = 2;
constexpr int ML = NB * SEQ, MC = NB * CTX, MT = ML + MC;
constexpr int PW = 6144;
constexpr int QW = 1024, GW = 3072;
constexpr int OFF_QA = 0, OFF_QB = 512;
constexpr int KVROWS = SEQ + CTX;
constexpr int NE = 16, CAP = 1024, CAPC = 32, EH = 1024;
constexpr float EPS = 1e-6f;
constexpr float LOG2E = 1.4426950408889634f;
constexpr float QSCALE = 0.125f * LOG2E;
constexpr int NWAVES = 8, NTHR = 512;

constexpr size_t MiB = 1u << 20;
constexpr size_t WS_CTL = 0, CTL_ZERO_BYTES = 64 * 1024;
constexpr size_t WS_MOD = 1 * MiB;
constexpr size_t WS_GAINS = 1 * MiB + 768 * 1024;
constexpr size_t WS_XC = 2 * MiB;
constexpr size_t WS_AFF = 6 * MiB;
constexpr size_t WS_IDX = 9 * MiB;
constexpr size_t WS_GATEV = 11 * MiB;
constexpr size_t WS_INV = 13 * MiB;
constexpr size_t WS_WIN = 16 * MiB;
constexpr size_t WS_WBR = 28 * MiB;
constexpr size_t WS_WOUT = 31 * MiB;
constexpr size_t WS_H = 33 * MiB;
constexpr size_t WS_KA = 99 * MiB, WS_KB = 108 * MiB, WS_VTA = 117 * MiB, WS_VTB = 126 * MiB;
constexpr size_t WS_QKV = 135 * MiB;
constexpr size_t WS_CONV = 234 * MiB;
constexpr size_t WS_GATE = 333 * MiB;
constexpr size_t WS_XS = 135 * MiB;
constexpr size_t WS_HID = 271 * MiB;
constexpr size_t WS_WGU = 407 * MiB;
constexpr size_t WS_WD = 471 * MiB;
constexpr size_t WS_DELTA = 531 * MiB;
constexpr size_t WS_H8 = 597 * MiB;
constexpr size_t WS_XB16 = 432 * MiB;
constexpr size_t WS_END = 630 * MiB;
constexpr int MOE_ROWS_LAT = NB * NE * CAP;
constexpr int MOE_ROWS = MOE_ROWS_LAT + NE * 256;

constexpr int RING_BYTES = 131072, MISC_OFF = RING_BYTES, LDS_BYTES = 147456;

__device__ __forceinline__ unsigned cvt_pk_bf16(float lo, float hi) { unsigned r; asm("v_cvt_pk_bf16_f32 %0, %1, %2" : "=v"(r) : "v"(lo), "v"(hi)); return r; }
__device__ __forceinline__ float bf_lo(unsigned w) { return __uint_as_float(w << 16); }
__device__ __forceinline__ float bf_hi(unsigned w) { return __uint_as_float(w & 0xffff0000u); }
__device__ __forceinline__ float wave_sum(float v) {
#pragma unroll
    for (int o = 1; o < 64; o <<= 1) v += __shfl_xor(v, o);
    return v;
}
__device__ __forceinline__ float fast_sigmoid(float v) { return __builtin_amdgcn_rcpf(1.0f + __builtin_amdgcn_exp2f(-v * LOG2E)); }
#define LDS_WAIT() asm volatile("s_waitcnt lgkmcnt(0)" ::: "memory")

#define XB_TMO      128
#define XB_XCNT(j)  (256  + 64 * (j))
#define XB_XSUB(j)  (1280 + 64 * (j))
#define XB_XGEN(j)  (2304 + 64 * (j))
#define XB_TOP      3328
#define XB_TOPGEN   3392
#define XCD_BAR_WORDS 3456
#define XB_SPIN_CAP (1u << 18)

__device__ __forceinline__ unsigned xb_ld(unsigned* p)              { return __hip_atomic_load(p, __ATOMIC_RELAXED, __HIP_MEMORY_SCOPE_AGENT); }
__device__ __forceinline__ unsigned xb_add(unsigned* p, unsigned v) { return __hip_atomic_fetch_add(p, v, __ATOMIC_RELAXED, __HIP_MEMORY_SCOPE_AGENT); }
__device__ __forceinline__ unsigned xb_xcc_id() { return (unsigned)__builtin_amdgcn_s_getreg((3 << 11) | 20) & 0xFu; }
#define XB_SPIN(cond, bar) do { unsigned _sp = 0; while (cond) { __builtin_amdgcn_s_sleep(1); \
    if ((++_sp & 255u) == 0u) { if (xb_ld(&(bar)[XB_TMO])) break; if (_sp > XB_SPIN_CAP) { atomicAdd(&(bar)[XB_TMO], 1u); break; } } } } while (0)

struct XcdBarrier { unsigned* bar; unsigned x; volatile LAS unsigned* st; };

__device__ __forceinline__ XcdBarrier xcd_barrier_post(unsigned* bar, volatile LAS unsigned* st) {
    XcdBarrier b; b.bar = bar; b.x = xb_xcc_id(); b.st = st;
    if (threadIdx.x == 0) (void)xb_add(&bar[XB_XCNT(b.x)], 1u);
    return b;
}
__device__ __forceinline__ void xcd_barrier_complete(unsigned* bar, unsigned x, unsigned& nloc, unsigned& nx) {
    const unsigned G = gridDim.x * gridDim.y * gridDim.z;
    unsigned sum, cnt, mine, sp = 0u;
    for (;;) {
        sum = 0u; cnt = 0u; mine = 0u;
#pragma unroll
        for (unsigned j = 0; j < 16; ++j) { const unsigned c = xb_ld(&bar[XB_XCNT(j)]); sum += c; cnt += (c > 0u) ? 1u : 0u; mine = (j == x) ? c : mine; }
        if (sum == G) break;
        __builtin_amdgcn_s_sleep(1);
        if ((++sp & 255u) == 0u) { if (xb_ld(&bar[XB_TMO])) break; if (sp > XB_SPIN_CAP) { atomicAdd(&bar[XB_TMO], 1u); break; } }
    }
    nloc = mine > 0u ? mine : 1u; nx = cnt > 0u ? cnt : 1u;
}
__device__ __forceinline__ void xcd_barrier(const XcdBarrier& b) {
    asm volatile("s_waitcnt vmcnt(0)" ::: "memory");
    __syncthreads();
    if (threadIdx.x == 0) {
        unsigned* bar = b.bar;
        __builtin_amdgcn_s_waitcnt(0);
        unsigned nloc = b.st[0], nx = b.st[1];
        if (nloc == 0u) { xcd_barrier_complete(bar, b.x, nloc, nx); b.st[0] = nloc; b.st[1] = nx; }
        const unsigned old = xb_add(&bar[XB_XSUB(b.x)], 1u);
        const unsigned gen = old / nloc;
        if (old + 1u == (gen + 1u) * nloc) {
            __builtin_amdgcn_fence(__ATOMIC_RELEASE, "agent");
            asm volatile("s_waitcnt vmcnt(0)" ::: "memory");
            const unsigned og = xb_add(&bar[XB_TOP], 1u);
            const unsigned tg = og / nx;
            if (og + 1u == (tg + 1u) * nx) xb_add(&bar[XB_TOPGEN], 1u);
            else XB_SPIN(xb_ld(&bar[XB_TOPGEN]) == tg, bar);
            __builtin_amdgcn_fence(__ATOMIC_ACQUIRE, "agent");
            xb_add(&bar[XB_XGEN(b.x)], 1u);
            asm volatile("s_waitcnt vmcnt(0)" ::: "memory");
        } else {
            XB_SPIN(xb_ld(&bar[XB_XGEN(b.x)]) == gen, bar);
            __builtin_amdgcn_fence(__ATOMIC_ACQUIRE, "agent");
            asm volatile("s_waitcnt vmcnt(0)" ::: "memory");
        }
    }
    __syncthreads();
}

#ifndef PG8_ALIGN_EPI
#define PG8_ALIGN_EPI 1
#endif
#ifndef PG8_SP2
#define PG8_SP2 1
#endif
namespace pg8 {
constexpr int BM = 256, BK = 64, HALF = 128, HTB = HALF * BK * 2, STAGE_BYTES = 8 * HTB, NXCD = 8, WGM = 8;
__host__ __device__ __forceinline__ int lds_byte(int r, int c) { const int st = (r >> 4) * 2 + (c >> 5), rr = r & 15, cc = c & 31, ob = rr * 64 + cc * 2; return st * 1024 + (ob ^ (((ob >> 9) & 1) << 5)); }
__host__ __device__ __forceinline__ void stage_rc(int b, int& R, int& C) { const int st = b / 1024, sb = b % 1024, swz = sb ^ (((sb >> 9) & 1) << 5); R = (st >> 1) * 16 + swz / 64; C = (st & 1) * 32 + (swz % 64) / 2; }
__host__ __device__ __forceinline__ int perm32(int rho) { const int n = rho >> 4, i = rho & 15; return 8 * (i >> 2) + 4 * n + (i & 3); }

__device__ __forceinline__ void glds16_saddr(unsigned voff, const void* sbase, unsigned lds_dst) { unsigned keep;
    asm volatile("s_mov_b32 %0, m0\n\ts_mov_b32 m0, %3\n\ts_nop 0\n\tglobal_load_lds_dwordx4 %1, %2\n\ts_mov_b32 m0, %0" : "=&s"(keep) : "v"(voff), "s"(sbase), "s"(lds_dst) : "memory"); }
struct Unit { const char* a; const char* b; int pm, pn, aux; };

struct TileOrder {
    int nM, nN, nwg, G, c;
    __device__ __forceinline__ void init(int nM_, int nN_, int G_, int c_) { nM = nM_; nN = nN_; nwg = nM * nN; G = G_; c = c_; }
    __device__ __forceinline__ bool tile(int i, int& pm, int& pn) const { return tileL((long)i * G + c, pm, pn); }
    __device__ __forceinline__ bool tileL(const long L, int& pm, int& pn) const {
        if (L >= nwg) return false;
        int wgid = (int)L; { const int q = nwg / NXCD, r = nwg % NXCD, xcd = wgid % NXCD, off = wgid / NXCD; wgid = (xcd < r ? xcd * (q + 1) : r * (q + 1) + (xcd - r) * q) + off; }
        const int nig = WGM * nN, gid = wgid / nig, fm = gid * WGM, gsz = (nM - fm) < WGM ? (nM - fm) : WGM;
        pm = fm + ((wgid % nig) % gsz); pn = (wgid % nig) / gsz; return true;
    }
};

template <class Epi, class Sched>
__device__ __forceinline__ void gemm_phase(LAS unsigned char* lds, const int K, const int lda, const int ldb, const Sched& S, const Epi& E) {
    int tid_ = threadIdx.x; asm volatile("" : "+v"(tid_));
    const int tid = tid_, wid = __builtin_amdgcn_readfirstlane(tid >> 6), lane = tid & 63, wr = wid >> 2, wc = wid & 3, fr = lane & 15, fq = lane >> 4;
    const int nt = K / BK;
    unsigned voffA[2], voffB[2]; int Rr[2];
#pragma unroll
    for (int i = 0; i < 2; ++i) { int R, C; stage_rc(tid * 16 + i * 8192, R, C); const int Rb = Epi::PERM ? ((R & ~31) + perm32(R & 31)) : R;
        voffA[i] = Sched::GATHER ? (unsigned)C * 2u : (unsigned)(R * lda + C) * 2u; voffB[i] = (unsigned)(Rb * ldb + C) * 2u; Rr[i] = R; }
    unsigned gA0 = 0u, gA1 = 0u, nG0 = 0u, nG1 = 0u;
    const size_t kstep = (size_t)(BK * 2);
    const size_t hstepA = (size_t)HALF * lda * 2, hstepB = (size_t)HALF * ldb * 2;
    const unsigned ldsw = (unsigned)wid * 1024u;
    const unsigned ldsbase = (unsigned)__builtin_amdgcn_readfirstlane((int)((unsigned)(uintptr_t)lds + ldsw));
    const int aoff = lds_byte(wr * 64 + fr, fq * 8), boff = lds_byte(wc * 32 + fr, fq * 8);
#define PG8_SA(b, h) (((b) * 2 + (h)) * HTB)
#define PG8_SB(b, h) ((4 + (b) * 2 + (h)) * HTB)
#define PG8_STAGE(bufoff, gbase, voff) do { _Pragma("unroll") for (int _i = 0; _i < 2; ++_i) \
        glds16_saddr((voff)[_i], (const void*)(gbase), ldsbase + (unsigned)((bufoff) + _i * 8192)); } while (0)
#define PG8_STAGE_A(b, h, ptr_plain, ptr_gather, GO) do { if constexpr (Sched::GATHER) { const unsigned go_[2] = { ((GO) & 0xffffu) * S.rowbytes() + voffA[0], ((GO) >> 16) * S.rowbytes() + voffA[1] }; PG8_STAGE(PG8_SA(b, h), ptr_gather, go_); } \
        else PG8_STAGE(PG8_SA(b, h), ptr_plain, voffA); } while (0)
#define PG8_LDA(dst, b, h) do { _Pragma("unroll") for (int m = 0; m < 4; ++m) { \
        if constexpr (Epi::FP8) dst##8[m] = __builtin_shufflevector(*(const LAS v4i32*)(lds + PG8_SA(b, h) + aoff + m * 2048), *(const LAS v4i32*)(lds + PG8_SA(b, h) + aoff + m * 2048 + 1024), 0, 1, 2, 3, 4, 5, 6, 7); \
        else { _Pragma("unroll") for (int k = 0; k < 2; ++k) dst[m][k] = *(const LAS bf16x8*)(lds + PG8_SA(b, h) + aoff + m * 2048 + k * 1024); } } } while (0)
#define PG8_LDB(dst, b, h) do { _Pragma("unroll") for (int n = 0; n < 2; ++n) { \
        if constexpr (Epi::FP8) dst##8[n] = __builtin_shufflevector(*(const LAS v4i32*)(lds + PG8_SB(b, h) + boff + n * 2048), *(const LAS v4i32*)(lds + PG8_SB(b, h) + boff + n * 2048 + 1024), 0, 1, 2, 3, 4, 5, 6, 7); \
        else { _Pragma("unroll") for (int k = 0; k < 2; ++k) dst[n][k] = *(const LAS bf16x8*)(lds + PG8_SB(b, h) + boff + n * 2048 + k * 1024); } } } while (0)
#define PG8_MMA(ai, bj, At, Bt) do { __builtin_amdgcn_s_setprio(1); \
        if constexpr (Epi::FP8) {     \
            _Pragma("unroll") for (int m = 0; m < 4; ++m) _Pragma("unroll") for (int n = 0; n < 2; ++n) { \
                asm volatile("v_mfma_scale_f32_16x16x128_f8f6f4 %0, %1, %2, %0, %3, %3 op_sel_hi:[0,0,0]" : "+v"(acc[ai][bj][m][n]) : "v"(Bt##8[n]), "v"(At##8[m]), "v"(sc8)); }   \
        } else { \
            _Pragma("unroll") for (int m = 0; m < 4; ++m) _Pragma("unroll") for (int n = 0; n < 2; ++n) _Pragma("unroll") for (int k = 0; k < 2; ++k) \
                acc[ai][bj][m][n] = __builtin_amdgcn_mfma_f32_16x16x32_bf16(Bt[n][k], At[m][k], acc[ai][bj][m][n], 0, 0, 0); } \
        __builtin_amdgcn_s_setprio(0); } while (0)
#define PG8_WAIT_V(n) asm volatile("s_waitcnt vmcnt(" #n ")" ::: "memory")
#define PG8_WAIT_L(n) asm volatile("s_waitcnt lgkmcnt(" #n ")" ::: "memory")
#define PG8_BAR __builtin_amdgcn_s_barrier()
#define PG8_SCHED __builtin_amdgcn_sched_barrier(0)
    Unit cur, nxt; int ui = 0;
    if (!S.next(0, cur)) return;
    f32x4 acc[2][2][4][2];
#pragma unroll
    for (int a = 0; a < 2; ++a)
#pragma unroll
        for (int b = 0; b < 2; ++b)
#pragma unroll
            for (int m = 0; m < 4; ++m)
#pragma unroll
                for (int n = 0; n < 2; ++n) acc[a][b][m][n] = (f32x4){0.f, 0.f, 0.f, 0.f};
    const int sc8 = 0x7F7F7F7F;
    bf16x8 At[4][2], B0[2][2], B1[2][2]; v8i32 At8[4], B08[2], B18[2];
    const char* cA = cur.a; const char* cB = cur.b;
    if constexpr (Sched::GATHER) { S.rows(cur, tid, gA0, gA1); }
#if PG8_SP2
    PG8_STAGE(PG8_SB(0, 0), cB, voffB); PG8_STAGE(PG8_SB(0, 1), cB + hstepB, voffB); PG8_STAGE_A(0, 0, cA, cA, gA0); PG8_STAGE_A(0, 1, cA + hstepA, cA, gA1);
    if (wr == 1) PG8_BAR;
    PG8_WAIT_V(2); PG8_BAR;
    PG8_STAGE(PG8_SB(1, 0), cB + kstep, voffB); PG8_STAGE_A(1, 0, cA + kstep, cA + kstep, gA0); PG8_STAGE(PG8_SB(1, 1), cB + hstepB + kstep, voffB);
    PG8_WAIT_V(6); PG8_BAR;
#else
    PG8_STAGE(PG8_SB(0, 0), cB, voffB); PG8_STAGE_A(0, 0, cA, cA, gA0); PG8_STAGE(PG8_SB(0, 1), cB + hstepB, voffB); PG8_STAGE_A(0, 1, cA + hstepA, cA, gA1);
    if (wr == 1) PG8_BAR;
    PG8_WAIT_V(4); PG8_BAR;
    PG8_STAGE(PG8_SB(1, 0), cB + kstep, voffB); PG8_STAGE_A(1, 0, cA + kstep, cA + kstep, gA0); PG8_STAGE(PG8_SB(1, 1), cB + hstepB + kstep, voffB);
    PG8_WAIT_V(6); PG8_BAR;
#endif
    for (;;) {
        const bool has_next = S.next(ui + 1, nxt);
        const char* nA = has_next ? nxt.a : cA; const char* nB = has_next ? nxt.b : cB;
        if constexpr (Sched::GATHER) { if (has_next) S.rows(nxt, tid, nG0, nG1); else { nG0 = gA0; nG1 = gA1; } }
#pragma unroll 1
        for (int t = 0; t < nt; t += 2) {
            const bool last = (t == nt - 2);
            const char* a1 = cA + (size_t)(t + 1) * kstep;
            const char* a2 = last ? nA : cA + (size_t)(t + 2) * kstep; const char* b2 = last ? nB : cB + (size_t)(t + 2) * kstep;
            const char* a3 = a2 + kstep; const char* b3 = b2 + kstep;
            const unsigned s0 = last ? nG0 : gA0, s1 = last ? nG1 : gA1;
#if PG8_SP2
            PG8_LDB(B0, 0, 0); PG8_LDB(B1, 0, 1); PG8_SCHED; PG8_LDA(At, 0, 0); PG8_STAGE_A(1, 1, a1 + hstepA, a1, gA1);
            PG8_WAIT_V(8); PG8_WAIT_L(0); PG8_BAR; PG8_MMA(0, 0, At, B0); PG8_MMA(0, 1, At, B1); PG8_BAR; PG8_SCHED;
            PG8_LDA(At, 0, 1); PG8_STAGE(PG8_SB(0, 0), b2, voffB); PG8_STAGE(PG8_SB(0, 1), b2 + hstepB, voffB); PG8_STAGE_A(0, 0, a2, a2, s0);
            PG8_WAIT_V(8); PG8_WAIT_L(0); PG8_BAR; PG8_MMA(1, 0, At, B0); PG8_MMA(1, 1, At, B1); PG8_BAR; PG8_SCHED;
            PG8_LDB(B0, 1, 0); PG8_LDB(B1, 1, 1); PG8_SCHED; PG8_LDA(At, 1, 0); PG8_STAGE_A(0, 1, a2 + hstepA, a2, s1);
            PG8_WAIT_V(8); PG8_WAIT_L(0); PG8_BAR; PG8_MMA(0, 0, At, B0); PG8_MMA(0, 1, At, B1); PG8_BAR; PG8_SCHED;
            PG8_LDA(At, 1, 1); PG8_STAGE(PG8_SB(1, 0), b3, voffB); PG8_STAGE(PG8_SB(1, 1), b3 + hstepB, voffB); PG8_STAGE_A(1, 0, a3, a3, s0);
            PG8_WAIT_V(8); PG8_WAIT_L(0); PG8_BAR; PG8_MMA(1, 0, At, B0); PG8_MMA(1, 1, At, B1); PG8_BAR; PG8_SCHED;
#else
            PG8_LDB(B0, 0, 0); PG8_SCHED; PG8_LDA(At, 0, 0); PG8_STAGE_A(1, 1, a1 + hstepA, a1, gA1);
            PG8_WAIT_L(8); PG8_BAR; PG8_WAIT_L(0); PG8_MMA(0, 0, At, B0); PG8_BAR; PG8_SCHED;
            PG8_LDB(B1, 0, 1); PG8_STAGE(PG8_SB(0, 0), b2, voffB);
            PG8_BAR; PG8_WAIT_L(0); PG8_MMA(0, 1, At, B1); PG8_BAR;
            PG8_LDA(At, 0, 1); PG8_STAGE_A(0, 0, a2, a2, s0);
            PG8_BAR; PG8_WAIT_L(0); PG8_MMA(1, 0, At, B0); PG8_BAR; PG8_SCHED;
            PG8_STAGE(PG8_SB(0, 1), b2 + hstepB, voffB);
            PG8_WAIT_V(6); PG8_BAR; PG8_MMA(1, 1, At, B1); PG8_BAR;
            PG8_LDB(B0, 1, 0); PG8_SCHED; PG8_LDA(At, 1, 0); PG8_STAGE_A(0, 1, a2 + hstepA, a2, s1);
            PG8_WAIT_L(8); PG8_BAR; PG8_WAIT_L(0); PG8_MMA(0, 0, At, B0); PG8_BAR; PG8_SCHED;
            PG8_LDB(B1, 1, 1); PG8_STAGE(PG8_SB(1, 0), b3, voffB);
            PG8_BAR; PG8_WAIT_L(0); PG8_MMA(0, 1, At, B1); PG8_BAR;
            PG8_LDA(At, 1, 1); PG8_STAGE_A(1, 0, a3, a3, s0);
            PG8_BAR; PG8_WAIT_L(0); PG8_MMA(1, 0, At, B0); PG8_BAR; PG8_SCHED;
            PG8_STAGE(PG8_SB(1, 1), b3 + hstepB, voffB);
            PG8_WAIT_V(6); PG8_BAR; PG8_MMA(1, 1, At, B1); PG8_BAR;
#endif
        }
#if PG8_ALIGN_EPI
        if (wr == 0) PG8_BAR;
#endif
        if constexpr (Epi::FP8) asm volatile("s_nop 15\n\ts_nop 15" ::: "memory");
        { int t_ = tid; asm volatile("" : "+v"(t_)); const int fr_ = t_ & 15, fq_ = (t_ >> 4) & 3;
          E(acc, cur, wr, wc, fr_, fq_); }
        if (!has_next) break;
        bool keep_acc = false; if constexpr (Epi::CHAIN) keep_acc = E.keep(cur);
        if (!keep_acc) {
#pragma unroll
        for (int a = 0; a < 2; ++a)
#pragma unroll
            for (int b = 0; b < 2; ++b)
#pragma unroll
                for (int m = 0; m < 4; ++m)
#pragma unroll
                    for (int n = 0; n < 2; ++n) acc[a][b][m][n] = (f32x4){0.f, 0.f, 0.f, 0.f};
        }
        cur = nxt; cA = nA; cB = nB; ++ui;
        if constexpr (Sched::GATHER) { gA0 = nG0; gA1 = nG1; }
#if PG8_ALIGN_EPI
        if (wr == 1) PG8_BAR;
#endif
    }
    PG8_WAIT_V(0);
#if !PG8_ALIGN_EPI
    if (wr == 0) PG8_BAR;
#endif
    PG8_BAR;
#undef PG8_SA
#undef PG8_SB
#undef PG8_STAGE
#undef PG8_STAGE_A
#undef PG8_LDA
#undef PG8_LDB
#undef PG8_MMA
#undef PG8_WAIT_V
#undef PG8_WAIT_L
#undef PG8_BAR
#undef PG8_SCHED
}

struct SchedPlain {
    static constexpr bool GATHER = false;
    TileOrder T; const char* A; const char* B; size_t atile, btile; int pn0;
    int deal = 0, bx = 0;
    __device__ __forceinline__ bool next(int i, Unit& u) const {
        if (deal) { long L;
            if (i < 5) L = (long)i * 256 + bx;
            else if (i == 5) { if (bx < 48) return false; L = 1280 + (bx - 48); }
            else if (i == 6) { if (bx >= 48 && bx < 96) L = 1488 + (bx - 48); else if (bx >= 208) L = 1536 + (bx - 208); else return false; }
            else return false;
            if (!T.tileL(L, u.pm, u.pn)) return false; }
        else if (!T.tile(i, u.pm, u.pn)) return false;
        u.a = A + (size_t)u.pm * atile; u.b = B + (size_t)u.pn * btile; u.pn += pn0; u.aux = 0; return true; }
};
struct SchedMerge {
    static constexpr bool GATHER = false;
    TileOrder T; const char* Q; const char* C; const char* W;
    __device__ __forceinline__ bool next(int i, Unit& u) const { const int k = i % 3; if (!T.tile(i / 3, u.pm, u.pn)) return false;
        u.a = (k < 2 ? Q + (size_t)(512 * k) * 2 : C) + (size_t)u.pm * 256 * QW * 2; u.b = W + ((size_t)(k * 1024 + u.pn * 256) * 512) * 2; u.aux = k; return true; }
};
struct SchedMergeOne {
    static constexpr bool GATHER = false;
    int pm, pn; const char* Q; const char* C; const char* W;
    __device__ __forceinline__ bool next(int i, Unit& u) const { if (i >= 3) return false; const int k = i; u.pm = pm; u.pn = pn;
        u.a = (k < 2 ? Q + (size_t)(512 * k) * 2 : C) + (size_t)u.pm * 256 * QW * 2; u.b = W + ((size_t)(k * 1024 + u.pn * 256) * 512) * 2; u.aux = k; return true; }
};
struct SchedPlainOne {
    static constexpr bool GATHER = false;
    int pm, pn; const char* A; const char* B; size_t atile, btile;
    __device__ __forceinline__ bool next(int i, Unit& u) const { if (i >= 1) return false; u.pm = pm; u.pn = pn; u.a = A + (size_t)pm * atile; u.b = B + (size_t)pn * btile; u.aux = 0; return true; }
};
template <bool GATHER_> struct SchedMoE {
    static constexpr bool GATHER = GATHER_;
    int G, v, nN, has_ctx; const char* A; const char* W; size_t wexp; const int* idx; int rb;
    __device__ __forceinline__ bool next(int i, Unit& u) const {
        const int L = i * G + v, per = 4 * nN, nlat = 64 * per; int tm, e, pn;
        if (L < nlat) { const int g = L / per, r = L % per; tm = g * 4 + r / nN; pn = r % nN; e = g & 15; }
        else { const int L2 = L - nlat; if (!has_ctx || L2 >= 16 * nN) return false; e = L2 / nN; pn = L2 % nN; tm = 256 + e; }
        u.a = GATHER_ ? A : A + (size_t)tm * 256 * rb; u.b = W + (size_t)e * wexp + (size_t)pn * 256 * rb; u.pm = tm; u.pn = pn; u.aux = e; return true;
    }
    __device__ __forceinline__ unsigned srcrow(int tm, int j) const {
        const bool latent = tm < 256; const int e = tm - 256, b = (j >> 5) & 3, sl = j & 31;
        const int ix = latent ? tm * 256 + j : MOE_ROWS_LAT + (b * NE + e) * CAPC + sl;
        const int base = latent ? (tm >> 6) * SEQ : ML + b * CTX;
        const int v = idx[ix];
        return (latent || j < 128) ? (unsigned)(base + v) : 0u;
    }
    __device__ __forceinline__ unsigned rowbytes() const { return (unsigned)rb; }
    __device__ __forceinline__ void rows(const Unit& u, const int tid, unsigned& p0, unsigned& p1) const {
        int t_ = tid; asm volatile("" : "+v"(t_)); int r0, r1, c_; stage_rc(t_ * 16, r0, c_); stage_rc(t_ * 16 + 8192, r1, c_);
        p0 = srcrow(u.pm, r0) | (srcrow(u.pm, r1) << 16); p1 = srcrow(u.pm, 128 + r0) | (srcrow(u.pm, 128 + r1) << 16);
    }
};

__device__ __forceinline__ unsigned pack4_fp8(float a, float b, float c, float d) {
    unsigned w; asm("v_cvt_pk_fp8_f32 %0, %1, %2" : "=v"(w) : "v"(a), "v"(b)); asm("v_cvt_pk_fp8_f32 %0, %1, %2 op_sel:[0,0,1]" : "+v"(w) : "v"(c), "v"(d)); return w; }
constexpr float WSCALE = 32.0f, WDESCALE = 1.0f / 32.0f;
#ifndef EPI_NT
#define EPI_NT 1
#endif
#if EPI_NT
#define EPI_ST16(p, v) __builtin_nontemporal_store((v), (u32x4*)(p))
#else
#define EPI_ST16(p, v) (*(u32x4*)(p) = (v))
#endif
struct EpiInProj {
    static constexpr bool PERM = true, CHAIN = false, FP8 = false;
    bf16_t* W0;
    const float* gains;
    const float* rope;
    __device__ __forceinline__ void operator()(f32x4 (&acc)[2][2][4][2], const Unit& u, int wr, int wc, int fr, int fq) const {
        if (u.pn < 6) {
            const int hg = u.pn * 4 + wc;
            const bool isv = (hg < 8) && ((hg & 2) != 0), isq = hg >= 8, lat = u.pm < 128;
            const int b = lat ? (u.pm >> 5) : (u.pm - 128);
            const int gsel = (hg < 8) ? ((hg & 4) ? 1 : 0) : (hg < 16 ? 2 : 3);
            const float* gp = gains + gsel * 64 + 8 * fq;
            const f32x4 g1a = *(const f32x4*)gp, g1b = *(const f32x4*)(gp + 4), g2a = *(const f32x4*)(gp + 32), g2b = *(const f32x4*)(gp + 36);
            float frq[8];
            { const f32x4 fa = *(const f32x4*)(rope + 8 * (fq & 1)), fb = *(const f32x4*)(rope + 8 * (fq & 1) + 4); frq[0] = fa[0]; frq[1] = fa[1]; frq[2] = fa[2]; frq[3] = fa[3]; frq[4] = fb[0]; frq[5] = fb[1]; frq[6] = fb[2]; frq[7] = fb[3]; }
            bf16_t* dbase; size_t dpitch; int prow0;
            if (isq) { dbase = W0 + WS_QKV / 2 + OFF_QA + (hg - 8) * 64 + 8 * fq; dpitch = QW; prow0 = u.pm * BM; }
            else { const size_t off = (hg & 4) ? (isv ? WS_VTB : WS_KB) : (isv ? WS_VTA : WS_KA);
                dbase = W0 + off / 2 + (size_t)(b * 2 + (hg & 1)) * KVROWS * 64 + 8 * fq; dpitch = 64; prow0 = lat ? (u.pm & 31) * BM : SEQ; }
#pragma unroll
            for (int ai = 0; ai < 2; ++ai)
#pragma unroll
                for (int m = 0; m < 4; ++m) {
                    const int rt = ai * HALF + wr * 64 + m * 16 + fr;
                    float x1[8], x2[8];
#pragma unroll
                    for (int e = 0; e < 4; ++e) { x1[e] = acc[ai][0][m][0][e]; x1[4 + e] = acc[ai][0][m][1][e]; x2[e] = acc[ai][1][m][0][e]; x2[4 + e] = acc[ai][1][m][1][e]; }
                    if (!isv) {
                        float ss = 0.f;
#pragma unroll
                        for (int e = 0; e < 8; ++e) ss += x1[e] * x1[e] + x2[e] * x2[e];
                        ss += __shfl_xor(ss, 16); ss += __shfl_xor(ss, 32);
                        const float rinv = 1.0f / sqrtf(ss * (1.0f / 64.0f) + EPS);
#pragma unroll
                        for (int e = 0; e < 4; ++e) { x1[e] *= rinv * g1a[e]; x1[4 + e] *= rinv * g1b[e]; x2[e] *= rinv * g2a[e]; x2[4 + e] *= rinv * g2b[e]; }
                        if (lat) {
                            const int rowpos = 4 * (u.pm & 31) + 2 * ai + wr, colpos = 16 * m + fr;
                            const float posf = (float)((fq < 2) ? rowpos : colpos);
#pragma unroll
                            for (int e = 0; e < 8; ++e) { const float ang = posf * frq[e];
                                const float rev = ang * 0.15915494309189535f, cse = __builtin_amdgcn_cosf(rev), sne = __builtin_amdgcn_sinf(rev);
                                const float a1 = x1[e], a2 = x2[e]; x1[e] = a1 * cse - a2 * sne; x2[e] = a2 * cse + a1 * sne; }
                        }
                        if (isq) {
#pragma unroll
                            for (int e = 0; e < 8; ++e) { x1[e] *= QSCALE; x2[e] *= QSCALE; }
                        }
                    }
                    u32x4 w1, w2; w1.x = cvt_pk_bf16(x1[0], x1[1]); w1.y = cvt_pk_bf16(x1[2], x1[3]); w1.z = cvt_pk_bf16(x1[4], x1[5]); w1.w = cvt_pk_bf16(x1[6], x1[7]);
                    w2.x = cvt_pk_bf16(x2[0], x2[1]); w2.y = cvt_pk_bf16(x2[2], x2[3]); w2.z = cvt_pk_bf16(x2[4], x2[5]); w2.w = cvt_pk_bf16(x2[6], x2[7]);
                    bf16_t* dp = dbase + (size_t)(prow0 + rt) * dpitch;
                    *(u32x4*)dp = w1; *(u32x4*)(dp + 32) = w2;
                }
            return;
        }
        if (u.pn >= 8 && u.pn < 12) {
            const int row0 = u.pm * BM + wr * 64 + fr, col0 = 512 + (u.pn - 8) * HALF + wc * 32 + 8 * fq;
#pragma unroll
            for (int ai = 0; ai < 2; ++ai)
#pragma unroll
                for (int m = 0; m < 4; ++m) { const f32x4 c0 = acc[ai][0][m][0], c1 = acc[ai][0][m][1], x0 = acc[ai][1][m][0], x1v = acc[ai][1][m][1];
                    u32x4 w; w.x = cvt_pk_bf16(c0[0] * x0[0], c0[1] * x0[1]); w.y = cvt_pk_bf16(c0[2] * x0[2], c0[3] * x0[3]); w.z = cvt_pk_bf16(c1[0] * x1v[0], c1[1] * x1v[1]); w.w = cvt_pk_bf16(c1[2] * x1v[2], c1[3] * x1v[3]);
                    EPI_ST16(W0 + WS_CONV / 2 + (size_t)(row0 + ai * HALF + m * 16) * QW + col0, w); }
            return;
        }
        const int pnl = u.pn - 6;
        const int row0 = u.pm * BM + wr * 64 + fr, col0 = pnl * BM + wc * 32 + 8 * fq;
        bf16_t* const cbase = W0 + WS_CONV / 2;
#pragma unroll
        for (int ai = 0; ai < 2; ++ai)
#pragma unroll
            for (int m = 0; m < 4; ++m) { bf16_t* rowp = cbase + (size_t)(row0 + ai * HALF + m * 16) * QW + col0;
#pragma unroll
                for (int bj = 0; bj < 2; ++bj) { const f32x4 v0 = acc[ai][bj][m][0], v1 = acc[ai][bj][m][1];
                    u32x4 w; w.x = cvt_pk_bf16(v0[0], v0[1]); w.y = cvt_pk_bf16(v0[2], v0[3]); w.z = cvt_pk_bf16(v1[0], v1[1]); w.w = cvt_pk_bf16(v1[2], v1[3]);
                    EPI_ST16(rowp + bj * HALF, w); } }
    }
};
struct EpiInProjGate {
    static constexpr bool PERM = true, CHAIN = false, FP8 = true;
    bf16_t* W0;
    __device__ __forceinline__ void operator()(f32x4 (&acc)[2][2][4][2], const Unit& u, int wr, int wc, int fr, int fq) const {
        unsigned char* const gt8 = (unsigned char*)W0 + WS_GATE + ((size_t)(u.pm * 12 + (u.pn - 12)) << 16) + (size_t)(((wr * 4 + wc) * 64) + fq * 16 + fr) * 16;
#pragma unroll
        for (int ai = 0; ai < 2; ++ai)
#pragma unroll
            for (int m = 0; m < 4; ++m) { unsigned qb[4];
#pragma unroll
                for (int bj = 0; bj < 2; ++bj)
#pragma unroll
                    for (int n = 0; n < 2; ++n) { unsigned wv = 0u;
#pragma unroll
                        for (int j = 0; j < 4; ++j) { const float ex = __builtin_amdgcn_exp2f(acc[ai][bj][m][n][j] * (-WDESCALE * LOG2E));
                            const float r256 = __builtin_amdgcn_rcpf(__builtin_fmaf(ex, 1.0f / 256.0f, 1.0f / 256.0f)); const unsigned q = (unsigned)fminf(r256, 255.0f); wv |= q << (8 * j); }
                        qb[bj * 2 + n] = wv; }
                EPI_ST16(gt8 + (size_t)((ai * 4 + m) * 512) * 16, ((u32x4){qb[0], qb[1], qb[2], qb[3]})); }
    }
};
struct EpiMerge {
    static constexpr bool PERM = true, CHAIN = true, FP8 = false;
    const unsigned char* Gt; bf16_t* Mg;
    __device__ __forceinline__ bool keep(const Unit& u) const { return u.aux < 2; }
    __device__ __forceinline__ void operator()(f32x4 (&acc)[2][2][4][2], const Unit& u, int wr, int wc, int fr, int fq) const {
        const int row0 = u.pm * BM + wr * 64 + fr, col0 = u.pn * BM + wc * 32 + 8 * fq; const int k = u.aux;
        const unsigned char* const gt8 = Gt + ((size_t)(u.pm * 12 + 4 * k + u.pn) << 16) + (size_t)(((wr * 4 + wc) * 64) + fq * 16 + fr) * 16;
        u32x4 g[2][4], q[2][4];
#pragma unroll
        for (int ai = 0; ai < 2; ++ai)
#pragma unroll
            for (int m = 0; m < 4; ++m) { const unsigned char* gp = gt8 + (size_t)((ai * 4 + m) * 512) * 16;
                g[ai][m] = *(const u32x4*)gp; if (k < 2) q[ai][m] = *(const u32x4*)(gp + ((size_t)4 << 16)); }
        asm volatile("" ::: "memory");
#pragma unroll
        for (int ai = 0; ai < 2; ++ai)
#pragma unroll
            for (int m = 0; m < 4; ++m)
#pragma unroll
                for (int bj = 0; bj < 2; ++bj) {
                    const unsigned g0w = bj ? g[ai][m].z : g[ai][m].x, g1w = bj ? g[ai][m].w : g[ai][m].y;
                    float gk[8];
#pragma unroll
                    for (int j = 0; j < 4; ++j) { gk[j] = ((float)((g0w >> (8 * j)) & 255u) + 0.5f) * (1.0f / 256.0f); gk[4 + j] = ((float)((g1w >> (8 * j)) & 255u) + 0.5f) * (1.0f / 256.0f); }
                    if (k < 2) {
                        const unsigned q0w = bj ? q[ai][m].z : q[ai][m].x, q1w = bj ? q[ai][m].w : q[ai][m].y;
#pragma unroll
                        for (int j = 0; j < 4; ++j) { const float d0 = (float)((q0w >> (8 * j)) & 255u) + 0.5f, d1 = (float)((q1w >> (8 * j)) & 255u) + 0.5f;
                            acc[ai][bj][m][0][j] *= (gk[j] * 256.0f) * __builtin_amdgcn_rcpf(d0); acc[ai][bj][m][1][j] *= (gk[4 + j] * 256.0f) * __builtin_amdgcn_rcpf(d1); }
                    } else {
                        const f32x4 v0 = acc[ai][bj][m][0], v1 = acc[ai][bj][m][1];
                        u32x4 w; w.x = cvt_pk_bf16(v0[0] * gk[0], v0[1] * gk[1]); w.y = cvt_pk_bf16(v0[2] * gk[2], v0[3] * gk[3]); w.z = cvt_pk_bf16(v1[0] * gk[4], v1[1] * gk[5]); w.w = cvt_pk_bf16(v1[2] * gk[6], v1[3] * gk[7]);
                        *(u32x4*)(Mg + (size_t)(row0 + ai * HALF + m * 16) * D + col0 + bj * HALF) = w;
                    }
                }
    }
};
struct EpiOut {
    static constexpr bool PERM = true, CHAIN = false, FP8 = false;
    bf16_t* Dl; const float* modl;
    const float* xf; const float* xcf; const bf16_t* xb16;
    __device__ __forceinline__ void operator()(f32x4 (&acc)[2][2][4][2], const Unit& u, int wr, int wc, int fr, int fq) const {
        const int mr = (u.pm < 128) ? (u.pm >> 5) : 4;
        const float* gt = modl + mr * PW + 2 * D;
        const int row0 = u.pm * BM + wr * 64 + fr, col0 = u.pn * BM + wc * 32 + 8 * fq;
        f32x4 gv[2][2];
#pragma unroll
        for (int bj = 0; bj < 2; ++bj)
#pragma unroll
            for (int n = 0; n < 2; ++n) gv[bj][n] = *(const f32x4*)(gt + col0 + bj * HALF + 4 * n);
#pragma unroll
        for (int ai = 0; ai < 2; ++ai)
#pragma unroll
            for (int m = 0; m < 4; ++m) { const int row = row0 + ai * HALF + m * 16; bf16_t* rowp = Dl + (size_t)row * D + col0;
                f32x4 xa[2], xb[2];
                if (xb16) {
#pragma unroll
                    for (int bj = 0; bj < 2; ++bj) { const u32x4 t = *(const u32x4*)(xb16 + (size_t)row * D + col0 + bj * HALF); xa[bj] = (f32x4){bf_lo(t.x), bf_hi(t.x), bf_lo(t.y), bf_hi(t.y)}; xb[bj] = (f32x4){bf_lo(t.z), bf_hi(t.z), bf_lo(t.w), bf_hi(t.w)}; }
                } else { const float* xr = (u.pm < 128 ? xf + (size_t)row * D : xcf + (size_t)(row - ML) * D) + col0;
#pragma unroll
                    for (int bj = 0; bj < 2; ++bj) { xa[bj] = *(const f32x4*)(xr + bj * HALF); xb[bj] = *(const f32x4*)(xr + bj * HALF + 4); } }
#pragma unroll
                for (int bj = 0; bj < 2; ++bj) { const f32x4 v0 = xa[bj] + acc[ai][bj][m][0] * gv[bj][0], v1 = xb[bj] + acc[ai][bj][m][1] * gv[bj][1];
                    u32x4 w; w.x = cvt_pk_bf16(v0[0], v0[1]); w.y = cvt_pk_bf16(v0[2], v0[3]); w.z = cvt_pk_bf16(v1[0], v1[1]); w.w = cvt_pk_bf16(v1[2], v1[3]);
                    *(u32x4*)(rowp + bj * HALF) = w; } }
    }
};
struct EpiGU {
    static constexpr bool PERM = true, CHAIN = false, FP8 = true;
    unsigned char* Hd;
    __device__ __forceinline__ void operator()(f32x4 (&acc)[2][2][4][2], const Unit& u, int wr, int wc, int fr, int fq) const {
        const int row0 = u.pm * BM + wr * 64 + fr, col0 = u.pn * HALF + wc * 32 + 8 * fq;
#pragma unroll
        for (int ai = 0; ai < 2; ++ai)
#pragma unroll
            for (int m = 0; m < 4; ++m) { unsigned char* rowp = Hd + (size_t)(row0 + ai * HALF + m * 16) * EH + col0;
                float o[8];
#pragma unroll
                for (int n = 0; n < 2; ++n)
#pragma unroll
                    for (int j = 0; j < 4; ++j) { const float a = acc[ai][0][m][n][j] * WDESCALE, uu = acc[ai][1][m][n][j] * WDESCALE; o[4 * n + j] = a * fast_sigmoid(a) * uu; }
                u32x2 w; w.x = pack4_fp8(o[0], o[1], o[2], o[3]); w.y = pack4_fp8(o[4], o[5], o[6], o[7]);
                __builtin_nontemporal_store(w, (u32x2*)rowp); }
    }
};
struct EpiDown {
    static constexpr bool PERM = true, CHAIN = false, FP8 = true;
    bf16_t* Y;
    __device__ __forceinline__ void operator()(f32x4 (&acc)[2][2][4][2], const Unit& u, int wr, int wc, int fr, int fq) const {
        const int row0 = u.pm * BM + wr * 64 + fr, col0 = u.pn * BM + wc * 32 + 8 * fq;
#pragma unroll
        for (int ai = 0; ai < 2; ++ai)
#pragma unroll
            for (int m = 0; m < 4; ++m) { bf16_t* rowp = Y + (size_t)(row0 + ai * HALF + m * 16) * D + col0;
#pragma unroll
                for (int bj = 0; bj < 2; ++bj) { const f32x4 v0 = acc[ai][bj][m][0] * WDESCALE, v1 = acc[ai][bj][m][1] * WDESCALE;
                    u32x4 w; w.x = cvt_pk_bf16(v0[0], v0[1]); w.y = cvt_pk_bf16(v0[2], v0[3]); w.z = cvt_pk_bf16(v1[0], v1[1]); w.w = cvt_pk_bf16(v1[2], v1[3]);
                    EPI_ST16(rowp + bj * HALF, w); } }
    }
};
}

namespace ab {
using bf16=__hip_bfloat16;
using bf16x8=__attribute__((ext_vector_type(8)))short;
using s16x4=__attribute__((ext_vector_type(4)))short;
using f32x16=__attribute__((ext_vector_type(16)))float;
using u32x4=__attribute__((ext_vector_type(4)))unsigned;
constexpr int D=64, QP=1024, KP=64;
constexpr int NW=8,QBLK=32,QB=QBLK*NW,KVBLK=64;
__device__ __forceinline__ int crow(int r,int hi){return (r&3)+8*(r>>2)+4*hi;}
#define SBAR() __builtin_amdgcn_sched_barrier(0)
constexpr int NSLOT=3, SLOTB=8192;
constexpr int LDS_K=0, LDS_V=NSLOT*SLOTB, LDS_WS=2*NSLOT*SLOTB, LDS_OST=LDS_WS+NW*64*4, LDS_BYTES=LDS_OST+NW*4096;
constexpr float C2=0.125f*1.4426950408889634f;
__device__ __forceinline__ void glds16(const void*gsrc,unsigned lds_dst){unsigned keep;
  asm volatile("s_mov_b32 %0, m0\n\ts_mov_b32 m0, %2\n\ts_nop 0\n\tglobal_load_lds_dwordx4 %1, off\n\ts_mov_b32 m0, %0":"=&s"(keep):"v"(gsrc),"s"(lds_dst):"memory");}
__device__ __forceinline__ float max3f(float a,float b,float c){float r;asm("v_max3_f32 %0, %1, %2, %3":"=v"(r):"v"(a),"v"(b),"v"(c));return r;}
__device__ __forceinline__ float max2f(float a,float b){float r;asm("v_max_f32_e32 %0, %1, %2":"=v"(r):"v"(a),"v"(b));return r;}
__device__ __forceinline__ float fadd_s(float a,float b){float r;asm("v_add_f32_e32 %0, %1, %2":"=v"(r):"v"(a),"v"(b));return r;}
__device__ __forceinline__ float fsub_s(float a,float b){float r;asm("v_sub_f32_e32 %0, %1, %2":"=v"(r):"v"(a),"v"(b));return r;}
typedef float f32x2_t __attribute__((ext_vector_type(2))); typedef __bf16 bf16x2_t __attribute__((ext_vector_type(2)));
__device__ __forceinline__ unsigned cvtpk_s(float lo,float hi){f32x2_t v={lo,hi};bf16x2_t b=__builtin_convertvector(v,bf16x2_t);return __builtin_bit_cast(unsigned,b);}
#define WAIT_BAR(N) asm volatile("s_waitcnt vmcnt(" #N ") lgkmcnt(0)\n\ts_barrier":::"memory")

__device__ __forceinline__ void qkt(f32x16&p0,f32x16&p1,const char*Kslot,const bf16x8*qr,const f32x16&negm,int r32,int hi){
  const char*kb=Kslot+hi*1024+r32*16;
  #pragma unroll
  for(int d0=0;d0<4;++d0){
    const bf16x8 b0=*reinterpret_cast<const bf16x8*>(kb+d0*2048);
    const bf16x8 b1=*reinterpret_cast<const bf16x8*>(kb+d0*2048+512);
    if(d0==0){p0=__builtin_amdgcn_mfma_f32_32x32x16_bf16(b0,qr[0],negm,0,0,0);p1=__builtin_amdgcn_mfma_f32_32x32x16_bf16(b1,qr[0],negm,0,0,0);}
    else{p0=__builtin_amdgcn_mfma_f32_32x32x16_bf16(b0,qr[d0],p0,0,0,0);p1=__builtin_amdgcn_mfma_f32_32x32x16_bf16(b1,qr[d0],p1,0,0,0);}}
}
typedef __attribute__((address_space(3))) const char* lds_cptr;
typedef short v4i16_t __attribute__((ext_vector_type(4)));
__device__ __forceinline__ void kload8(bf16x8*kf,lds_cptr kp){
  kf[0]=*(const __attribute__((address_space(3))) bf16x8*)(kp);      kf[1]=*(const __attribute__((address_space(3))) bf16x8*)(kp+512);
  kf[2]=*(const __attribute__((address_space(3))) bf16x8*)(kp+2048); kf[3]=*(const __attribute__((address_space(3))) bf16x8*)(kp+2560);
  kf[4]=*(const __attribute__((address_space(3))) bf16x8*)(kp+4096); kf[5]=*(const __attribute__((address_space(3))) bf16x8*)(kp+4608);
  kf[6]=*(const __attribute__((address_space(3))) bf16x8*)(kp+6144); kf[7]=*(const __attribute__((address_space(3))) bf16x8*)(kp+6656);
}
__device__ __forceinline__ void kload2(bf16x8*kf,lds_cptr kp,int j){ kf[2*j]=*(const __attribute__((address_space(3))) bf16x8*)(kp+j*2048); kf[2*j+1]=*(const __attribute__((address_space(3))) bf16x8*)(kp+j*2048+512); }
__device__ __forceinline__ s16x4 vtr(lds_cptr p){ return __builtin_bit_cast(s16x4,__builtin_amdgcn_ds_read_tr16_b64_v4i16((__attribute__((address_space(3))) v4i16_t*)p)); }
__device__ __forceinline__ float rowmax(const f32x16&p0,const f32x16&p1){
  float a=max3f(p0[0],p0[1],p1[0]),b=max3f(p0[2],p0[3],p1[1]);a=max3f(a,p1[2],p1[3]);
  #pragma unroll
  for(int r=4;r<16;r+=4){a=max3f(a,p0[r],p0[r+1]);b=max3f(b,p0[r+2],p0[r+3]);a=max3f(a,p1[r],p1[r+1]);b=max3f(b,p1[r+2],p1[r+3]);}
  const float m=max2f(a,b);
  auto rr=__builtin_amdgcn_permlane32_swap(__float_as_uint(m),__float_as_uint(m),false,false);
  return max2f(__uint_as_float(rr[0]),__uint_as_float(rr[1]));
}
__device__ __forceinline__ void pv(f32x16*o,int vb,bf16x8 pa0,bf16x8 pa1,bf16x8 pa2,bf16x8 pa3){
  #pragma unroll
  for(int d0=0;d0<2;++d0){s16x4 lo[4],hi[4];
    #pragma unroll
    for(int ks=0;ks<4;++ks){
      asm volatile("ds_read_b64_tr_b16 %0,%1 offset:%c2":"=&v"(lo[ks]):"v"(vb),"i"(d0*4096+ks*1024):"memory");
      asm volatile("ds_read_b64_tr_b16 %0,%1 offset:%c2":"=&v"(hi[ks]):"v"(vb),"i"(d0*4096+ks*1024+512):"memory");}
    asm volatile("s_waitcnt lgkmcnt(0)":::"memory");SBAR();
    #define PK(k) (bf16x8){lo[k][0],lo[k][1],lo[k][2],lo[k][3],hi[k][0],hi[k][1],hi[k][2],hi[k][3]}
    o[d0]=__builtin_amdgcn_mfma_f32_32x32x16_bf16(pa0,PK(0),o[d0],0,0,0);
    o[d0]=__builtin_amdgcn_mfma_f32_32x32x16_bf16(pa1,PK(1),o[d0],0,0,0);
    o[d0]=__builtin_amdgcn_mfma_f32_32x32x16_bf16(pa2,PK(2),o[d0],0,0,0);
    o[d0]=__builtin_amdgcn_mfma_f32_32x32x16_bf16(pa3,PK(3),o[d0],0,0,0);
    #undef PK
  }
}

#ifndef ATTN_STORE16
#define ATTN_STORE16(p,v) (*(u32x4*)(p)=(v))
#endif
template<int THRL,bool WIN,bool HAS_SINK,bool NOMAX> __device__ __forceinline__ void attn_unit(const bf16*Qu,const bf16*__restrict__ Kh,const bf16*__restrict__ Vh,bf16*Ou,const int NT,char*shm,const int tid_in,const int lo,const int q0,const float sink2,const float mfix){
  int tid_o=tid_in; asm volatile("":"+v"(tid_o)); const int tid=tid_o;
  const int lane=tid&63,r32=lane&31,hi=lane>>5; const int wid=__builtin_amdgcn_readfirstlane(tid>>6);
  if(wid>=4)__builtin_amdgcn_s_setprio(1);
  const bf16*Qw=Qu+(long)(wid*QBLK)*QP;
  const unsigned lds0=(unsigned)(uintptr_t)shm;
  float*wsf=(float*)(shm+LDS_WS)+wid*64;
  const bf16*ksrc=Kh+(long)lane*KP+wid*8;
  const bf16*vsrc=Vh+(long)(16*(wid&3)+(lane>>2))*KP+(wid>>2)*32+(lane&3)*8;
  const unsigned kdst=lds0+LDS_K+wid*1024, vdst=lds0+LDS_V+wid*1024;
  #define KVROW(t) (WIN ? (((t)<4) ? (long)(::SEQ+64*(t)) : (long)(64*(lo-4+(t)))) : (long)(t)*KVBLK)
  #define DMA_K(t,slot) glds16(ksrc+KVROW(t)*KP,(unsigned)__builtin_amdgcn_readfirstlane(kdst+(slot)))
  #define DMA_V(t,slot) glds16(vsrc+KVROW(t)*KP,(unsigned)__builtin_amdgcn_readfirstlane(vdst+(slot)))
  const int vb0=(int)(lds0+LDS_V)+((lane>>4)&1)*32+(lane&3)*8+(4*hi+((lane&15)>>2))*64;
  const char*Kbase=shm+LDS_K; bf16x8 kf[8];
  const lds_cptr shm3=(lds_cptr)shm; const lds_cptr kp0=shm3+LDS_K+hi*1024+r32*16; const lds_cptr vp0=shm3+LDS_V+((lane>>4)&1)*32+(lane&3)*8+(4*hi+((lane&15)>>2))*64;
  DMA_K(0,0);DMA_V(0,0);DMA_K(1,SLOTB);
  bf16x8 qr[4];
  #pragma unroll
  for(int d0=0;d0<4;++d0)qr[d0]=*reinterpret_cast<const bf16x8*>(&Qw[(long)r32*QP+d0*16+hi*8]);
  float mhat=NOMAX?mfix:0.f,l_reg=0.f;f32x16 o[2];o[0]=f32x16{};o[1]=f32x16{};f32x16 negm=f32x16{};
  if constexpr(NOMAX){ _Pragma("unroll") for(int r=0;r<16;++r)negm[r]=-mfix; }
  asm volatile("":"+v"(negm));
  const int qpos_=q0+wid*QBLK+r32;
  #define CMASK(P0,P1,t) do{ if(WIN && (t)>=4){ const int d0_=64*(lo-4+(t))+4*hi-qpos_; \
      _Pragma("unroll") for(int r=0;r<16;++r){ const int d_=d0_+(r&3)+8*(r>>2); if(d_>128||d_<-128)P0[r]=-INFINITY; if(d_+32>128||d_+32<-128)P1[r]=-INFINITY; } } }while(0)
  bool resc=false;
  #define START(P0,P1) do{ resc=false; if constexpr(!NOMAX) { const float rm=rowmax(P0,P1); \
      const float dl=rm; mhat=fadd_s(mhat,dl); \
      _Pragma("unroll") for(int r=0;r<16;++r){P0[r]=fsub_s(P0[r],dl);P1[r]=fsub_s(P1[r],dl);} \
      _Pragma("unroll") for(int r=0;r<16;++r)negm[r]=-mhat; asm volatile("":"+v"(negm)); } \
    _Pragma("unroll") for(int r=0;r<16;++r)P0[r]=__builtin_amdgcn_exp2f(P0[r]); }while(0)
  #define RESC() do{ if(resc){ asm volatile("s_waitcnt lgkmcnt(0)":::"memory"); \
      _Pragma("unroll") for(int d_=0;d_<2;++d_) _Pragma("unroll") for(int r=0;r<16;++r)o[d_][r]*=wsf[crow(r,hi)]; } }while(0)
  f32x16 pA0,pA1,pB0,pB1;
  int sl_prev=0,sl_cur=0,sl_next=SLOTB;
  #define ROT() do{sl_prev=sl_cur;sl_cur=sl_next;sl_next=(sl_next==(NSLOT-1)*SLOTB)?0:sl_next+SLOTB;}while(0)
  DMA_K(2,2*SLOTB);
  WAIT_BAR(3);
  qkt(pA0,pA1,Kbase,qr,negm,r32,hi);asm volatile("s_nop 15\n\ts_nop 7":"+v"(pA0),"+v"(pA1));CMASK(pA0,pA1,0);
  START(pA0,pA1);
  _Pragma("unroll") for(int r=0;r<16;++r)pA1[r]=__builtin_amdgcn_exp2f(pA1[r]);
  WAIT_BAR(0);
  DMA_K(3,0);DMA_V(1,SLOTB);
  ROT();
  kload8(kf,kp0+sl_cur);
  WAIT_BAR(2);
  s16x4 vlo[8],vhi[8]; u32x4 pw0,pw1,pw2,pw3;
  #define PKW(P,B) cvtpk_s(P[B],P[B+1])
  #define PAF(k) __builtin_bit_cast(bf16x8,pw##k)
  #define VFR(i) (bf16x8){vlo[i][0],vlo[i][1],vlo[i][2],vlo[i][3],vhi[i][0],vhi[i][1],vhi[i][2],vhi[i][3]}
  #define PIN(x) asm volatile("":"+v"(x))
  #define MX3(a,b,c) __builtin_fmaxf(__builtin_fmaxf((a),(b)),(c))
  #define GAPA(MF,A0,A1,A2,A3,W0,W1,PW) do{ MF; sacc+=A0; sacc+=A1; sacc+=A2; sacc+=A3; PIN(sacc); W0; W1; PIN(PW); SBAR(); }while(0)
  #define EX(v) __builtin_amdgcn_exp2f(v)
  #define GAPB(MF,X,B) do{ MF; X[B]=EX(X[B]); X[B+1]=EX(X[B+1]); X[B+2]=EX(X[B+2]); X[B+3]=EX(X[B+3]); PIN(X); SBAR(); }while(0)
  #define VRD(i) do{ vlo[i]=vtr(vp_+(((i)>>2)*4096+((i)&3)*1024)); vhi[i]=vtr(vp_+(((i)>>2)*4096+((i)&3)*1024+512)); }while(0)
  #define KRD(G,j) do{ if(G){ kload2(kf,kp0+sl_next,j); SBAR(); } }while(0)
  #define STEP(C0,C1,P0,P1,t,GK,GV,GL) do{ SBAR(); \
    const lds_cptr vp_=vp0+sl_prev; \
    VRD(0); SBAR(); float sacc=(P0[0]+P0[1]); \
    GAPA(C0=__builtin_amdgcn_mfma_f32_32x32x16_bf16(kf[0],qr[0],negm,0,0,0), P0[2],P0[3],P0[4],P0[5],     pw0[0]=PKW(P0,0), pw0[1]=PKW(P0,2), pw0); \
    VRD(4); SBAR(); GAPA(C1=__builtin_amdgcn_mfma_f32_32x32x16_bf16(kf[1],qr[0],negm,0,0,0), P0[6],P0[7],P0[8],P0[9],     pw0[2]=PKW(P0,4), pw0[3]=PKW(P0,6), pw0); \
    VRD(1); SBAR(); GAPA(C0=__builtin_amdgcn_mfma_f32_32x32x16_bf16(kf[2],qr[1],C0,0,0,0),   P0[10],P0[11],P0[12],P0[13], pw1[0]=PKW(P0,8), pw1[1]=PKW(P0,10), pw1); \
    VRD(5); SBAR(); GAPA(C1=__builtin_amdgcn_mfma_f32_32x32x16_bf16(kf[3],qr[1],C1,0,0,0),   P0[14],P0[15],P1[0],P1[1],   pw1[2]=PKW(P0,12),pw1[3]=PKW(P0,14), pw1); \
    VRD(2); SBAR(); GAPA(C0=__builtin_amdgcn_mfma_f32_32x32x16_bf16(kf[4],qr[2],C0,0,0,0),   P1[2],P1[3],P1[4],P1[5],     pw2[0]=PKW(P1,0), pw2[1]=PKW(P1,2), pw2); \
    VRD(6); SBAR(); GAPA(C1=__builtin_amdgcn_mfma_f32_32x32x16_bf16(kf[5],qr[2],C1,0,0,0),   P1[6],P1[7],P1[8],P1[9],     pw2[2]=PKW(P1,4), pw2[3]=PKW(P1,6), pw2); \
    VRD(3); SBAR(); GAPA(C0=__builtin_amdgcn_mfma_f32_32x32x16_bf16(kf[6],qr[3],C0,0,0,0),   P1[10],P1[11],P1[12],P1[13], pw3[0]=PKW(P1,8), pw3[1]=PKW(P1,10), pw3); \
    VRD(7); SBAR(); GAPA(C1=__builtin_amdgcn_mfma_f32_32x32x16_bf16(kf[7],qr[3],C1,0,0,0),   P1[14],P1[15],0.f,0.f,       pw3[2]=PKW(P1,12),pw3[3]=PKW(P1,14), pw3); \
    l_reg+=sacc; \
    if(GK){DMA_K((t)+3,sl_cur);} if(GV){DMA_V((t)+1,sl_next);} \
    CMASK(C0,C1,t); \
    if constexpr(NOMAX) { resc=false; if(__builtin_expect(NT<0,0)){ const float dl=1.f; mhat+=dl;   \
        _Pragma("unroll") for(int r=0;r<16;++r){C0[r]-=dl;C1[r]-=dl;} \
        _Pragma("unroll") for(int r=0;r<16;++r)negm[r]=-mhat; asm volatile("":"+v"(negm)); \
        const float f=__builtin_amdgcn_exp2f(-dl); l_reg*=f; if(hi==0)wsf[r32]=f; resc=true; } } \
    if constexpr(!NOMAX) { float a=MX3(C0[0],C0[1],C1[0]),b=MX3(C0[2],C0[3],C1[1]); a=MX3(a,C1[2],C1[3]); \
      _Pragma("unroll") for(int r=4;r<16;r+=4){a=MX3(a,C0[r],C0[r+1]);b=MX3(b,C0[r+2],C0[r+3]);a=MX3(a,C1[r],C1[r+1]);b=MX3(b,C1[r+2],C1[r+3]);} \
      float rm=__builtin_fmaxf(a,b); { auto rr=__builtin_amdgcn_permlane32_swap(__float_as_uint(rm),__float_as_uint(rm),false,false); rm=__builtin_fmaxf(__uint_as_float(rr[0]),__uint_as_float(rr[1])); } \
      resc=false; \
      if(__builtin_expect(__any(rm>(float)THRL),0)){ const float dl=__builtin_fmaxf(rm,0.f); mhat+=dl; \
        _Pragma("unroll") for(int r=0;r<16;++r){C0[r]-=dl;C1[r]-=dl;} \
        _Pragma("unroll") for(int r=0;r<16;++r)negm[r]=-mhat; asm volatile("":"+v"(negm)); \
        const float f=__builtin_amdgcn_exp2f(-dl); l_reg*=f; if(hi==0)wsf[r32]=f; resc=true; } } \
    SBAR(); \
    GAPB(o[0]=__builtin_amdgcn_mfma_f32_32x32x16_bf16(PAF(0),VFR(0),o[0],0,0,0), C0,0); \
    GAPB(o[1]=__builtin_amdgcn_mfma_f32_32x32x16_bf16(PAF(0),VFR(4),o[1],0,0,0), C0,4); \
    KRD(GL,0); GAPB(o[0]=__builtin_amdgcn_mfma_f32_32x32x16_bf16(PAF(1),VFR(1),o[0],0,0,0), C0,8); \
    KRD(GL,1); GAPB(o[1]=__builtin_amdgcn_mfma_f32_32x32x16_bf16(PAF(1),VFR(5),o[1],0,0,0), C0,12); \
    KRD(GL,2); GAPB(o[0]=__builtin_amdgcn_mfma_f32_32x32x16_bf16(PAF(2),VFR(2),o[0],0,0,0), C1,0); \
    KRD(GL,3); GAPB(o[1]=__builtin_amdgcn_mfma_f32_32x32x16_bf16(PAF(2),VFR(6),o[1],0,0,0), C1,4); \
    GAPB(o[0]=__builtin_amdgcn_mfma_f32_32x32x16_bf16(PAF(3),VFR(3),o[0],0,0,0), C1,8); \
    GAPB(o[1]=__builtin_amdgcn_mfma_f32_32x32x16_bf16(PAF(3),VFR(7),o[1],0,0,0), C1,12); \
    }while(0)
  int t=1;
  for(;t+5<NT;t+=2){
    STEP(pB0,pB1,pA0,pA1,t,true,true,true);     WAIT_BAR(2); RESC(); ROT();
    STEP(pA0,pA1,pB0,pB1,t+1,true,true,true);   WAIT_BAR(2); RESC(); ROT();
  }
  #define ENDW(tt) do{ if((tt)+3<NT){WAIT_BAR(2);} else if((tt)+2<NT){WAIT_BAR(1);} else {WAIT_BAR(0);} }while(0)
  for(;t+1<NT;t+=2){
    STEP(pB0,pB1,pA0,pA1,t,(t+3<NT),(t+1<NT),(t+1<NT));       ENDW(t);   RESC(); ROT();
    STEP(pA0,pA1,pB0,pB1,t+1,(t+4<NT),(t+2<NT),(t+2<NT));     ENDW(t+1); RESC(); ROT();
  }
  STEP(pB0,pB1,pA0,pA1,NT-1,false,false,false); RESC();
  { float sacc=pB0[0]+pB0[1]; _Pragma("unroll") for(int r=2;r<16;++r)sacc+=pB0[r]; _Pragma("unroll") for(int r=0;r<16;++r)sacc+=pB1[r]; l_reg+=sacc;
    pw0=(u32x4){PKW(pB0,0),PKW(pB0,2),PKW(pB0,4),PKW(pB0,6)};pw1=(u32x4){PKW(pB0,8),PKW(pB0,10),PKW(pB0,12),PKW(pB0,14)};pw2=(u32x4){PKW(pB1,0),PKW(pB1,2),PKW(pB1,4),PKW(pB1,6)};pw3=(u32x4){PKW(pB1,8),PKW(pB1,10),PKW(pB1,12),PKW(pB1,14)};
    SBAR(); pv(o,vb0+sl_cur,PAF(0),PAF(1),PAF(2),PAF(3)); }
  #undef PKW
  #undef PAF
  #undef VFR
  #undef PIN
  #undef MX3
  #undef GAPA
  #undef GAPB
  #undef EX
  #undef VRD
  #undef KRD
  #undef STEP
  #undef ENDW
  {auto rr=__builtin_amdgcn_permlane32_swap(__float_as_uint(l_reg),__float_as_uint(l_reg),false,false);l_reg=__uint_as_float(rr[0])+__uint_as_float(rr[1]);}
  if(HAS_SINK) l_reg+=__builtin_amdgcn_exp2f(sink2-mhat);
  if(hi==0)wsf[32+r32]=l_reg;asm volatile("s_waitcnt lgkmcnt(0)":::"memory");
  float rli[16];
  #pragma unroll
  for(int r=0;r<16;++r)rli[r]=__builtin_amdgcn_rcpf(wsf[32+crow(r,hi)]);
  bf16*Ow=Ou+(long)(wid*QBLK)*QP;
  { bf16*stg=(bf16*)(shm+LDS_OST)+wid*2048;
    #pragma unroll
    for(int r=0;r<16;++r){const int orow=crow(r,hi);
      #pragma unroll
      for(int d0=0;d0<2;++d0)stg[orow*64+d0*32+r32]=__float2bfloat16(o[d0][r]*rli[r]);}
    asm volatile("s_waitcnt lgkmcnt(0)":::"memory");
    #pragma unroll
    for(int i=0;i<4;++i){const int row=i*8+(lane>>3),ch=lane&7; const u32x4 v=*(const u32x4*)(stg+row*64+ch*8); ATTN_STORE16(Ow+(long)row*QP+ch*8,v);} }
  __builtin_amdgcn_s_setprio(0);
  asm volatile("s_waitcnt lgkmcnt(0)\n\ts_barrier":::"memory");
  #undef DMA_K
  #undef DMA_V
  #undef KVROW
  #undef CMASK
  #undef START
  #undef RESC
  #undef ROT
}
constexpr int ATTN_LDS_BYTES=LDS_BYTES;
#undef SBAR
#undef WAIT_BAR
}

struct Args { const float* in[21]; float* out; unsigned char* ws; int ph_lo, ph_hi; };

constexpr int TAB_OFF = MISC_OFF + 256;
struct Frame {
    LAS unsigned char* lds; int tid, lane, wave, G, bx, vcu, gw, NGW;
    __device__ __forceinline__ unsigned long long tab(int i) const { const u32x2 v = ((const LAS u32x2*)(lds + TAB_OFF))[i];
        const unsigned lo = __builtin_amdgcn_readfirstlane(v.x), hi = __builtin_amdgcn_readfirstlane(v.y); return ((unsigned long long)hi << 32) | lo; }
    __device__ __forceinline__ const float* in(int i) const { return (const float*)(const GAS float*)tab(i); }
    __device__ __forceinline__ unsigned char* wsp(size_t off) const { return (unsigned char*)(GAS unsigned char*)(tab(22) + off); }
#define FIN(name, i) __device__ __forceinline__ const float* name() const { return in(i); }
    FIN(x, 0) FIN(c, 1) FIN(ctx, 2) FIN(c_ctx, 3) FIN(w_ada, 4) FIN(b_ada, 5) FIN(g_mix, 6) FIN(g_ffn, 7) FIN(w_in, 8) FIN(qg_a, 9) FIN(kg_a, 10) FIN(qg_b, 11) FIN(kg_b, 12)
    FIN(sink_b, 13) FIN(conv_w, 14) FIN(w_branch, 15) FIN(w_out, 16) FIN(w_router, 17) FIN(w_eg, 18) FIN(w_eu, 19) FIN(w_ed, 20)
#undef FIN
    __device__ __forceinline__ float* out() const { return (float*)(GAS float*)tab(21); }
#define FWS(type, name, off) __device__ __forceinline__ type* name() const { return (type*)wsp(off); }
    FWS(float, mod, WS_MOD) FWS(float, gains, WS_GAINS) FWS(float, xc, WS_XC) FWS(float, aff, WS_AFF) FWS(float, gatev, WS_GATEV) FWS(int, idx, WS_IDX) FWS(int, inv, WS_INV)
    FWS(bf16_t, WinT, WS_WIN) FWS(bf16_t, WbrT, WS_WBR) FWS(bf16_t, WoutT, WS_WOUT) FWS(bf16_t, H, WS_H) FWS(bf16_t, KA, WS_KA) FWS(bf16_t, KB, WS_KB) FWS(bf16_t, VA, WS_VTA) FWS(bf16_t, VB, WS_VTB)
    FWS(bf16_t, QKV, WS_QKV) FWS(bf16_t, CONV, WS_CONV) FWS(bf16_t, GATE, WS_GATE) FWS(bf16_t, XS, WS_XS) FWS(bf16_t, HID, WS_HID) FWS(bf16_t, WGU, WS_WGU) FWS(bf16_t, WD, WS_WD) FWS(bf16_t, DELTA, WS_DELTA) FWS(unsigned char, H8, WS_H8)
#undef FWS
};

__device__ __forceinline__ void transpose_item(const float* W, int K, int N, bf16_t* WT, int k0, int n0, int drow0, LAS float* scr, int lane) {
    float tv[32];
#pragma unroll
    for (int i = 0; i < 32; ++i) tv[i] = W[(size_t)(k0 + 2 * i + (lane >> 5)) * N + n0 + (lane & 31)];
#pragma unroll
    for (int i = 0; i < 32; ++i) scr[(2 * i + (lane >> 5)) * 33 + (lane & 31)] = tv[i];
    LDS_WAIT(); asm volatile("" ::: "memory");
    const int c = lane & 7;
#pragma unroll
    for (int j = 0; j < 4; ++j) { const int n = (lane >> 3) + 8 * j; const LAS float* s = scr + (8 * c) * 33 + n;
        u32x4 o; o.x = cvt_pk_bf16(s[0 * 33], s[1 * 33]); o.y = cvt_pk_bf16(s[2 * 33], s[3 * 33]); o.z = cvt_pk_bf16(s[4 * 33], s[5 * 33]); o.w = cvt_pk_bf16(s[6 * 33], s[7 * 33]);
        *(u32x4*)(WT + (size_t)(drow0 + n) * K + k0 + 8 * c) = o; }
    LDS_WAIT(); asm volatile("" ::: "memory");
}
__device__ __forceinline__ void transpose_item_fp8(const float* W, int K, int N, unsigned char* WT, int k0, int n0, int drow0, float scale, LAS float* scr, int lane) {
    float tv[32];
#pragma unroll
    for (int i = 0; i < 32; ++i) tv[i] = W[(size_t)(k0 + 2 * i + (lane >> 5)) * N + n0 + (lane & 31)];
#pragma unroll
    for (int i = 0; i < 32; ++i) scr[(2 * i + (lane >> 5)) * 33 + (lane & 31)] = tv[i] * scale;
    LDS_WAIT(); asm volatile("" ::: "memory");
    const int n = lane >> 1, kh = lane & 1; const LAS float* sp = scr + (32 * kh) * 33 + n;
    unsigned w[8];
#pragma unroll
    for (int q = 0; q < 8; ++q) w[q] = pg8::pack4_fp8(sp[(4 * q) * 33], sp[(4 * q + 1) * 33], sp[(4 * q + 2) * 33], sp[(4 * q + 3) * 33]);
    unsigned char* dp = WT + (size_t)(drow0 + n) * K + k0 + 32 * kh;
    *(u32x4*)dp = (u32x4){w[0], w[1], w[2], w[3]}; *(u32x4*)(dp + 16) = (u32x4){w[4], w[5], w[6], w[7]};
    LDS_WAIT(); asm volatile("" ::: "memory");
}
constexpr int MIXER_ITEMS = 16 * 192 + 3 * 8 * 32 + 16 * 32, EXPERT_ITEMS = NE * 3 * 16 * 32;
__device__ __forceinline__ void convert_mixer_weights(const Frame& F, int l, int begin, int end, int first, int stride) {
    LAS float* scr = (LAS float*)(F.lds + F.wave * 8448);
    constexpr int I_IN = 16 * 192, I_BR = 8 * 32, I_OUT = 16 * 32;
    for (int it = begin + first; it < end; it += stride) {
        int r = it;
        if (r < I_IN) { const int kb = r / 192, nb = r % 192, n0 = 32 * nb;
            int drow = n0;
            if (n0 < 1536) drow = (n0 & ~255) + 128 * ((n0 & 63) >> 5) + 32 * ((n0 & 255) >> 6);
            else if (n0 >= 2048 && n0 < 3072) { const int isx = n0 >= 2560, ch = n0 - (isx ? 2560 : 2048); drow = (8 + (ch >> 7)) * 256 + 128 * isx + (ch & 127); }
            if (n0 >= 3072) transpose_item_fp8(F.w_in() + (size_t)l * D * PW, D, PW, (unsigned char*)F.WinT() + 6 * MiB, 64 * kb, n0, n0 - 3072, pg8::WSCALE, scr, F.lane);
            else transpose_item(F.w_in() + (size_t)l * D * PW, D, PW, F.WinT(), 64 * kb, n0, drow, scr, F.lane);
            continue; } r -= I_IN;
        if (r < 3 * I_BR) { const int k3 = r / I_BR, q = r % I_BR, kb = q / 32, nb = q % 32;
            transpose_item(F.w_branch() + ((size_t)l * 3 + k3) * 512 * D, 512, D, F.WbrT() + (size_t)k3 * D * 512, 64 * kb, 32 * nb, 32 * nb, scr, F.lane); continue; } r -= 3 * I_BR;
        { const int kb = r / 32, nb = r % 32; transpose_item(F.w_out() + (size_t)l * D * D, D, D, F.WoutT(), 64 * kb, 32 * nb, 32 * nb, scr, F.lane); }
    }
}
__device__ __forceinline__ void convert_expert_weights(const Frame& F, int l, int begin, int end, int first, int stride) {
    LAS float* scr = (LAS float*)(F.lds + F.wave * 8448);
    constexpr int PER = 16 * 32;
    for (int it = begin + first; it < end; it += stride) {
        const int e = it / (3 * PER), r = it % (3 * PER), which = r / PER, q = r % PER, kb = q / 32, nb = q % 32, n0 = 32 * nb;
        const size_t eo = ((size_t)l * NE + e) * (size_t)D * EH;
        unsigned char* const wgu = (unsigned char*)F.WGU(); unsigned char* const wd = (unsigned char*)F.WD();
        if (which == 0) transpose_item_fp8(F.w_eg() + eo, D, EH, wgu + (size_t)e * 2048 * D, 64 * kb, n0, (n0 >> 7) * 256 + (n0 & 127), pg8::WSCALE, scr, F.lane);
        else if (which == 1) transpose_item_fp8(F.w_eu() + eo, D, EH, wgu + (size_t)e * 2048 * D, 64 * kb, n0, (n0 >> 7) * 256 + 128 + (n0 & 127), pg8::WSCALE, scr, F.lane);
        else transpose_item_fp8(F.w_ed() + eo, EH, D, wd + (size_t)e * D * EH, 64 * kb, n0, n0, pg8::WSCALE, scr, F.lane);
    }
}

__device__ __forceinline__ void norm_mod(f32x4 (&v)[4], const float* g, const float* sh, const float* sc, int lane) {
    f32x4 gg[4], s1[4], s0[4];
#pragma unroll
    for (int j = 0; j < 4; ++j) { gg[j] = *(const f32x4*)(g + 4 * lane + 256 * j); s1[j] = *(const f32x4*)(sc + 4 * lane + 256 * j); s0[j] = *(const f32x4*)(sh + 4 * lane + 256 * j); }
    float ss = 0.f;
#pragma unroll
    for (int j = 0; j < 4; ++j) ss += (v[j].x * v[j].x + v[j].y * v[j].y) + (v[j].z * v[j].z + v[j].w * v[j].w);
    ss = wave_sum(ss);
    const float rinv = 1.0f / sqrtf(ss * (1.0f / D) + EPS);
#pragma unroll
    for (int j = 0; j < 4; ++j) v[j] = (v[j] * rinv * gg[j]) * (1.0f + s1[j]) + s0[j];
}
__device__ __forceinline__ void norm_mod_lds(f32x4 (&v)[4], const LAS float* g, const LAS float* sh, const LAS float* sc, int lane) {
    float ss = 0.f;
#pragma unroll
    for (int j = 0; j < 4; ++j) ss += (v[j].x * v[j].x + v[j].y * v[j].y) + (v[j].z * v[j].z + v[j].w * v[j].w);
    ss = wave_sum(ss);
    const float rinv = 1.0f / sqrtf(ss * (1.0f / D) + EPS);
#pragma unroll
    for (int j = 0; j < 4; ++j) { const f32x4 gg = *(const LAS f32x4*)(g + 4 * lane + 256 * j), s1 = *(const LAS f32x4*)(sc + 4 * lane + 256 * j), s0 = *(const LAS f32x4*)(sh + 4 * lane + 256 * j);
        v[j] = (v[j] * rinv * gg) * (1.0f + s1) + s0; }
}
__device__ __forceinline__ void norm_mod_reg(f32x4 (&v)[4], const f32x4 (&gg)[4], const f32x4 (&s0)[4], const f32x4 (&s1)[4]) {
    float ss = 0.f;
#pragma unroll
    for (int j = 0; j < 4; ++j) ss += (v[j].x * v[j].x + v[j].y * v[j].y) + (v[j].z * v[j].z + v[j].w * v[j].w);
    ss = wave_sum(ss);
    const float rinv = 1.0f / sqrtf(ss * (1.0f / D) + EPS);
#pragma unroll
    for (int j = 0; j < 4; ++j) v[j] = (v[j] * rinv * gg[j]) * (1.0f + s1[j]) + s0[j];
}
__device__ __forceinline__ void store_row_fp8(unsigned char* orow, const f32x4 (&v)[4], int lane) {
#pragma unroll
    for (int j = 0; j < 4; ++j) *(unsigned*)(orow + 4 * lane + 256 * j) = pg8::pack4_fp8(v[j].x, v[j].y, v[j].z, v[j].w);
}
__device__ __forceinline__ void store_row_bf16(bf16_t* orow, const f32x4 (&v)[4], int lane) {
#pragma unroll
    for (int j = 0; j < 4; ++j) { u32x2 w; w.x = cvt_pk_bf16(v[j].x, v[j].y); w.y = cvt_pk_bf16(v[j].z, v[j].w); *(u32x2*)(orow + 4 * lane + 256 * j) = w; }
}

__device__ const float kInvFreq[16] = { 1.0f, 0.5623413251903491f, 0.31622776601683794f, 0.17782794100389228f, 0.1f, 0.05623413251903491f, 0.031622776601683794f, 0.017782794100389228f,
                                        0.01f, 0.005623413251903491f, 0.0031622776601683794f, 0.0017782794100389228f, 0.001f, 0.0005623413251903491f, 0.00031622776601683794f, 0.00017782794100389228f };
__device__ __forceinline__ void phase_prologue(const Frame& F) {
    LAS float* sv = (LAS float*)F.lds;
    LAS float* red = (LAS float*)(F.lds + 20480);
    { const float* cp = F.c(); const float* cc = F.c_ctx(); float cv[10];
#pragma unroll
      for (int j = 0; j < 8; ++j) cv[j] = cp[F.tid + NTHR * j];
      cv[8] = cc[F.tid]; cv[9] = cc[F.tid + NTHR];
#pragma unroll
      for (int j = 0; j < 10; ++j) sv[F.tid + NTHR * j] = cv[j] / (1.0f + __expf(-cv[j])); }
    __syncthreads();
    for (int item = F.bx; item < 2 * 96; item += F.G) {
        const int l = item / 96, col = (item % 96) * 64 + F.lane;
        const float* W = F.w_ada() + (size_t)l * D * PW + col;
        float a0 = 0.f, a1 = 0.f, a2 = 0.f, a3 = 0.f, a4 = 0.f;
#pragma unroll 16
        for (int kk = 0; kk < 128; ++kk) { const int k = F.wave * 128 + kk; const float w = W[(size_t)k * PW];
            a0 += sv[k] * w; a1 += sv[D + k] * w; a2 += sv[2 * D + k] * w; a3 += sv[3 * D + k] * w; a4 += sv[4 * D + k] * w; }
        red[(F.wave * 5 + 0) * 64 + F.lane] = a0; red[(F.wave * 5 + 1) * 64 + F.lane] = a1; red[(F.wave * 5 + 2) * 64 + F.lane] = a2; red[(F.wave * 5 + 3) * 64 + F.lane] = a3; red[(F.wave * 5 + 4) * 64 + F.lane] = a4;
        __syncthreads();
        if (F.wave < 5) { float s = 0.f;
#pragma unroll
            for (int w = 0; w < 8; ++w) s += red[(w * 5 + F.wave) * 64 + F.lane];
            F.mod()[(size_t)(l * 5 + F.wave) * PW + col] = s + F.b_ada()[l * PW + col]; }
        __syncthreads();
    }
    if (F.bx == 0) { float* gt = F.gains(); if (F.tid < 16) gt[512 + F.tid] = kInvFreq[F.tid];
        if (F.tid >= 64 && F.tid < 68) {
            const int l = (F.tid - 64) >> 1, br = (F.tid - 64) & 1; const float* gq = (br ? F.qg_b() : F.qg_a()) + l * 64; const float* gk = (br ? F.kg_b() : F.kg_a()) + l * 64; float mq = 0.f, mk = 0.f;
            for (int d = 0; d < 64; ++d) { mq = fmaxf(mq, fabsf(gq[d])); mk = fmaxf(mk, fabsf(gk[d])); }
            gt[528 + l * 2 + br] = QSCALE * 64.0f * mq * mk * 1.02f; } for (int i = F.tid; i < 2 * 4 * 64; i += NTHR) { const int l = i >> 8, w = (i >> 6) & 3, d = i & 63;
            const float* src = (w == 0) ? F.kg_a() : (w == 1) ? F.kg_b() : (w == 2) ? F.qg_a() : F.qg_b(); gt[i] = src[l * 64 + d]; } }
    __syncthreads();
    convert_mixer_weights(F, 0, 0, MIXER_ITEMS, F.gw, F.NGW);
}

__device__ __forceinline__ void phase_norm1(const Frame& F, int l, const float* xl, const float* xcsrc) {
    const int lane = F.lane;
#define N1_LOAD(V, RB) do { _Pragma("unroll") for (int q = 0; q < 4; ++q) { const int row = (RB) + q * F.NGW; const int rc = row < MT ? row : (RB); \
            const float* xr = rc < ML ? xl + (size_t)rc * D : xcsrc + (size_t)(rc - ML) * D; \
            _Pragma("unroll") for (int j = 0; j < 4; ++j) V[q][j] = *(const f32x4*)(xr + 4 * lane + 256 * j); } } while (0)
    int r0 = F.gw < MT ? F.gw : 0;
    f32x4 v[4][4], vn[4][4];
    N1_LOAD(v, r0);
    LAS float* const nvl = (LAS float*)F.lds;
    { const float* modv = F.mod() + (size_t)l * 5 * PW; const float* gm = F.g_mix() + l * D; float nv[22];
#pragma unroll
      for (int j = 0; j < 22; ++j) { const int i = F.tid + NTHR * j, r = i >> 10, k = i & 1023; nv[j] = (r == 0) ? gm[k] : (r <= 5 ? modv[(size_t)(r - 1) * PW + k] : modv[(size_t)(r - 6) * PW + D + k]); }
#pragma unroll
      for (int j = 0; j < 22; ++j) nvl[F.tid + NTHR * j] = nv[j]; }
    __syncthreads();
    for (;;) {
        const int rn = r0 + 4 * F.NGW; const bool more = rn < MT;
        { const int rl = more ? rn : r0; N1_LOAD(vn, rl); }
        __builtin_amdgcn_sched_barrier(0);
#pragma unroll
        for (int q = 0; q < 4; ++q) { const int row = r0 + q * F.NGW;
            if (row < MT) { const int mr = row < ML ? row / SEQ : 4;
                norm_mod_lds(v[q], nvl, nvl + (1 + mr) * D, nvl + (6 + mr) * D, lane);
                store_row_bf16(F.H() + (size_t)row * D, v[q], lane); store_row_fp8(F.H8() + (size_t)row * D, v[q], lane); } }
        if (!more) break;
#pragma unroll
        for (int q = 0; q < 4; ++q)
#pragma unroll
            for (int j = 0; j < 4; ++j) v[q][j] = vn[q][j];
        r0 = rn;
    }
#undef N1_LOAD
}

__device__ __forceinline__ void phase_elementwise(const Frame& F, int l, int g_begin, int g_end, int gw, int ngw, bool dummy = false) {
    const int lane = F.lane;
    f32x4 cw[3][2];
    { const float* cwp = F.conv_w() + (size_t)l * 3 * 512 + 8 * lane;
#pragma unroll
      for (int q = 0; q < 3; ++q) { cw[q][0] = *(const f32x4*)(cwp + q * 512); cw[q][1] = *(const f32x4*)(cwp + q * 512 + 4); } }
    bf16_t* const Cb = F.CONV();
    for (int g4 = g_begin + gw; g4 < g_end; g4 += ngw) {
        const int g0 = g4 * 4; const bool lat = g0 < ML;
        const int tw = lat ? g0 % SEQ : (g0 - ML) % CTX, nseq = lat ? SEQ : CTX;
        bf16_t* const crow0 = Cb + (size_t)g0 * QW;
        u32x4 uu[6], bg[4];
#pragma unroll
        for (int q = 0; q < 6; ++q) { const int tt = tw + q - 1; const bool ok = (tt >= 0) && (tt < nseq);
            uu[q] = ok ? *(const u32x4*)(crow0 + (ptrdiff_t)(q - 1) * QW + 512 + 8 * lane) : (u32x4){0u, 0u, 0u, 0u}; }
#pragma unroll
        for (int i = 0; i < 4; ++i) bg[i] = *(const u32x4*)(crow0 + (size_t)i * QW + 8 * lane);
        float u[6][8];
#pragma unroll
        for (int q = 0; q < 6; ++q) { u[q][0] = bf_lo(uu[q].x); u[q][1] = bf_hi(uu[q].x); u[q][2] = bf_lo(uu[q].y); u[q][3] = bf_hi(uu[q].y); u[q][4] = bf_lo(uu[q].z); u[q][5] = bf_hi(uu[q].z); u[q][6] = bf_lo(uu[q].w); u[q][7] = bf_hi(uu[q].w); }
#pragma unroll
        for (int i = 0; i < 4; ++i) {
            float o8[8];
#pragma unroll
            for (int e = 0; e < 8; ++e) { const float w0 = (e < 4) ? cw[0][0][e & 3] : cw[0][1][e & 3], w1 = (e < 4) ? cw[1][0][e & 3] : cw[1][1][e & 3], w2 = (e < 4) ? cw[2][0][e & 3] : cw[2][1][e & 3];
                o8[e] = w0 * u[i][e] + w1 * u[i + 1][e] + w2 * u[i + 2][e]; }
            const u32x4 bb = bg[i];
            u32x4 w; w.x = cvt_pk_bf16(o8[0] * bf_lo(bb.x), o8[1] * bf_hi(bb.x)); w.y = cvt_pk_bf16(o8[2] * bf_lo(bb.y), o8[3] * bf_hi(bb.y));
            w.z = cvt_pk_bf16(o8[4] * bf_lo(bb.z), o8[5] * bf_hi(bb.z)); w.w = cvt_pk_bf16(o8[6] * bf_lo(bb.w), o8[7] * bf_hi(bb.w));
            if (!dummy) *(u32x4*)(crow0 + (size_t)i * QW + 8 * lane) = w;
        }
    }
}

__device__ __forceinline__ void ctr_signal(unsigned* ctr) {
    asm volatile("s_waitcnt vmcnt(0)" ::: "memory"); __syncthreads();
    if (threadIdx.x == 0) { __builtin_amdgcn_fence(__ATOMIC_RELEASE, "agent"); asm volatile("s_waitcnt vmcnt(0)" ::: "memory"); (void)xb_add(ctr, 1u); }
}
__device__ __forceinline__ void ctr_wait(unsigned* ctr, unsigned n) {
    if (threadIdx.x == 0) { unsigned sp = 0u; while (xb_ld(ctr) < n) { __builtin_amdgcn_s_sleep(2); if (++sp > (1u << 22)) break; }
        __builtin_amdgcn_fence(__ATOMIC_ACQUIRE, "agent"); asm volatile("s_waitcnt vmcnt(0)" ::: "memory"); }
    __syncthreads();
}
#if defined(DUPMASK)
#define ATT_DUMMY(x) (x)
#else
#define ATT_DUMMY(x) false
#endif
constexpr int CTX_FUSED_G = 256;
__device__ __forceinline__ bool ctx_fused(const Frame& F, bool has_ctx) { return has_ctx && F.G == CTX_FUSED_G; }
__device__ __forceinline__ void phase_attention(const Frame& F, int l, bool has_ctx, bool first, bool dummy_out = false) {
    const float mA = F.gains()[528 + l * 2], mB = F.gains()[528 + l * 2 + 1];
    const bool fastA = mA < 80.0f; (void)mB;
    const bool fused = ctx_fused(F, has_ctx);
    const int v = F.vcu;
    const bool isM = fused && v >= 64 && v < 80, isO = fused && v >= 80 && v < 96;
    const int nwin = v < 64 ? 4 : v < 80 ? 0 : v < 96 ? 2 : v < 192 ? 5 : 4;
    const int wstart = v < 64 ? 4 * v : v < 80 ? 256 : v < 96 ? 256 + 2 * (v - 80) : v < 192 ? 288 + 5 * (v - 96) : 768 + 4 * (v - 192);
    unsigned* const ctrA = (unsigned*)F.wsp(WS_CTL) + 8192 + 64 * (2 * l), * const ctrM = ctrA + 64;
    enum { K_SKIP = 0, K_CONVCTX, K_CONV, K_GLOBAL, K_WINDOW, K_CTXATT, K_MERGE, K_OUT };
    for (int n = 0;; ++n) {
        int kind = K_SKIP, arg = 0;
        if (fused) {
            if (n == 0) kind = v < 32 ? K_CONVCTX : K_SKIP;
            else if (n == 1) { kind = v < 64 ? K_CTXATT : K_SKIP; arg = v; }
            else if (n == 2) kind = isM ? K_SKIP : K_CONV;
            else if (n == 3 || n == 4) { kind = K_GLOBAL; arg = (n - 3) * 256 + v; }
            else if (n == 5) kind = isM ? K_MERGE : K_SKIP;
            else if (n == 6 || n == 7) { kind = K_GLOBAL; arg = (n - 4) * 256 + v; }
            else if (n == 8) kind = isO ? K_OUT : K_SKIP;
            else { const int j = n - 9; if (j >= nwin) break; kind = K_WINDOW; arg = wstart + j; }
        } else {
            if (n == 0) kind = K_CONV;
            else { const int uid = (n - 1) * F.G + v; if (uid >= 2048 + (has_ctx ? 64 : 0)) break;
                if (uid < 1024) { kind = K_GLOBAL; arg = uid; } else if (uid < 2048) { kind = K_WINDOW; arg = uid - 1024; } else { kind = K_CTXATT; arg = uid - 2048; } }
        }
        if (kind == K_CONVCTX) { if (first) phase_elementwise(F, l, ML / 4, MT / 4, v * NWAVES + F.wave, 32 * NWAVES); }
        else if (kind == K_CONV) {
            if (first) { if (fused) { const int vv = v < 64 ? v : v - 16; phase_elementwise(F, l, 0, ML / 4, vv * NWAVES + F.wave, (CTX_FUSED_G - 16) * NWAVES); }
                         else phase_elementwise(F, l, 0, MT / 4, F.gw, F.NGW); }
        } else if (kind == K_GLOBAL) {
            const int uid = arg; const int b = uid >> 8, h = (uid >> 5) & 7, qb = uid & 31, kvh = h >> 2;
            ab::bf16* qo = (ab::bf16*)(F.QKV() + (size_t)(b * SEQ + qb * 256) * QW + OFF_QA + h * 64); ab::bf16* oo = ATT_DUMMY(dummy_out) ? (ab::bf16*)F.H() : qo;
            const ab::bf16* kp = (const ab::bf16*)(F.KA() + (size_t)(b * 2 + kvh) * KVROWS * 64); const ab::bf16* vp = (const ab::bf16*)(F.VA() + (size_t)(b * 2 + kvh) * KVROWS * 64);
            if (fastA) ab::attn_unit<8, false, false, true>(qo, kp, vp, oo, KVROWS / 64, (char*)F.lds, F.tid, 0, 0, 0.f, mA);
            else ab::attn_unit<8, false, false, false>(qo, kp, vp, oo, KVROWS / 64, (char*)F.lds, F.tid, 0, 0, 0.f, 0.f);
        } else if (kind == K_WINDOW) {
            const int w = arg; const int b = w >> 8, h = (w >> 5) & 7, qb = w & 31, kvh = h >> 2;
            ab::bf16* qo = (ab::bf16*)(F.QKV() + (size_t)(b * SEQ + qb * 256) * QW + OFF_QB + h * 64); ab::bf16* oo = ATT_DUMMY(dummy_out) ? (ab::bf16*)F.H() : qo;
            int lo = qb * 4 - 2, hi2 = qb * 4 + 6; if (lo < 0) lo = 0; if (hi2 > SEQ / 64) hi2 = SEQ / 64;
            const size_t ko = (size_t)(b * 2 + kvh) * KVROWS * 64; const float sk = F.sink_b()[l * 8 + h] * LOG2E;
            ab::attn_unit<8, true, true, false>(qo, (const ab::bf16*)(F.KB() + ko), (const ab::bf16*)(F.VB() + ko), oo, 4 + (hi2 - lo), (char*)F.lds, F.tid, lo, qb * 256, sk, 0.f);
        } else if (kind == K_CTXATT) {
            const int w = arg, isb = w >> 5, b = (w >> 3) & 3, h = w & 7, kvh = h >> 2;
            ab::bf16* qo = (ab::bf16*)(F.QKV() + (size_t)(ML + b * CTX) * QW + (isb ? OFF_QB : OFF_QA) + h * 64); ab::bf16* oo = ATT_DUMMY(dummy_out) ? (ab::bf16*)F.H() : qo;
            const size_t ko = ((size_t)(b * 2 + kvh) * KVROWS + SEQ) * 64;
            if (isb) ab::attn_unit<8, false, true, false>(qo, (const ab::bf16*)(F.KB() + ko), (const ab::bf16*)(F.VB() + ko), oo, CTX / 64, (char*)F.lds, F.tid, 0, 0, F.sink_b()[l * 8 + h] * LOG2E, 0.f);
            else ab::attn_unit<8, false, false, false>(qo, (const ab::bf16*)(F.KA() + ko), (const ab::bf16*)(F.VA() + ko), oo, CTX / 64, (char*)F.lds, F.tid, 0, 0, 0.f, 0.f);
            if (fused) ctr_signal(ctrA);
        } else if (kind == K_MERGE) {
            ctr_wait(ctrA, 64u);
            const int t = v - 64;
            pg8::SchedMergeOne S; S.pm = ML / 256 + (t >> 2); S.pn = t & 3; S.Q = (const char*)F.QKV(); S.C = (const char*)F.CONV(); S.W = (const char*)F.WbrT();
            pg8::EpiMerge E{(const unsigned char*)F.GATE(), F.H()};
            pg8::gemm_phase(F.lds, 512, QW, 512, S, E);
            ctr_signal(ctrM);
        } else if (kind == K_OUT) {
            ctr_wait(ctrM, 16u);
            const int t = v - 80;
            pg8::SchedPlainOne S; S.pm = ML / 256 + (t >> 2); S.pn = t & 3; S.A = (const char*)F.H(); S.B = (const char*)F.WoutT(); S.atile = (size_t)256 * D * 2; S.btile = (size_t)256 * D * 2;
            pg8::EpiOut E{F.DELTA(), F.mod() + (size_t)l * 5 * PW, F.x(), F.ctx(), (l == 0) ? (const bf16_t*)nullptr : (const bf16_t*)F.wsp(WS_XB16)};
            pg8::gemm_phase(F.lds, D, D, D, S, E);
        }
    }
}

__device__ __forceinline__ void router_row(const Frame& F, f32x4 (&v)[4], int l, int row, int b, int pos, int mr, const float* modl, const LAS float* wrt, int lane) {
        norm_mod(v, F.g_ffn() + l * D, modl + mr * PW + 3 * D, modl + mr * PW + 4 * D, lane);
        store_row_fp8(F.H8() + (size_t)row * D, v, lane);
        float lg[16];
#pragma unroll
        for (int e = 0; e < 16; ++e) { float s = 0.f;
#pragma unroll
            for (int j = 0; j < 4; ++j) { const f32x4 w = *(const LAS f32x4*)(wrt + e * D + 4 * lane + 256 * j); s += (v[j].x * w.x + v[j].y * w.y) + (v[j].z * w.z + v[j].w * w.w); }
            lg[e] = s; }
        float w8[8], w4[4], w2[2], lgt;
        { const bool up = (lane & 32) != 0;
#pragma unroll
          for (int i = 0; i < 8; ++i) { const float mine = up ? lg[8 + i] : lg[i], oth = up ? lg[i] : lg[8 + i]; w8[i] = mine + __shfl_xor(oth, 32); } }
        { const bool up = (lane & 16) != 0;
#pragma unroll
          for (int i = 0; i < 4; ++i) { const float mine = up ? w8[4 + i] : w8[i], oth = up ? w8[i] : w8[4 + i]; w4[i] = mine + __shfl_xor(oth, 16); } }
        { const bool up = (lane & 8) != 0;
#pragma unroll
          for (int i = 0; i < 2; ++i) { const float mine = up ? w4[2 + i] : w4[i], oth = up ? w4[i] : w4[2 + i]; w2[i] = mine + __shfl_xor(oth, 8); } }
        { const bool up = (lane & 4) != 0; const float mine = up ? w2[1] : w2[0], oth = up ? w2[0] : w2[1]; lgt = mine + __shfl_xor(oth, 4); }
        lgt += __shfl_xor(lgt, 2); lgt += __shfl_xor(lgt, 1);
        float mx = lgt;
        mx = fmaxf(mx, __shfl_xor(mx, 4)); mx = fmaxf(mx, __shfl_xor(mx, 8)); mx = fmaxf(mx, __shfl_xor(mx, 16)); mx = fmaxf(mx, __shfl_xor(mx, 32));
        const float ex = __expf(lgt - mx); float sum = ex;
        sum += __shfl_xor(sum, 4); sum += __shfl_xor(sum, 8); sum += __shfl_xor(sum, 16); sum += __shfl_xor(sum, 32);
        if ((lane & 3) == 0) { const int e = ((lane >> 5) & 1) * 8 + ((lane >> 4) & 1) * 4 + ((lane >> 3) & 1) * 2 + ((lane >> 2) & 1);
            F.aff()[(size_t)(b * NE + e) * KVROWS + pos] = ex / sum; F.inv()[(size_t)row * NE + e] = -1; }
}
__device__ __forceinline__ void router_finish(const Frame& F, const float (&lg)[16], int row, int b, int pos, int lane) {
    float w8[8], w4[4], w2[2], lgt;
    { const bool up = (lane & 32) != 0;
#pragma unroll
      for (int i = 0; i < 8; ++i) { const float mine = up ? lg[8 + i] : lg[i], oth = up ? lg[i] : lg[8 + i]; w8[i] = mine + __shfl_xor(oth, 32); } }
    { const bool up = (lane & 16) != 0;
#pragma unroll
      for (int i = 0; i < 4; ++i) { const float mine = up ? w8[4 + i] : w8[i], oth = up ? w8[i] : w8[4 + i]; w4[i] = mine + __shfl_xor(oth, 16); } }
    { const bool up = (lane & 8) != 0;
#pragma unroll
      for (int i = 0; i < 2; ++i) { const float mine = up ? w4[2 + i] : w4[i], oth = up ? w4[i] : w4[2 + i]; w2[i] = mine + __shfl_xor(oth, 8); } }
    { const bool up = (lane & 4) != 0; const float mine = up ? w2[1] : w2[0], oth = up ? w2[0] : w2[1]; lgt = mine + __shfl_xor(oth, 4); }
    lgt += __shfl_xor(lgt, 2); lgt += __shfl_xor(lgt, 1);
    float mx = lgt;
    mx = fmaxf(mx, __shfl_xor(mx, 4)); mx = fmaxf(mx, __shfl_xor(mx, 8)); mx = fmaxf(mx, __shfl_xor(mx, 16)); mx = fmaxf(mx, __shfl_xor(mx, 32));
    const float ex = __expf(lgt - mx); float sum = ex;
    sum += __shfl_xor(sum, 4); sum += __shfl_xor(sum, 8); sum += __shfl_xor(sum, 16); sum += __shfl_xor(sum, 32);
    if ((lane & 3) == 0) { const int e = ((lane >> 5) & 1) * 8 + ((lane >> 4) & 1) * 4 + ((lane >> 3) & 1) * 2 + ((lane >> 2) & 1);
        F.aff()[(size_t)(b * NE + e) * KVROWS + pos] = ex / sum; F.inv()[(size_t)row * NE + e] = -1; }
}
constexpr int WRP = 1028;
__device__ __forceinline__ void phase_norm2_mfma(const Frame& F, int l, bool has_ctx) {
    LAS float* wrt = (LAS float*)F.lds;
    const int nrows = has_ctx ? MT : ML, ngroups = nrows / 16, lane = F.lane, r = lane & 15, g = lane >> 4;
    const bf16_t* const xm = F.DELTA();
    u32x4 xw[32];
    { const int gi0 = F.gw < ngroups ? F.gw : 0; const bf16_t* xr = xm + (size_t)(gi0 * 16 + r) * D + 8 * g;
#pragma unroll
      for (int t = 0; t < 32; ++t) xw[t] = *(const u32x4*)(xr + 32 * t); }
    { const f32x4* wsrc = (const f32x4*)(F.w_router() + (size_t)l * D * NE) + F.tid * 8;
      f32x4 wv[8];
#pragma unroll
      for (int i = 0; i < 8; ++i) wv[i] = wsrc[i];
#pragma unroll
      for (int i = 0; i < 8; ++i) { const int k = 2 * F.tid + (i >> 2), e0 = (i & 3) * 4; wrt[(e0 + 0) * WRP + k] = wv[i].x; wrt[(e0 + 1) * WRP + k] = wv[i].y; wrt[(e0 + 2) * WRP + k] = wv[i].z; wrt[(e0 + 3) * WRP + k] = wv[i].w; } }
    LAS float* const nvl = wrt + NE * WRP;
    { const float* modv = F.mod() + (size_t)l * 5 * PW; const float* gf = F.g_ffn() + l * D; float nv[22];
#pragma unroll
      for (int j = 0; j < 22; ++j) { const int i = F.tid + NTHR * j, r = i >> 10, k = i & 1023; nv[j] = (r == 0) ? gf[k] : (r <= 5 ? modv[(size_t)(r - 1) * PW + 3 * D + k] : modv[(size_t)(r - 6) * PW + 4 * D + k]); }
#pragma unroll
      for (int j = 0; j < 22; ++j) nvl[F.tid + NTHR * j] = nv[j]; }
    __syncthreads();
    for (int it = 0;; ++it) {
        int gi;
        if (it == 0) gi = F.gw; else { if (F.wave != 0) break; gi = F.NGW + F.vcu + (it - 1) * F.G; }
        if (gi >= ngroups) break;
        const int row = gi * 16 + r; const bool lat = row < ML;
        const int b = lat ? row / SEQ : (row - ML) / CTX, pos = lat ? row % SEQ : SEQ + (row - ML) % CTX, mr = lat ? b : 4;
        if (it > 0) { const bf16_t* xr = xm + (size_t)row * D + 8 * g;
#pragma unroll
          for (int t = 0; t < 32; ++t) xw[t] = *(const u32x4*)(xr + 32 * t); }
        float ss = 0.f;
#pragma unroll
        for (int t = 0; t < 32; ++t) { const u32x4 w = xw[t];
            const float a0 = bf_lo(w.x), a1 = bf_hi(w.x), a2 = bf_lo(w.y), a3 = bf_hi(w.y), a4 = bf_lo(w.z), a5 = bf_hi(w.z), a6 = bf_lo(w.w), a7 = bf_hi(w.w);
            ss += (a0 * a0 + a1 * a1) + (a2 * a2 + a3 * a3) + (a4 * a4 + a5 * a5) + (a6 * a6 + a7 * a7); }
        ss += __shfl_xor(ss, 16); ss += __shfl_xor(ss, 32);
        const float rinv = 1.0f / sqrtf(ss * (1.0f / D) + EPS);
#pragma unroll
        for (int t = 0; t < 32; ++t) asm volatile("" : "+v"(xw[t]));
        const LAS float* const gl = nvl + 8 * g; const LAS float* const shl = nvl + (1 + mr) * D + 8 * g; const LAS float* const scl = nvl + (6 + mr) * D + 8 * g;
        const LAS float* const wl = wrt + r * WRP + 8 * g;
        unsigned char* const h8 = F.H8() + (size_t)row * D + 8 * g;
        f32x4 acc = (f32x4){0.f, 0.f, 0.f, 0.f};
#pragma unroll
        for (int t = 0; t < 32; ++t) { const u32x4 w = xw[t];
            const f32x4 g0 = *(const LAS f32x4*)(gl + 32 * t), g1 = *(const LAS f32x4*)(gl + 32 * t + 4), s00 = *(const LAS f32x4*)(shl + 32 * t), s01 = *(const LAS f32x4*)(shl + 32 * t + 4),
                        s10 = *(const LAS f32x4*)(scl + 32 * t), s11 = *(const LAS f32x4*)(scl + 32 * t + 4), w0 = *(const LAS f32x4*)(wl + 32 * t), w1 = *(const LAS f32x4*)(wl + 32 * t + 4);
            float h[8];
            h[0] = (bf_lo(w.x) * rinv * g0.x) * (1.0f + s10.x) + s00.x; h[1] = (bf_hi(w.x) * rinv * g0.y) * (1.0f + s10.y) + s00.y; h[2] = (bf_lo(w.y) * rinv * g0.z) * (1.0f + s10.z) + s00.z; h[3] = (bf_hi(w.y) * rinv * g0.w) * (1.0f + s10.w) + s00.w;
            h[4] = (bf_lo(w.z) * rinv * g1.x) * (1.0f + s11.x) + s01.x; h[5] = (bf_hi(w.z) * rinv * g1.y) * (1.0f + s11.y) + s01.y; h[6] = (bf_lo(w.w) * rinv * g1.z) * (1.0f + s11.z) + s01.z; h[7] = (bf_hi(w.w) * rinv * g1.w) * (1.0f + s11.w) + s01.w;
            u32x2 pk; pk.x = pg8::pack4_fp8(h[0], h[1], h[2], h[3]); pk.y = pg8::pack4_fp8(h[4], h[5], h[6], h[7]);
            *(u32x2*)(h8 + 32 * t) = pk;
            acc = __builtin_amdgcn_mfma_f32_16x16x4f32(w0.x, h[0], acc, 0, 0, 0); acc = __builtin_amdgcn_mfma_f32_16x16x4f32(w0.y, h[1], acc, 0, 0, 0);
            acc = __builtin_amdgcn_mfma_f32_16x16x4f32(w0.z, h[2], acc, 0, 0, 0); acc = __builtin_amdgcn_mfma_f32_16x16x4f32(w0.w, h[3], acc, 0, 0, 0);
            acc = __builtin_amdgcn_mfma_f32_16x16x4f32(w1.x, h[4], acc, 0, 0, 0); acc = __builtin_amdgcn_mfma_f32_16x16x4f32(w1.y, h[5], acc, 0, 0, 0);
            acc = __builtin_amdgcn_mfma_f32_16x16x4f32(w1.z, h[6], acc, 0, 0, 0); acc = __builtin_amdgcn_mfma_f32_16x16x4f32(w1.w, h[7], acc, 0, 0, 0);
            __builtin_amdgcn_sched_barrier(0); }
        float mx = fmaxf(fmaxf(acc.x, acc.y), fmaxf(acc.z, acc.w));
        mx = fmaxf(mx, __shfl_xor(mx, 16)); mx = fmaxf(mx, __shfl_xor(mx, 32));
        const float e0 = __expf(acc.x - mx), e1 = __expf(acc.y - mx), e2 = __expf(acc.z - mx), e3 = __expf(acc.w - mx);
        float sum = (e0 + e1) + (e2 + e3);
        sum += __shfl_xor(sum, 16); sum += __shfl_xor(sum, 32);
        const float rs = 1.0f / sum;
        float* const ap = F.aff() + (size_t)(b * NE + 4 * g) * KVROWS + pos;
        ap[0] = e0 * rs; ap[KVROWS] = e1 * rs; ap[2 * KVROWS] = e2 * rs; ap[3 * KVROWS] = e3 * rs;
        { int m1 = -1; asm volatile("" : "+v"(m1));
          *(v4i32*)(F.inv() + (size_t)row * NE + 4 * g) = (v4i32){m1, m1, m1, m1}; }
    }
}

template <bool XBF>
__device__ __forceinline__ void phase_norm2_router(const Frame& F, int l, bool has_ctx) {
    LAS float* wrt = (LAS float*)F.lds;
    { const f32x4* wsrc = (const f32x4*)(F.w_router() + (size_t)l * D * NE) + F.tid * 8;
      f32x4 wv[8];
#pragma unroll
      for (int i = 0; i < 8; ++i) wv[i] = wsrc[i];
#pragma unroll
      for (int i = 0; i < 8; ++i) { const int k = 2 * F.tid + (i >> 2), e0 = (i & 3) * 4; wrt[(e0 + 0) * D + k] = wv[i].x; wrt[(e0 + 1) * D + k] = wv[i].y; wrt[(e0 + 2) * D + k] = wv[i].z; wrt[(e0 + 3) * D + k] = wv[i].w; } }
    LAS float* const nvl = wrt + NE * D;
    { const float* modv = F.mod() + (size_t)l * 5 * PW; const float* gf = F.g_ffn() + l * D; float nv[22];
#pragma unroll
      for (int j = 0; j < 22; ++j) { const int i = F.tid + NTHR * j, r = i >> 10, k = i & 1023; nv[j] = (r == 0) ? gf[k] : (r <= 5 ? modv[(size_t)(r - 1) * PW + 3 * D + k] : modv[(size_t)(r - 6) * PW + 4 * D + k]); }
#pragma unroll
      for (int j = 0; j < 22; ++j) nvl[F.tid + NTHR * j] = nv[j]; }
    __syncthreads();
    const float* modl = F.mod() + (size_t)l * 5 * PW; const int nrows = has_ctx ? MT : ML; const int lane = F.lane;
    const bf16_t* const xb16 = (const bf16_t*)F.wsp(WS_XB16);
    const float* const xlat = (l == 0) ? F.x() : (const float*)F.out(); const float* const xctx = (l == 0) ? F.ctx() : (const float*)F.xc(); const bf16_t* const dlt = F.DELTA();
    constexpr int R = 2;
#define N2_LOAD(V, DW, RB) do { _Pragma("unroll") for (int q = 0; q < R; ++q) { const int row = (RB) + q * F.NGW; const int rc = row < nrows ? row : (RB); \
            const bf16_t* dr = dlt + (size_t)rc * D + 4 * lane; \
            _Pragma("unroll") for (int j = 0; j < 4; ++j) DW[q][j] = *(const u32x2*)(dr + 256 * j); } } while (0)
    int r0 = F.gw; if (r0 >= nrows) return;
    f32x4 gR[4], shR[4], scR[4]; int mrc = -1;
#pragma unroll
    for (int j = 0; j < 4; ++j) gR[j] = *(const LAS f32x4*)(nvl + 4 * lane + 256 * j);
    f32x4 v[R][4]; u32x2 dw[R][4], dn[R][4];
    N2_LOAD(v, dw, r0);
    for (;;) {
        const int rn = r0 + R * F.NGW; const bool more = rn < nrows;
        { const int rl = more ? rn : r0; N2_LOAD(v, dn, rl); }
        __builtin_amdgcn_sched_barrier(0);
#pragma unroll
        for (int q = 0; q < R; ++q) { const int row = r0 + q * F.NGW; const int rc = row < nrows ? row : r0; const int mr = rc < ML ? rc / SEQ : 4;
#pragma unroll
            for (int j = 0; j < 4; ++j) v[q][j] = (f32x4){bf_lo(dw[q][j].x), bf_hi(dw[q][j].x), bf_lo(dw[q][j].y), bf_hi(dw[q][j].y)};
            if (mr != mrc) { mrc = mr;
#pragma unroll
                for (int j = 0; j < 4; ++j) { shR[j] = *(const LAS f32x4*)(nvl + (1 + mr) * D + 4 * lane + 256 * j); scR[j] = *(const LAS f32x4*)(nvl + (6 + mr) * D + 4 * lane + 256 * j); } }
            norm_mod_reg(v[q], gR, shR, scR);
            if (row < nrows) store_row_fp8(F.H8() + (size_t)row * D, v[q], lane); }
        typedef float f32x2 __attribute__((ext_vector_type(2)));
        f32x2 vp[4][4];
#pragma unroll
        for (int j = 0; j < 4; ++j) { vp[j][0] = (f32x2){v[0][j].x, v[1][j].x}; vp[j][1] = (f32x2){v[0][j].y, v[1][j].y}; vp[j][2] = (f32x2){v[0][j].z, v[1][j].z}; vp[j][3] = (f32x2){v[0][j].w, v[1][j].w}; }
        float lg[R][16];
#pragma unroll
        for (int e = 0; e < 16; ++e) { f32x2 acc = (f32x2){0.f, 0.f};
#pragma unroll
            for (int j = 0; j < 4; ++j) { const f32x4 w = *(const LAS f32x4*)(wrt + e * D + 4 * lane + 256 * j); const f32x2 w01 = (f32x2){w.x, w.y}, w23 = (f32x2){w.z, w.w};
                asm("v_pk_fma_f32 %0, %1, %2, %0 op_sel_hi:[1,0,1]" : "+v"(acc) : "v"(vp[j][0]), "v"(w01));
                asm("v_pk_fma_f32 %0, %1, %2, %0 op_sel:[0,1,0] op_sel_hi:[1,1,1]" : "+v"(acc) : "v"(vp[j][1]), "v"(w01));
                asm("v_pk_fma_f32 %0, %1, %2, %0 op_sel_hi:[1,0,1]" : "+v"(acc) : "v"(vp[j][2]), "v"(w23));
                asm("v_pk_fma_f32 %0, %1, %2, %0 op_sel:[0,1,0] op_sel_hi:[1,1,1]" : "+v"(acc) : "v"(vp[j][3]), "v"(w23)); }
            lg[0][e] = acc.x; lg[1][e] = acc.y;
            if ((e & 3) == 3) __builtin_amdgcn_sched_barrier(0); }
#pragma unroll
        for (int q = 0; q < R; ++q) { const int row = r0 + q * F.NGW;
            if (row < nrows) { const bool lat = row < ML; const int b = lat ? row / SEQ : (row - ML) / CTX, pos = lat ? row % SEQ : SEQ + (row - ML) % CTX;
                router_finish(F, lg[q], row, b, pos, lane); } }
        if (!more) break;
#pragma unroll
        for (int q = 0; q < R; ++q)
#pragma unroll
            for (int j = 0; j < 4; ++j) dw[q][j] = dn[q][j];
        r0 = rn;
    }
#undef N2_LOAD
}

__device__ __forceinline__ void topk_unit(const Frame& F, const float* affrow, int n, int k, int* idx_out, float* gate_out, int* inv_base) {
    LAS unsigned* keys = (LAS unsigned*)F.lds; LAS int* hist = (LAS int*)(F.lds + 32768);
    LAS int* misc = (LAS int*)(F.lds + 32768 + 65536);
    const int tid = F.tid, lane = F.lane, wid = F.wave;
    for (int i0 = 0; i0 < n; i0 += 8 * NTHR) { float kv[8];
#pragma unroll
        for (int j = 0; j < 8; ++j) { const int i = i0 + tid + j * NTHR; kv[j] = affrow[i < n ? i : 0]; }
#pragma unroll
        for (int j = 0; j < 8; ++j) { const int i = i0 + tid + j * NTHR; if (i < n) keys[i] = __float_as_uint(kv[j]); } }
    for (int i = tid; i < 8 * 2048; i += NTHR) hist[i] = 0;
    __syncthreads();
    unsigned prefix = 0u; int krem = k;
    {
        for (int i = tid; i < n; i += NTHR) __hip_atomic_fetch_add(&hist[wid * 2048 + (keys[i] >> 20)], 1, __ATOMIC_RELAXED, __HIP_MEMORY_SCOPE_WORKGROUP);
        __syncthreads();
        int h[4], s4 = 0;
#pragma unroll
        for (int q = 0; q < 4; ++q) { int c = 0;
#pragma unroll
            for (int w = 0; w < 8; ++w) c += hist[w * 2048 + 2047 - 4 * tid - q];
            h[q] = c; s4 += c; }
        int incl = s4;
#pragma unroll
        for (int o = 1; o < 64; o <<= 1) { const int tv = __shfl_up(incl, o); if (lane >= o) incl += tv; }
        if (lane == 63) misc[8 + wid] = incl;
        __syncthreads();
        int base = 0;
#pragma unroll
        for (int w = 0; w < 8; ++w) { const int tv = misc[8 + w]; if (w < wid) base += tv; }
        incl += base; const int excl = incl - s4;
        if (excl < krem && incl >= krem) { int c = excl, sel, nk;
            if (c + h[0] >= krem) { sel = 2047 - 4 * tid; nk = krem - c; }
            else { c += h[0]; if (c + h[1] >= krem) { sel = 2046 - 4 * tid; nk = krem - c; }
                else { c += h[1]; if (c + h[2] >= krem) { sel = 2045 - 4 * tid; nk = krem - c; } else { c += h[2]; sel = 2044 - 4 * tid; nk = krem - c; } } }
            misc[0] = sel; misc[1] = nk; }
        __syncthreads();
        prefix = (unsigned)misc[0]; krem = misc[1];
        __syncthreads();
    }
    for (int pass = 1; pass < 4; ++pass) {
        const int shift = (pass == 1) ? 12 : (pass == 2 ? 4 : 0), width = (pass == 3) ? 4 : 8, hs = shift + width; const unsigned bm = (1u << width) - 1u;
        if (tid < 256) hist[tid] = 0;
        __syncthreads();
        for (int i = tid; i < n; i += NTHR) { const unsigned key = keys[i]; if ((key >> hs) == prefix) __hip_atomic_fetch_add(&hist[(key >> shift) & bm], 1, __ATOMIC_RELAXED, __HIP_MEMORY_SCOPE_WORKGROUP); }
        __syncthreads();
        if (wid == 0) {
            const int h0 = hist[255 - 4 * lane], h1 = hist[254 - 4 * lane], h2 = hist[253 - 4 * lane], h3 = hist[252 - 4 * lane];
            const int s = h0 + h1 + h2 + h3; int incl = s;
#pragma unroll
            for (int o = 1; o < 64; o <<= 1) { const int tv = __shfl_up(incl, o); if (lane >= o) incl += tv; }
            const int excl = incl - s;
            if (excl < krem && incl >= krem) { int c = excl, sel, nk;
                if (c + h0 >= krem) { sel = 255 - 4 * lane; nk = krem - c; }
                else { c += h0; if (c + h1 >= krem) { sel = 254 - 4 * lane; nk = krem - c; }
                    else { c += h1; if (c + h2 >= krem) { sel = 253 - 4 * lane; nk = krem - c; } else { c += h2; sel = 252 - 4 * lane; nk = krem - c; } } }
                misc[0] = sel; misc[1] = nk; }
        }
        __syncthreads();
        prefix = (prefix << width) | (unsigned)misc[0]; krem = misc[1];
        __syncthreads();
    }
    const unsigned T = prefix; const int per = (n + NTHR - 1) / NTHR, i0 = tid * per;
    int cg = 0, ce = 0;
    for (int q = 0; q < per; ++q) { const int i = i0 + q; if (i < n) { const unsigned key = keys[i]; cg += (key > T); ce += (key == T); } }
    int pk = cg | (ce << 16), incl = pk;
#pragma unroll
    for (int o = 1; o < 64; o <<= 1) { const int tv = __shfl_up(incl, o); if (lane >= o) incl += tv; }
    if (lane == 63) misc[8 + wid] = incl;
    __syncthreads();
    int base = 0;
#pragma unroll
    for (int w = 0; w < 8; ++w) { const int tv = misc[8 + w]; if (w < wid) base += tv; }
    const int ex = base + incl - pk; int sg = ex & 0xffff, se = ex >> 16; const int ngt = k - krem;
    for (int q = 0; q < per; ++q) { const int i = i0 + q; if (i < n) { const unsigned key = keys[i]; int slot = -1;
        if (key > T) slot = sg++; else if (key == T) { if (se < krem) slot = ngt + se; ++se; }
        if (slot >= 0) { idx_out[slot] = i; gate_out[slot] = __uint_as_float(key); inv_base[(size_t)i * NE] = slot; } } }
    __syncthreads();
}
__device__ __forceinline__ void phase_topk(const Frame& F, int l, bool has_ctx) {
    const int nunits = has_ctx ? 128 : 64;
    for (int u = F.bx; u < nunits; u += F.G) {
        if (u < 64) { const int b = u >> 4, e = u & 15;
            topk_unit(F, F.aff() + (size_t)u * KVROWS, SEQ, CAP, F.idx() + u * CAP, F.gatev() + u * CAP, F.inv() + (size_t)(b * SEQ) * NE + e); }
        else { const int g = u - 64, b = g >> 4, e = g & 15;
            topk_unit(F, F.aff() + (size_t)g * KVROWS + SEQ, CTX, CAPC, F.idx() + MOE_ROWS_LAT + g * CAPC, F.gatev() + MOE_ROWS_LAT + g * CAPC, F.inv() + (size_t)(ML + b * CTX) * NE + e); }
    }
    __syncthreads();
    const int nfree = F.G - nunits, fr = F.bx - nunits;
    if (nfree <= 0) { convert_expert_weights(F, l, 0, EXPERT_ITEMS, F.gw, F.NGW); if (l + 1 < DEPTH) convert_mixer_weights(F, l + 1, 0, MIXER_ITEMS, F.gw, F.NGW); return; }
    if (l + 1 < DEPTH) {
        convert_expert_weights(F, l, 0, EXPERT_ITEMS, F.gw, F.NGW);
        if (fr >= 0) convert_mixer_weights(F, l + 1, 0, MIXER_ITEMS, fr * NWAVES + F.wave, nfree * NWAVES);
    } else {
        const int cut = (EXPERT_ITEMS / 4) * 3;
        convert_expert_weights(F, l, 0, cut, F.gw, F.NGW);
        if (fr >= 0) convert_expert_weights(F, l, cut, EXPERT_ITEMS, fr * NWAVES + F.wave, nfree * NWAVES);
    }
}

__device__ __forceinline__ void phase_combine(const Frame& F, int l, bool has_ctx, bool next_norm, bool dummy = false) {
    const float* modl = F.mod() + (size_t)l * 5 * PW; const int nrows = has_ctx ? MT : ML; const int lane = F.lane;
    const bf16_t* const Y = F.XS(); const int* const invp = F.inv(); const float* const gvp = F.gatev(); float* const outp = F.out(); float* const xcp = F.xc();
    const float* const xlat = (l == 0) ? F.x() : (const float*)F.out(); const float* const xctx = (l == 0) ? F.ctx() : (const float*)F.xc(); const bf16_t* const dlt = F.DELTA();
    LAS float* const cvl = (LAS float*)F.lds;
    { const float* gmn = F.g_mix() + (next_norm ? (l + 1) : l) * D; const float* modn_ = F.mod() + (size_t)(next_norm ? (l + 1) : l) * 5 * PW; float nv[32];
#pragma unroll
      for (int j = 0; j < 32; ++j) { const int i = F.tid + NTHR * j, r = i >> 10, k = i & 1023;
          nv[j] = (r < 5) ? modl[(size_t)r * PW + 5 * D + k] : (r == 5 ? gmn[k] : (r <= 10 ? modn_[(size_t)(r - 6) * PW + k] : modn_[(size_t)(r - 11) * PW + D + k])); }
#pragma unroll
      for (int j = 0; j < 32; ++j) cvl[F.tid + NTHR * j] = nv[j]; }
    __syncthreads();
    for (int r0 = F.gw; r0 < nrows; r0 += 2 * F.NGW) {
        const int rA = r0; const bool hasB = (r0 + F.NGW) < nrows; const int rB = hasB ? r0 + F.NGW : r0;
        const bool latA = rA < ML, latB = rB < ML;
        const int bA = latA ? rA / SEQ : (rA - ML) / CTX, bB = latB ? rB / SEQ : (rB - ML) / CTX;
        float* xrA = latA ? outp + (size_t)rA * D : xcp + (size_t)(rA - ML) * D; float* xrB = latB ? outp + (size_t)rB * D : xcp + (size_t)(rB - ML) * D;
        const float* xoA = latA ? xlat + (size_t)rA * D : xctx + (size_t)(rA - ML) * D; const float* xoB = latB ? xlat + (size_t)rB * D : xctx + (size_t)(rB - ML) * D;
        int myinv = invp[(size_t)((lane & 16) ? rB : rA) * NE + (lane & 15)];
        if ((lane & 16) && !hasB) myinv = -1;
        f32x4 xa[4], xb[4];
#pragma unroll
        for (int j = 0; j < 4; ++j) {
            const u32x2 da = *(const u32x2*)(dlt + (size_t)rA * D + 4 * lane + 256 * j), db = *(const u32x2*)(dlt + (size_t)rB * D + 4 * lane + 256 * j);
            xa[j].x = bf_lo(da.x); xa[j].y = bf_hi(da.x); xa[j].z = bf_lo(da.y); xa[j].w = bf_hi(da.y); xb[j].x = bf_lo(db.x); xb[j].y = bf_hi(db.x); xb[j].z = bf_lo(db.y); xb[j].w = bf_hi(db.y); }
        (void)xoA; (void)xoB;
        const unsigned long long bal = __ballot(myinv >= 0);
        unsigned mA = (unsigned)(bal & 0xffffull), mB = (unsigned)((bal >> 16) & 0xffffull);
        f32x4 aa[4], ab2[4];
#pragma unroll
        for (int j = 0; j < 4; ++j) { aa[j] = (f32x4){0.f, 0.f, 0.f, 0.f}; ab2[j] = (f32x4){0.f, 0.f, 0.f, 0.f}; }
        while (mA | mB) {
            size_t yo[4]; float gv[4];
#pragma unroll
            for (int c = 0; c < 4; ++c) {
                const bool isB = c >= 2; unsigned& m = isB ? mB : mA; yo[c] = 0; gv[c] = 0.f;
                if (m) { const int e = __builtin_ctz(m); m &= m - 1u;
                    const int slot = __builtin_amdgcn_readlane(myinv, (isB ? 16 : 0) + e);
                    const bool lat = isB ? latB : latA; const int bb = isB ? bB : bA;
                    const int yrow = lat ? (bb * NE + e) * CAP + slot : MOE_ROWS_LAT + e * 256 + bb * 32 + slot;
                    gv[c] = lat ? gvp[(bb * NE + e) * CAP + slot] : gvp[MOE_ROWS_LAT + (bb * NE + e) * CAPC + slot];
                    yo[c] = (size_t)yrow * D; }
            }
            u32x2 yw[4][4];
#pragma unroll
            for (int c = 0; c < 4; ++c)
#pragma unroll
                for (int j = 0; j < 4; ++j) yw[c][j] = __builtin_nontemporal_load((const u32x2*)(Y + yo[c] + 4 * lane + 256 * j));
#pragma unroll
            for (int c = 0; c < 2; ++c)
#pragma unroll
                for (int j = 0; j < 4; ++j) { const u32x2 w = yw[c][j]; aa[j].x += gv[c] * bf_lo(w.x); aa[j].y += gv[c] * bf_hi(w.x); aa[j].z += gv[c] * bf_lo(w.y); aa[j].w += gv[c] * bf_hi(w.y); }
#pragma unroll
            for (int c = 2; c < 4; ++c)
#pragma unroll
                for (int j = 0; j < 4; ++j) { const u32x2 w = yw[c][j]; ab2[j].x += gv[c] * bf_lo(w.x); ab2[j].y += gv[c] * bf_hi(w.x); ab2[j].z += gv[c] * bf_lo(w.y); ab2[j].w += gv[c] * bf_hi(w.y); }
        }
        {
            const int mr = latA ? bA : 4; const LAS float* gt2 = cvl + mr * D;
            float* dst = dummy ? (float*)F.HID() + (size_t)(latA ? rA : 0) * D : xrA;
#pragma unroll
            for (int j = 0; j < 4; ++j) { const f32x4 gg = *(const LAS f32x4*)(gt2 + 4 * lane + 256 * j); xa[j] = xa[j] + gg * aa[j]; if (!(next_norm && latA)) __builtin_nontemporal_store(xa[j], (f32x4*)(dst + 4 * lane + 256 * j)); }
            if (next_norm && latA && !dummy) store_row_bf16((bf16_t*)F.wsp(WS_XB16) + (size_t)rA * D, xa, lane);
            if (next_norm && !dummy) {
                norm_mod_lds(xa, cvl + 5 * D, cvl + (6 + mr) * D, cvl + (11 + mr) * D, lane); store_row_bf16(F.H() + (size_t)rA * D, xa, lane); store_row_fp8(F.H8() + (size_t)rA * D, xa, lane); }
        }
        if (hasB) {
            const int mr = latB ? bB : 4; const LAS float* gt2 = cvl + mr * D;
            float* dst = dummy ? (float*)F.HID() + (size_t)(latB ? rB : 0) * D : xrB;
#pragma unroll
            for (int j = 0; j < 4; ++j) { const f32x4 gg = *(const LAS f32x4*)(gt2 + 4 * lane + 256 * j); xb[j] = xb[j] + gg * ab2[j]; if (!(next_norm && latB)) __builtin_nontemporal_store(xb[j], (f32x4*)(dst + 4 * lane + 256 * j)); }
            if (next_norm && latB && !dummy) store_row_bf16((bf16_t*)F.wsp(WS_XB16) + (size_t)rB * D, xb, lane);
            if (next_norm && !dummy) {
                norm_mod_lds(xb, cvl + 5 * D, cvl + (6 + mr) * D, cvl + (11 + mr) * D, lane); store_row_bf16(F.H() + (size_t)rB * D, xb, lane); store_row_fp8(F.H8() + (size_t)rB * D, xb, lane); }
        }
    }
}

__device__ __forceinline__ Frame mkframe(LAS unsigned char* lds) {
    Frame F; F.lds = lds;
    int t = threadIdx.x; asm volatile("" : "+v"(t)); int bx = blockIdx.x; asm volatile("" : "+s"(bx)); int G = gridDim.x; asm volatile("" : "+s"(G));
    F.tid = t; F.lane = t & 63; F.wave = __builtin_amdgcn_readfirstlane(t >> 6); F.G = G; F.bx = bx;
    F.vcu = (G % 8 == 0) ? (bx % 8) * (G / 8) + bx / 8 : bx; F.gw = F.vcu * NWAVES + F.wave; F.NGW = G * NWAVES;
    return F;
}
constexpr int PH_PER_LAYER = 9, NPHASES = 2 + DEPTH * PH_PER_LAYER;

__global__ void __launch_bounds__(NTHR, 2) fwd_kernel(Args args) {
    extern __shared__ __attribute__((aligned(16))) unsigned char lds_raw[];
    LAS unsigned char* const lds = (LAS unsigned char*)lds_raw;
    const int tid0 = threadIdx.x;
    volatile LAS unsigned* MISC = (volatile LAS unsigned*)(lds + MISC_OFF);
    if (tid0 < 32) MISC[tid0] = 0u;
    if (tid0 < 23) { const unsigned long long pv = (tid0 < 21) ? (unsigned long long)args.in[tid0 < 21 ? tid0 : 0] : (tid0 == 21 ? (unsigned long long)args.out : (unsigned long long)args.ws);
        ((LAS unsigned long long*)(lds + TAB_OFF))[tid0] = pv; }
    unsigned char* ws = args.ws;
    __syncthreads();
    XcdBarrier bar; bar.bar = (unsigned*)(ws + WS_CTL) + 1024; bar.x = 0; bar.st = nullptr;
#if MK_ONE_LAUNCH
    bar = xcd_barrier_post((unsigned*)(ws + WS_CTL) + 1024, MISC + 8);
#endif
    const int lo = args.ph_lo, hi = args.ph_hi;
#ifndef PHMASK
#define PHMASK 0xFFFFFFFFu
#endif
#define IN(k) (lo <= (k) && (k) < hi)
#define PM(j) ((PHMASK >> (j)) & 1u)
#ifndef DUPMASK
#define DUPMASK 0u
#endif
#define REPS(j) (((DUPMASK >> (j)) & 1u) ? 2 : 1)
#if MK_ONE_LAUNCH
#ifndef SEAMREP
#define SEAMREP 1
#endif
#define SEAM(k) do { if (IN(k) && IN((k) + 1)) { for (int sr_ = 0; sr_ < SEAMREP; ++sr_) xcd_barrier(bar); } } while (0)
#else
#define SEAM(k) do { } while (0)
#endif

#ifdef PTMASK
#define PT_BEGIN(k) do { if (((PTMASK) >> (k)) & 1u) { if (tid0 == 0) { const unsigned long long t_ = wall_clock64(); MISC[20] = (unsigned)t_; MISC[21] = (unsigned)(t_ >> 32); } } } while (0)
#define PT_END(k) do { if (((PTMASK) >> (k)) & 1u) { if (tid0 == 0) { const unsigned long long t_ = wall_clock64() - (((unsigned long long)MISC[21] << 32) | MISC[20]); const unsigned long long a_ = (((unsigned long long)MISC[23] << 32) | MISC[22]) + t_; MISC[22] = (unsigned)a_; MISC[23] = (unsigned)(a_ >> 32); } } } while (0)
#else
#define PT_BEGIN(k) do { } while (0)
#define PT_END(k) do { } while (0)
#endif
    PT_BEGIN(0);
    for (int rp = 0; rp < REPS(11); ++rp) if (PM(11) && IN(0)) { const Frame F = mkframe(lds); phase_prologue(F); }
    SEAM(0); PT_END(0); PT_BEGIN(1);
    for (int rp = 0; rp < REPS(12); ++rp) if (PM(12) && IN(1)) { const Frame F = mkframe(lds); phase_norm1(F, 0, F.x(), F.ctx()); }
    SEAM(1); PT_END(1);

    for (int l = 0; l < DEPTH; ++l) {
        const int pb = 2 + l * PH_PER_LAYER; const bool has_ctx = (l + 1 < DEPTH);
        PT_BEGIN(pb + 0);
        for (int rp = 0; rp < REPS(0); ++rp) if (PM(0) && IN(pb + 0)) { const Frame F = mkframe(lds);
            { pg8::SchedPlain S; S.T.init(MT / 256, 12, F.G, F.bx); S.A = (const char*)F.H(); S.B = (const char*)F.WinT(); S.atile = (size_t)256 * D * 2; S.btile = (size_t)256 * D * 2; S.pn0 = 0;
              pg8::EpiInProj E{(bf16_t*)F.wsp(0), F.gains() + l * 256, F.gains() + 512};
              pg8::gemm_phase(F.lds, D, D, D, S, E); }
            { pg8::SchedPlain S; S.T.init((has_ctx ? MT : ML) / 256, 12, F.G, F.G - 1 - F.bx); S.A = (const char*)F.H8();     S.B = (const char*)F.WinT() + 6 * MiB; S.atile = (size_t)256 * D; S.btile = (size_t)256 * D; S.pn0 = 12; if (F.G == 256) { S.deal = 1; S.bx = F.bx; }
              pg8::EpiInProjGate E{(bf16_t*)F.wsp(0)};
              pg8::gemm_phase(F.lds, D / 2, D / 2, D / 2, S, E); }
        }
        SEAM(pb + 0); PT_END(pb + 0); PT_BEGIN(pb + 1);
        for (int rp = 0; rp < REPS(1); ++rp) if (PM(1) && IN(pb + 1)) { const Frame F = mkframe(lds); phase_attention(F, l, has_ctx, rp == 0, rp > 0); }
        SEAM(pb + 1); PT_END(pb + 1); PT_BEGIN(pb + 2);
        for (int rp = 0; rp < REPS(2); ++rp) if (PM(2) && IN(pb + 2)) { const Frame F = mkframe(lds);
            pg8::SchedMerge S; S.T.init((has_ctx && !ctx_fused(F, has_ctx) ? MT : ML) / 256, D / 256, F.G, F.bx);     S.Q = (const char*)F.QKV(); S.C = (const char*)F.CONV(); S.W = (const char*)F.WbrT();
            pg8::EpiMerge E{(const unsigned char*)F.GATE(), F.H()};
            pg8::gemm_phase(F.lds, 512, QW, 512, S, E);
        }
        SEAM(pb + 2); PT_END(pb + 2); PT_BEGIN(pb + 3);
        for (int rp = 0; rp < REPS(3); ++rp) if (PM(3) && IN(pb + 3)) { const Frame F = mkframe(lds);
            pg8::SchedPlain S; S.T.init((has_ctx && !ctx_fused(F, has_ctx) ? MT : ML) / 256, D / 256, F.G, F.bx); S.A = (const char*)F.H(); S.B = (const char*)F.WoutT(); S.atile = (size_t)256 * D * 2; S.btile = (size_t)256 * D * 2; S.pn0 = 0;
            pg8::EpiOut E{F.DELTA(), F.mod() + (size_t)l * 5 * PW, F.x(), F.ctx(), (l == 0) ? (const bf16_t*)nullptr : (const bf16_t*)F.wsp(WS_XB16)};
            pg8::gemm_phase(F.lds, D, D, D, S, E);
        }
        SEAM(pb + 3); PT_END(pb + 3); PT_BEGIN(pb + 4);
        for (int rp = 0; rp < REPS(4); ++rp) if (PM(4) && IN(pb + 4)) { const Frame F = mkframe(lds); phase_norm2_mfma(F, l, has_ctx); }
        SEAM(pb + 4); PT_END(pb + 4); PT_BEGIN(pb + 5);
        for (int rp = 0; rp < REPS(5); ++rp) if (PM(5) && IN(pb + 5)) { const Frame F = mkframe(lds); phase_topk(F, l, has_ctx); }
        SEAM(pb + 5); PT_END(pb + 5); PT_BEGIN(pb + 6);
        for (int rp = 0; rp < REPS(6); ++rp) if (PM(6) && IN(pb + 6)) { const Frame F = mkframe(lds);
            pg8::SchedMoE<true> S; S.G = F.G; S.v = F.vcu; S.nN = 8; S.has_ctx = has_ctx; S.A = (const char*)F.H8(); S.W = (const char*)F.WGU(); S.wexp = (size_t)2048 * D; S.idx = F.idx(); S.rb = D;
            pg8::EpiGU E{(unsigned char*)F.HID()};
            pg8::gemm_phase(F.lds, D / 2, D / 2, D / 2, S, E);
        }
        SEAM(pb + 6); PT_END(pb + 6); PT_BEGIN(pb + 7);
        for (int rp = 0; rp < REPS(7); ++rp) if (PM(7) && IN(pb + 7)) { const Frame F = mkframe(lds);
            pg8::SchedMoE<false> S; S.G = F.G; S.v = F.vcu; S.nN = 4; S.has_ctx = has_ctx; S.A = (const char*)F.HID(); S.W = (const char*)F.WD(); S.wexp = (size_t)D * EH; S.idx = nullptr; S.rb = EH;
            pg8::EpiDown E{F.XS()};
            pg8::gemm_phase(F.lds, EH / 2, EH / 2, EH / 2, S, E);
        }
        SEAM(pb + 7); PT_END(pb + 7); PT_BEGIN(pb + 8);
        for (int rp = 0; rp < REPS(8); ++rp) if (PM(8) && IN(pb + 8)) { const Frame F = mkframe(lds); phase_combine(F, l, has_ctx, l + 1 < DEPTH, rp > 0); }
        SEAM(pb + 8); PT_END(pb + 8);
    }
#ifdef PTMASK
    if (blockIdx.x == 0 && tid0 == 0) { const unsigned long long a_ = (((unsigned long long)MISC[23] << 32) | MISC[22]) * (unsigned long long)(PAMP); const unsigned long long t0_ = wall_clock64(); while (wall_clock64() - t0_ < a_) __builtin_amdgcn_s_sleep(32); }
#endif
}

extern "C" void kernel_launch(void* const* d_in, const int* in_sizes, int n_in, void* d_out, int out_size, void* d_ws, size_t ws_size, hipStream_t stream) {
    static int grid = 0;
    if (grid == 0) {
        if (n_in != 21 || out_size != ML * D || ws_size < WS_END) { fprintf(stderr, "kernel_launch: unexpected shapes (n_in %d, out %d, ws %zu)\n", n_in, out_size, ws_size); grid = -1; return; }
        int dev = 0, cus = 0, per_cu = 0;
        if (hipGetDevice(&dev) != hipSuccess || hipDeviceGetAttribute(&cus, hipDeviceAttributeMultiprocessorCount, dev) != hipSuccess) { grid = -1; return; }
        if (hipFuncSetAttribute((const void*)fwd_kernel, hipFuncAttributeMaxDynamicSharedMemorySize, LDS_BYTES) != hipSuccess) { fprintf(stderr, "kernel_launch: hipFuncSetAttribute failed\n"); grid = -1; return; }
        if (hipOccupancyMaxActiveBlocksPerMultiprocessor(&per_cu, (const void*)fwd_kernel, NTHR, LDS_BYTES) != hipSuccess || per_cu < 1) { fprintf(stderr, "kernel_launch: occupancy query reports %d\n", per_cu); }
        (void)hipGetLastError();
        grid = cus;
    }
    if (grid < 0) return;
    (void)hipMemsetAsync((char*)d_ws + WS_CTL, 0, CTL_ZERO_BYTES, stream);
    Args a{};
    for (int i = 0; i < 21; ++i) a.in[i] = (const float*)d_in[i];
    a.out = (float*)d_out; a.ws = (unsigned char*)d_ws;
#if MK_ONE_LAUNCH
    a.ph_lo = 0; a.ph_hi = NPHASES;
    hipLaunchKernelGGL(fwd_kernel, dim3(grid), dim3(NTHR), LDS_BYTES, stream, a);
#else
    for (int p = 0; p < NPHASES; ++p) { a.ph_lo = p; a.ph_hi = p + 1; hipLaunchKernelGGL(fwd_kernel, dim3(grid), dim3(NTHR), LDS_BYTES, stream, a); }
#endif
}
```
